# Optimizing an MI355X kernel written in HIP

```python
import math
import jax, jax.numpy as jnp
from jax import lax
import numpy as np

D_MODEL = 1024
BATCH = 8
SEQ = 4096
DEPTH = 1

MLA_HEADS = 16
MLA_NOPE = 64
MLA_ROPE = 32
MLA_V = 64
Q_LORA = 256
KV_LORA = 128
SWA_Q_HEADS = 16
SWA_KV_HEADS = 2
SWA_GROUP = SWA_Q_HEADS // SWA_KV_HEADS
SWA_HEAD_DIM = 64
WINDOW = 128
Q_BLOCK = 128
ROPE_THETA = 10000.0
D_FF = 4 * D_MODEL
PLE_DIM = 256
N_BRANCHES = 2
NORM_EPS = 1e-6
NEG = -1e30

IN_SPLITS = (Q_LORA, KV_LORA, MLA_ROPE,
             SWA_Q_HEADS * SWA_HEAD_DIM, SWA_KV_HEADS * SWA_HEAD_DIM, SWA_KV_HEADS * SWA_HEAD_DIM,
             N_BRANCHES * D_MODEL)
IN_COLS = sum(IN_SPLITS)
IN_OFFSETS = tuple(int(v) for v in np.cumsum(IN_SPLITS)[:-1])

kernel_name = "hybrid_mla_swa_gated_sandwich"


def rms_norm(x, g):
    xf = x.astype(jnp.float32)
    y = xf * lax.rsqrt(jnp.mean(xf * xf, axis=-1, keepdims=True) + NORM_EPS)
    return (y * g.astype(jnp.float32)).astype(x.dtype)


def rope(x, pos):
    d = x.shape[-1]
    half = d // 2
    inv = jnp.exp(-math.log(ROPE_THETA) * jnp.arange(half, dtype=jnp.float32) * (2.0 / d))
    ang = pos.astype(jnp.float32)[:, None] * inv[None, :]
    cos = jnp.cos(ang)[None, :, None, :]
    sin = jnp.sin(ang)[None, :, None, :]
    xf = x.astype(jnp.float32)
    x1, x2 = xf[..., :half], xf[..., half:]
    return jnp.concatenate([x1 * cos - x2 * sin, x2 * cos + x1 * sin], axis=-1).astype(x.dtype)


def mla_attention(q, k, v):
    B, S, H, D = q.shape
    nb = S // Q_BLOCK
    scale = D ** -0.5
    qb = q.reshape(B, nb, Q_BLOCK, H, D).transpose(1, 0, 2, 3, 4)
    kpos = jnp.arange(S)

    def one_block(args):
        qblk, i = args
        s = jnp.einsum('bqhd,bkhd->bhqk', qblk, k, preferred_element_type=jnp.float32) * scale
        qpos = i * Q_BLOCK + jnp.arange(Q_BLOCK)
        mask = kpos[None, :] <= qpos[:, None]
        s = jnp.where(mask[None, None], s, NEG)
        pr = jax.nn.softmax(s, axis=-1)
        return jnp.einsum('bhqk,bkhd->bqhd', pr.astype(v.dtype), v)

    out = lax.map(one_block, (qb, jnp.arange(nb)))
    return out.transpose(1, 0, 2, 3, 4).reshape(B, S, H, v.shape[-1])


def swa_attention(q, k, v, sinks):
    B, S, HQ, hd = q.shape
    blk = WINDOW
    nb = S // blk
    scale = hd ** -0.5
    qb = q.reshape(B, nb, blk, SWA_KV_HEADS, SWA_GROUP, hd)

    def band(t):
        tb = t.reshape(B, nb, blk, SWA_KV_HEADS, hd)
        prev = jnp.pad(tb[:, :-1], ((0, 0), (1, 0), (0, 0), (0, 0), (0, 0)))
        return jnp.concatenate([prev, tb], axis=2)

    kb, vb = band(k), band(v)
    s = jnp.einsum('bnqhgd,bnkhd->bnhgqk', qb, kb, preferred_element_type=jnp.float32) * scale
    qi = jnp.arange(blk)[:, None]
    kj = jnp.arange(2 * blk)[None, :] - blk
    rel = qi - kj
    band_mask = (rel >= 0) & (rel < WINDOW)
    valid = (jnp.arange(nb)[:, None, None] * blk + kj[None]) >= 0
    mask = band_mask[None] & valid
    s = jnp.where(mask[None, :, None, None], s, NEG)
    sink = sinks.astype(jnp.float32).reshape(SWA_KV_HEADS, SWA_GROUP)[None, None, :, :, None, None]
    m = jnp.maximum(jnp.max(s, axis=-1, keepdims=True), sink)
    e = jnp.exp(s - m)
    pr = e / (jnp.sum(e, axis=-1, keepdims=True) + jnp.exp(sink - m))
    o = jnp.einsum('bnhgqk,bnkhd->bnqhgd', pr.astype(v.dtype), vb)
    return o.reshape(B, S, HQ, hd)


def setup_inputs(seed: int = 0) -> dict:
    key = jax.random.key(seed)
    ks = jax.random.split(key, 24)

    def dense(k, fan_in, fan_out):
        return jax.random.normal(k, (DEPTH, fan_in, fan_out), jnp.float32) * fan_in ** -0.5

    def gain(k, n):
        return 1.0 + 0.05 * jax.random.normal(k, (DEPTH, n), jnp.float32)

    return {
        "x": jax.random.normal(ks[0], (BATCH, SEQ, D_MODEL), jnp.float32),
        "p": jax.random.normal(ks[1], (DEPTH, BATCH, SEQ, PLE_DIM), jnp.float32),
        "g_mix_pre": gain(ks[2], D_MODEL),
        "w_in": dense(ks[3], D_MODEL, IN_COLS),
        "g_q_a": gain(ks[4], Q_LORA),
        "w_q_b": dense(ks[5], Q_LORA, MLA_HEADS * (MLA_NOPE + MLA_ROPE)),
        "g_kv_a": gain(ks[6], KV_LORA),
        "w_kv_b": dense(ks[7], KV_LORA, MLA_HEADS * (MLA_NOPE + MLA_V)),
        "sinks": 0.5 * jax.random.normal(ks[8], (DEPTH, SWA_Q_HEADS), jnp.float32),
        "w_mla_up": dense(ks[9], MLA_HEADS * MLA_V, D_MODEL),
        "w_swa_up": dense(ks[10], SWA_Q_HEADS * SWA_HEAD_DIM, D_MODEL),
        "w_out": dense(ks[11], D_MODEL, D_MODEL),
        "g_mix_post": gain(ks[12], D_MODEL),
        "g_mlp_pre": gain(ks[13], D_MODEL),
        "w_mlp_up": dense(ks[14], D_MODEL, D_FF),
        "w_mlp_down": dense(ks[15], D_FF, D_MODEL),
        "g_mlp_post": gain(ks[16], D_MODEL),
        "w_ple": dense(ks[17], PLE_DIM, D_MODEL),
        "g_ple": gain(ks[18], D_MODEL),
        "w_ple_gate": dense(ks[19], D_MODEL, D_MODEL),
    }


def reference(x, p, g_mix_pre, w_in, g_q_a, w_q_b, g_kv_a, w_kv_b, sinks, w_mla_up, w_swa_up,
              w_out, g_mix_post, g_mlp_pre, w_mlp_up, w_mlp_down, g_mlp_post, w_ple, g_ple,
              w_ple_gate):
    B, S, _ = x.shape
    pos = jnp.arange(S)
    for i in range(DEPTH):
        h = rms_norm(x, g_mix_pre[i])
        z = h @ w_in[i]
        q_a, kv_a, k_r, sq, sk, sv, gates = jnp.split(z, IN_OFFSETS, axis=-1)

        qm = (rms_norm(q_a, g_q_a[i]) @ w_q_b[i]).reshape(B, S, MLA_HEADS, MLA_NOPE + MLA_ROPE)
        q_nope, q_rope = qm[..., :MLA_NOPE], rope(qm[..., MLA_NOPE:], pos)
        kvm = (rms_norm(kv_a, g_kv_a[i]) @ w_kv_b[i]).reshape(B, S, MLA_HEADS, MLA_NOPE + MLA_V)
        k_nope, v_m = kvm[..., :MLA_NOPE], kvm[..., MLA_NOPE:]
        k_rope = jnp.broadcast_to(rope(k_r[:, :, None, :], pos), (B, S, MLA_HEADS, MLA_ROPE))
        q_mla = jnp.concatenate([q_nope, q_rope], axis=-1)
        k_mla = jnp.concatenate([k_nope, k_rope], axis=-1)
        o_mla = mla_attention(q_mla, k_mla, v_m).reshape(B, S, MLA_HEADS * MLA_V)

        q_s = rope(sq.reshape(B, S, SWA_Q_HEADS, SWA_HEAD_DIM), pos)
        k_s = rope(sk.reshape(B, S, SWA_KV_HEADS, SWA_HEAD_DIM), pos)
        v_s = sv.reshape(B, S, SWA_KV_HEADS, SWA_HEAD_DIM)
        o_swa = swa_attention(q_s, k_s, v_s, sinks[i]).reshape(B, S, SWA_Q_HEADS * SWA_HEAD_DIM)

        g_a, g_b = gates[..., :D_MODEL], gates[..., D_MODEL:]
        y = jax.nn.sigmoid(g_a) * (o_mla @ w_mla_up[i]) + jax.nn.sigmoid(g_b) * (o_swa @ w_swa_up[i])
        x = x + rms_norm(y @ w_out[i], g_mix_post[i])

        h = rms_norm(x, g_mlp_pre[i])
        u = jnp.square(jax.nn.relu(h @ w_mlp_up[i]))
        x = x + rms_norm(u @ w_mlp_down[i], g_mlp_post[i])

        e = rms_norm(p[i] @ w_ple[i], g_ple[i])
        x = x + jax.nn.sigmoid(x @ w_ple_gate[i]) * e
    return x
```

```cpp
#include <hip/hip_runtime.h>
#include <hip/hip_cooperative_groups.h>
#include <cstdio>
#include <cstdint>
namespace cg = cooperative_groups;
#ifndef MK_N_LAUNCHES
#define MK_N_LAUNCHES 1
#endif
namespace pg8 {
#define PG8_LAS __attribute__((address_space(3)))
typedef unsigned short bf16_t;
typedef short bf16x8 __attribute__((ext_vector_type(8)));
typedef float f32x4 __attribute__((ext_vector_type(4)));
typedef unsigned u32x4 __attribute__((ext_vector_type(4)));
constexpr int BM = 256, BK = 64, HALF = 128, HTB = HALF * BK * 2  , STAGE_BYTES = 8 * HTB, NXCD = 8, WGM = 8;

__host__ __device__ __forceinline__ int lds_byte(int r, int c) { const int st = (r >> 4) * 2 + (c >> 5), rr = r & 15, cc = c & 31, ob = rr * 64 + cc * 2; return st * 1024 + (ob ^ (((ob >> 9) & 1) << 5)); }
__host__ __device__ __forceinline__ void stage_rc(int b, int& R, int& C) { const int st = b / 1024, sb = b % 1024, swz = sb ^ (((sb >> 9) & 1) << 5); R = (st >> 1) * 16 + swz / 64; C = (st & 1) * 32 + (swz % 64) / 2; }
__host__ __device__ __forceinline__ int perm32(int rho) { const int n = rho >> 4, i = rho & 15; return 8 * (i >> 2) + 4 * n + (i & 3); }

struct Unit { int pm, pn, kind; };
struct Gemm { const bf16_t* A; const bf16_t* Bt; int M, N, K; };

template <class Epi, class Sched, bool ALIGN_EPI = false, bool SP2 = false>
__device__ __forceinline__ void gemm_phase(PG8_LAS unsigned char* lds, const Gemm g, const Sched& S, const Epi& E) {
    const int tid = threadIdx.x, wid = __builtin_amdgcn_readfirstlane(tid >> 6), lane = tid & 63, wr = wid >> 2, wc = wid & 3, fr = lane & 15, fq = lane >> 4;
    int K_ = g.K; asm volatile("" : "+s"(K_));
    const int K = K_, nt = K / BK;
    unsigned voffA[2], voffB[2];
#pragma unroll
    for (int i = 0; i < 2; ++i) { int R, C; stage_rc(tid * 16 + i * 8192, R, C); const int Rb = Epi::PERM ? ((R & ~31) + perm32(R & 31)) : R;
        voffA[i] = (unsigned)(R * K + C) * 2u; voffB[i] = (unsigned)(Rb * K + C) * 2u; }
    const size_t kstep = (size_t)(BK * 2);
    const size_t hstep = (size_t)HALF * K * 2;
    const size_t tstep = 2 * hstep;
    const unsigned ldsw = (unsigned)wid * 1024u;
    const int aoff = lds_byte(wr * 64 + fr, fq * 8), boff = lds_byte(wc * 32 + fr, fq * 8);
#define PG8_SA(b, h) (((b) * 2 + (h)) * HTB)
#define PG8_SB(b, h) ((4 + (b) * 2 + (h)) * HTB)
#define PG8_STAGE(bufoff, gbase, voff) do { _Pragma("unroll") for (int _i = 0; _i < 2; ++_i) \
        __builtin_amdgcn_global_load_lds((const unsigned*)((const char*)(gbase) + (voff)[_i]), (PG8_LAS unsigned*)(lds + (bufoff) + ldsw + _i * 8192), 16, 0, 0); } while (0)
#define PG8_LDA(dst, b, h) do { _Pragma("unroll") for (int m = 0; m < 4; ++m) _Pragma("unroll") for (int k = 0; k < 2; ++k) dst[m][k] = *(const PG8_LAS bf16x8*)(lds + PG8_SA(b, h) + aoff + m * 2048 + k * 1024); } while (0)
#define PG8_LDB(dst, b, h) do { _Pragma("unroll") for (int n = 0; n < 2; ++n) _Pragma("unroll") for (int k = 0; k < 2; ++k) dst[n][k] = *(const PG8_LAS bf16x8*)(lds + PG8_SB(b, h) + boff + n * 2048 + k * 1024); } while (0)
#define PG8_MMA(ai, bj, At, Bt) do { __builtin_amdgcn_s_setprio(1); _Pragma("unroll") for (int m = 0; m < 4; ++m) _Pragma("unroll") for (int n = 0; n < 2; ++n) _Pragma("unroll") for (int k = 0; k < 2; ++k) \
        acc[ai][bj][m][n] = __builtin_amdgcn_mfma_f32_16x16x32_bf16(Bt[n][k], At[m][k], acc[ai][bj][m][n], 0, 0, 0); __builtin_amdgcn_s_setprio(0); } while (0)
#define PG8_WAIT_V(n) asm volatile("s_waitcnt vmcnt(" #n ")" ::: "memory")
#define PG8_WAIT_L(n) asm volatile("s_waitcnt lgkmcnt(" #n ")" ::: "memory")
#define PG8_BAR __builtin_amdgcn_s_barrier()
#define PG8_SCHED __builtin_amdgcn_sched_barrier(0)
    Unit cur, nxt; int ui = 0;
    if (!S.next(0, cur)) return;
    f32x4 acc[2][2][4][2];
#pragma unroll
    for (int a = 0; a < 2; ++a)
#pragma unroll
        for (int b = 0; b < 2; ++b)
#pragma unroll
            for (int m = 0; m < 4; ++m)
#pragma unroll
                for (int n = 0; n < 2; ++n) acc[a][b][m][n] = (f32x4){0.f, 0.f, 0.f, 0.f};
    bf16x8 At[4][2], B0[2][2], B1[2][2];
    const char* cA = (const char*)g.A + (size_t)cur.pm * tstep; const char* cB = (const char*)g.Bt + (size_t)cur.pn * tstep;
    S.a_ready(cur);
    if constexpr (SP2) {
        PG8_STAGE(PG8_SB(0, 0), cB, voffB); PG8_STAGE(PG8_SB(0, 1), cB + hstep, voffB); PG8_STAGE(PG8_SA(0, 0), cA, voffA); PG8_STAGE(PG8_SA(0, 1), cA + hstep, voffA);
        if (wr == 1) PG8_BAR;
        PG8_WAIT_V(2); PG8_BAR;
        PG8_STAGE(PG8_SB(1, 0), cB + kstep, voffB); PG8_STAGE(PG8_SA(1, 0), cA + kstep, voffA); PG8_STAGE(PG8_SB(1, 1), cB + hstep + kstep, voffB);
        PG8_WAIT_V(6); PG8_BAR;
    } else {
        PG8_STAGE(PG8_SB(0, 0), cB, voffB); PG8_STAGE(PG8_SA(0, 0), cA, voffA); PG8_STAGE(PG8_SB(0, 1), cB + hstep, voffB); PG8_STAGE(PG8_SA(0, 1), cA + hstep, voffA);
        if (wr == 1) PG8_BAR;
        PG8_WAIT_V(4); PG8_BAR;
        PG8_STAGE(PG8_SB(1, 0), cB + kstep, voffB); PG8_STAGE(PG8_SA(1, 0), cA + kstep, voffA); PG8_STAGE(PG8_SB(1, 1), cB + hstep + kstep, voffB);
        PG8_WAIT_V(6); PG8_BAR;
    }
    for (;;) {
        const bool has_next = S.next(ui + 1, nxt);
        const char* nA = has_next ? (const char*)g.A + (size_t)nxt.pm * tstep : cA; const char* nB = has_next ? (const char*)g.Bt + (size_t)nxt.pn * tstep : cB;
        for (int t = 0; t < nt; t += 2) {
            const bool last = (t == nt - 2);
            const char* a1 = cA + (size_t)(t + 1) * kstep;
            const char* a2 = last ? nA : cA + (size_t)(t + 2) * kstep; const char* b2 = last ? nB : cB + (size_t)(t + 2) * kstep;
            const char* a3 = a2 + kstep; const char* b3 = b2 + kstep;
            if (last && has_next) S.a_ready(nxt);
            if constexpr (SP2) {
            PG8_LDB(B0, 0, 0); PG8_LDB(B1, 0, 1); PG8_SCHED; PG8_LDA(At, 0, 0); PG8_STAGE(PG8_SA(1, 1), a1 + hstep, voffA);
            PG8_WAIT_V(8); PG8_WAIT_L(0); PG8_BAR; PG8_MMA(0, 0, At, B0); PG8_MMA(0, 1, At, B1); PG8_BAR; PG8_SCHED;
            PG8_LDA(At, 0, 1); PG8_STAGE(PG8_SB(0, 0), b2, voffB); PG8_STAGE(PG8_SB(0, 1), b2 + hstep, voffB); PG8_STAGE(PG8_SA(0, 0), a2, voffA);
            PG8_WAIT_V(8); PG8_WAIT_L(0); PG8_BAR; PG8_MMA(1, 0, At, B0); PG8_MMA(1, 1, At, B1); PG8_BAR; PG8_SCHED;
            PG8_LDB(B0, 1, 0); PG8_LDB(B1, 1, 1); PG8_SCHED; PG8_LDA(At, 1, 0); PG8_STAGE(PG8_SA(0, 1), a2 + hstep, voffA);
            PG8_WAIT_V(8); PG8_WAIT_L(0); PG8_BAR; PG8_MMA(0, 0, At, B0); PG8_MMA(0, 1, At, B1); PG8_BAR; PG8_SCHED;
            PG8_LDA(At, 1, 1); PG8_STAGE(PG8_SB(1, 0), b3, voffB); PG8_STAGE(PG8_SB(1, 1), b3 + hstep, voffB); PG8_STAGE(PG8_SA(1, 0), a3, voffA);
            PG8_WAIT_V(8); PG8_WAIT_L(0); PG8_BAR; PG8_MMA(1, 0, At, B0); PG8_MMA(1, 1, At, B1); PG8_BAR; PG8_SCHED;
            } else {
            PG8_LDB(B0, 0, 0); PG8_SCHED; PG8_LDA(At, 0, 0); PG8_STAGE(PG8_SA(1, 1), a1 + hstep, voffA);
            PG8_WAIT_L(8); PG8_BAR; PG8_WAIT_L(0); PG8_MMA(0, 0, At, B0); PG8_BAR; PG8_SCHED;
            PG8_LDB(B1, 0, 1); PG8_STAGE(PG8_SB(0, 0), b2, voffB);
            PG8_BAR; PG8_WAIT_L(0); PG8_MMA(0, 1, At, B1); PG8_BAR;
            PG8_LDA(At, 0, 1); PG8_STAGE(PG8_SA(0, 0), a2, voffA);
            PG8_BAR; PG8_WAIT_L(0); PG8_MMA(1, 0, At, B0); PG8_BAR; PG8_SCHED;
            PG8_STAGE(PG8_SB(0, 1), b2 + hstep, voffB);
            PG8_WAIT_V(6); PG8_BAR; PG8_MMA(1, 1, At, B1); PG8_BAR;
            PG8_LDB(B0, 1, 0); PG8_SCHED; PG8_LDA(At, 1, 0); PG8_STAGE(PG8_SA(0, 1), a2 + hstep, voffA);
            PG8_WAIT_L(8); PG8_BAR; PG8_WAIT_L(0); PG8_MMA(0, 0, At, B0); PG8_BAR; PG8_SCHED;
            PG8_LDB(B1, 1, 1); PG8_STAGE(PG8_SB(1, 0), b3, voffB);
            PG8_BAR; PG8_WAIT_L(0); PG8_MMA(0, 1, At, B1); PG8_BAR;
            PG8_LDA(At, 1, 1); PG8_STAGE(PG8_SA(1, 0), a3, voffA);
            PG8_BAR; PG8_WAIT_L(0); PG8_MMA(1, 0, At, B0); PG8_BAR; PG8_SCHED;
            PG8_STAGE(PG8_SB(1, 1), b3 + hstep, voffB);
            PG8_WAIT_V(6); PG8_BAR; PG8_MMA(1, 1, At, B1); PG8_BAR;
            }
        }
        if constexpr (ALIGN_EPI) { if (wr == 0) PG8_BAR; }
        if constexpr (!Epi::AFTER_DRAIN) { if (cur.kind & 0x100) E.mid(acc, cur, wr, wc, fr, fq); else E(acc, cur, wr, wc, fr, fq); S.done(cur); }
        if (!has_next) break;
        {
#pragma unroll
        for (int a = 0; a < 2; ++a)
#pragma unroll
            for (int b = 0; b < 2; ++b)
#pragma unroll
                for (int m = 0; m < 4; ++m)
#pragma unroll
                    for (int n = 0; n < 2; ++n) acc[a][b][m][n] = (f32x4){0.f, 0.f, 0.f, 0.f};
        }
        cur = nxt; cA = nA; cB = nB; ++ui;
        if constexpr (ALIGN_EPI) { if (wr == 1) PG8_BAR; }
    }
    PG8_WAIT_V(0);
    if constexpr (!ALIGN_EPI) { if (wr == 0) PG8_BAR; }
    PG8_BAR;
    if constexpr (Epi::AFTER_DRAIN) { E.fused(acc, cur, wr, wc, fr, fq, lds, wid, lane); S.done(cur); }
#undef PG8_SA
#undef PG8_SB
#undef PG8_STAGE
#undef PG8_LDA
#undef PG8_LDB
#undef PG8_MMA
#undef PG8_WAIT_V
#undef PG8_WAIT_L
#undef PG8_BAR
#undef PG8_SCHED
}
}

#define LAS __attribute__((address_space(3)))
typedef unsigned short bf16;
typedef float f32x4 __attribute__((ext_vector_type(4)));
typedef float f32x2 __attribute__((ext_vector_type(2)));
typedef float f32x16 __attribute__((ext_vector_type(16)));
typedef short bf16x8 __attribute__((ext_vector_type(8)));
typedef short s16x4 __attribute__((ext_vector_type(4)));
typedef unsigned u32x4 __attribute__((ext_vector_type(4)));
typedef unsigned u32x2 __attribute__((ext_vector_type(2)));
typedef __bf16 bf16x2_t __attribute__((ext_vector_type(2)));

constexpr int DM = 1024, SEQ = 4096, NB = 8, M = NB * SEQ, FF = 4096;
constexpr int NWAVES = 8;
constexpr float EPS = 1e-6f, LOG2E = 1.4426950408889634f;
constexpr float C2_MLA = 0.10206207261596575f * LOG2E;
constexpr float C2_SWA = 0.125f * LOG2E;
constexpr int N_IN_PAD = 3840;

constexpr size_t MiB = 1u << 20;
constexpr size_t WS_TAB = 1 * MiB, WS_PQ = 2 * MiB, WS_PKV = 2 * MiB + 512 * 1024, WS_PT = 3 * MiB, WS_PE = 5 * MiB, WS_RSTDE = 7 * MiB;
constexpr size_t WS_WIN = 8 * MiB, WS_WQKV = 16 * MiB, WS_WPP = 18 * MiB, WS_WUP = 19 * MiB, WS_WOUT = 23 * MiB, WS_W1 = 25 * MiB, WS_W2 = 33 * MiB, WS_WPG = 41 * MiB;
constexpr size_t WS_XN = 48 * MiB, WS_QA = 112 * MiB, WS_KVR = 128 * MiB, WS_KS = 144 * MiB, WS_VS = 152 * MiB, WS_KROPE = 160 * MiB, WS_ERAW = 112 * MiB;
constexpr size_t WS_T = 176 * MiB, WS_QR = 176 * MiB, WS_PB = 240 * MiB;
constexpr size_t WS_QN = 256 * MiB, WS_QS = 320 * MiB, WS_KN = 384 * MiB, WS_VM = 448 * MiB, WS_U = 256 * MiB, WS_END = 512 * MiB;

constexpr int LDS_BYTES = 132 * 1024;

struct Params { const float* in[20]; float* out; unsigned char* ws; int ph_lo, ph_hi; };

__device__ __forceinline__ unsigned cvtpk(float lo, float hi) { f32x2 v = {lo, hi}; bf16x2_t b = __builtin_convertvector(v, bf16x2_t); return __builtin_bit_cast(unsigned, b); }
__device__ __forceinline__ u32x2 pack4(f32x4 v) { u32x2 r; r.x = cvtpk(v[0], v[1]); r.y = cvtpk(v[2], v[3]); return r; }
__device__ __forceinline__ float bf2f(unsigned short h) { return __builtin_bit_cast(float, (unsigned)h << 16); }
__device__ __forceinline__ f32x4 unpack4(u32x2 w) { f32x4 r; r[0] = __builtin_bit_cast(float, w.x << 16); r[1] = __builtin_bit_cast(float, w.x & 0xffff0000u); r[2] = __builtin_bit_cast(float, w.y << 16); r[3] = __builtin_bit_cast(float, w.y & 0xffff0000u); return r; }
__device__ __forceinline__ float sigmoidf_(float x) { return __builtin_amdgcn_rcpf(1.0f + __builtin_amdgcn_exp2f(-x * LOG2E)); }
__device__ __forceinline__ f32x4 sigmoid4(f32x4 v) { f32x4 r; r[0] = sigmoidf_(v[0]); r[1] = sigmoidf_(v[1]); r[2] = sigmoidf_(v[2]); r[3] = sigmoidf_(v[3]); return r; }
__device__ __forceinline__ float wave_sum(float v) {
#pragma unroll
    for (int o = 1; o < 64; o <<= 1) v += __shfl_xor(v, o);
    return v;
}
__device__ __forceinline__ float dot4(f32x4 v) { return (v[0] * v[0] + v[1] * v[1]) + (v[2] * v[2] + v[3] * v[3]); }

struct Sched {
    int G, c, nseg, pairs;
    int nN[2], pmo[2], pno[2], start[3];
    __device__ __forceinline__ bool next(int i, pg8::Unit& u) const {
        const int ii = pairs ? (i >> 1) : i;
        const long L = (long)ii * G + c; if (L >= start[nseg]) return false;
        const int s = (nseg > 1 && L >= start[1]) ? 1 : 0; const int l = (int)L - start[s];
        const int nwg = start[s + 1] - start[s], q = nwg >> 3, id = (l & 7) * q + (l >> 3);
        const int nig = 8 * nN[s], gid = id / nig, r = id % nig;
        const int pm = gid * 8 + (r & 7), pn = r >> 3;
        u.pm = pmo[s] + pm; u.pn = pno[s] + pn; u.kind = u.pn;
        if (pairs) { if (i & 1) { u.pm += 128; u.pn += 4; u.kind = 0; } else u.kind = 0x100; }
        return true;
    }
    __device__ __forceinline__ void a_ready(const pg8::Unit&) const {}
    __device__ __forceinline__ void done(const pg8::Unit&) const {}
};
__device__ __forceinline__ Sched make_sched(int G, int c, int nN0) { Sched s; s.G = G; s.c = c; s.nseg = 1; s.pairs = 0; s.nN[0] = nN0; s.nN[1] = 1; s.pmo[0] = s.pmo[1] = 0; s.pno[0] = s.pno[1] = 0; s.start[0] = 0; s.start[1] = 128 * nN0; s.start[2] = s.start[1]; return s; }

typedef pg8::f32x4 A4;
#define EPI_ROWS(ai, m) for (int ai = 0; ai < 2; ++ai) _Pragma("unroll") for (int m = 0; m < 4; ++m)

struct EpiP1 {
    static constexpr bool PERM = false, AFTER_DRAIN = false;
    bf16 *qa, *kvr, *krope, *qs, *ks, *vs, *gates; float *part_q, *part_kv; const f32x2* tab;
    __device__ __forceinline__ void mid(const A4 (&acc)[2][2][4][2], const pg8::Unit& u, int wr, int wc, int fr, int fq) const {}
    __device__ __forceinline__ void operator()(const A4 (&acc)[2][2][4][2], const pg8::Unit& u, int wr, int wc, int fr, int fq) const {
        const int pn = u.kind, row0 = u.pm * 256 + wr * 64 + fr, cl0 = wc * 32 + fq * 4;
        if (pn <= 1) {
            bf16* dst = pn == 0 ? qa : kvr; float* part = pn == 0 ? part_q : part_kv;
#pragma unroll
            EPI_ROWS(ai, m) { const int row = row0 + ai * 128 + m * 16; float ss = 0.f;
#pragma unroll
                for (int bj = 0; bj < 2; ++bj)
#pragma unroll
                    for (int n = 0; n < 2; ++n) { const A4 v = acc[ai][bj][m][n]; if (pn == 0 || bj == 0) ss += dot4(v);
                        *(u32x2*)(dst + (size_t)row * 256 + bj * 128 + cl0 + n * 16) = pack4(v); }
                ss += __shfl_xor(ss, 16); ss += __shfl_xor(ss, 32);
                if (fq == 0) part[(size_t)row * 4 + wc] = ss;
                if (pn == 1 && wc == 0) {
                    const int pos = row & (SEQ - 1); const A4 x1 = acc[ai][1][m][0], x2 = acc[ai][1][m][1]; A4 o1, o2;
#pragma unroll
                    for (int e = 0; e < 4; ++e) { const f32x2 cs = tab[pos * 32 + 2 * (4 * fq + e)]; o1[e] = x1[e] * cs.x - x2[e] * cs.y; o2[e] = x2[e] * cs.x + x1[e] * cs.y; }
                    *(u32x2*)(krope + (size_t)row * 32 + 4 * fq) = pack4(o1); *(u32x2*)(krope + (size_t)row * 32 + 16 + 4 * fq) = pack4(o2);
                }
            }
        } else if (pn <= 6) {
            const int d1 = 16 * (wc & 1) + 4 * fq;
#pragma unroll
            EPI_ROWS(ai, m) { const int row = row0 + ai * 128 + m * 16; const int pos = row & (SEQ - 1);
                const f32x4 t0 = *(const f32x4*)(tab + pos * 32 + d1), t1 = *(const f32x4*)(tab + pos * 32 + d1 + 2);
                const float cc[4] = {t0[0], t0[2], t1[0], t1[2]}, sn[4] = {t0[1], t0[3], t1[1], t1[3]};
#pragma unroll
                for (int bj = 0; bj < 2; ++bj) {
                    if (pn == 6 && bj == 1) {
#pragma unroll
                        for (int n = 0; n < 2; ++n) *(u32x2*)(vs + (size_t)row * 128 + cl0 + n * 16) = pack4(acc[ai][1][m][n]);
                    } else {
                        const A4 x1 = acc[ai][bj][m][0], x2 = acc[ai][bj][m][1]; A4 o1, o2; const float sc = pn == 6 ? 1.0f : C2_SWA;
#pragma unroll
                        for (int e = 0; e < 4; ++e) { o1[e] = (x1[e] * cc[e] - x2[e] * sn[e]) * sc; o2[e] = (x2[e] * cc[e] + x1[e] * sn[e]) * sc; }
                        bf16* d = pn == 6 ? ks + (size_t)row * 128 + (wc >> 1) * 64 : qs + (size_t)row * 1024 + ((pn - 2) * 4 + bj * 2 + (wc >> 1)) * 64;
                        *(u32x2*)(d + d1) = pack4(o1); *(u32x2*)(d + 32 + d1) = pack4(o2);
                    }
                }
            }
        } else {
#pragma unroll
            EPI_ROWS(ai, m) { const int row = row0 + ai * 128 + m * 16;
#pragma unroll
                for (int bj = 0; bj < 2; ++bj)
#pragma unroll
                    for (int n = 0; n < 2; ++n) *(u32x2*)(gates + (size_t)row * 2048 + (pn - 7) * 256 + bj * 128 + cl0 + n * 16) = pack4(sigmoid4(acc[ai][bj][m][n]));
            }
        }
    }
};

struct EpiP2 {
    static constexpr bool PERM = false, AFTER_DRAIN = false;
    bf16 *qn, *qr, *kn, *vm; const float *part_q, *part_kv; const f32x2* tab;
    __device__ __forceinline__ void mid(const A4 (&acc)[2][2][4][2], const pg8::Unit& u, int wr, int wc, int fr, int fq) const {}
    __device__ __forceinline__ void operator()(const A4 (&acc)[2][2][4][2], const pg8::Unit& u, int wr, int wc, int fr, int fq) const {
        const int pn = u.kind, row0 = (u.pm & 127) * 256 + wr * 64 + fr, cl0 = wc * 32 + fq * 4;
        const bool isq = pn < 6; const float* part = isq ? part_q : part_kv; const float invn = isq ? (1.0f / 256.0f) : (1.0f / 128.0f);
#pragma unroll
        EPI_ROWS(ai, m) { const int row = row0 + ai * 128 + m * 16;
            const f32x4 pp = *(const f32x4*)(part + (size_t)row * 4);
            float rs = __builtin_amdgcn_rsqf(((pp[0] + pp[1]) + (pp[2] + pp[3])) * invn + EPS);
            if (isq) rs *= C2_MLA;
            if (pn == 4 || pn == 5) {
                const int pos = row & (SEQ - 1);
                float cc[4], sn[4];
#pragma unroll
                for (int e = 0; e < 4; ++e) { const f32x2 cs = tab[pos * 32 + 2 * (4 * fq + e)]; cc[e] = cs.x; sn[e] = cs.y; }
#pragma unroll
                for (int bj = 0; bj < 2; ++bj) { const A4 x1 = acc[ai][bj][m][0], x2 = acc[ai][bj][m][1]; A4 o1, o2;
#pragma unroll
                    for (int e = 0; e < 4; ++e) { o1[e] = (x1[e] * cc[e] - x2[e] * sn[e]) * rs; o2[e] = (x2[e] * cc[e] + x1[e] * sn[e]) * rs; }
                    bf16* d = qr + (size_t)row * 512 + ((pn - 4) * 8 + bj * 4 + wc) * 32;
                    *(u32x2*)(d + 4 * fq) = pack4(o1); *(u32x2*)(d + 16 + 4 * fq) = pack4(o2); }
            } else {
                bf16* d = pn < 4 ? qn + (size_t)row * 1024 + pn * 256 : (pn < 10 ? kn + (size_t)row * 1024 + (pn - 6) * 256 : vm + (size_t)row * 1024 + (pn - 10) * 256);
#pragma unroll
                for (int bj = 0; bj < 2; ++bj)
#pragma unroll
                    for (int n = 0; n < 2; ++n) *(u32x2*)(d + bj * 128 + cl0 + n * 16) = pack4(acc[ai][bj][m][n] * rs);
            }
            asm volatile("" ::: "memory");
        }
    }
};

struct EpiP4 {
    static constexpr bool PERM = false, AFTER_DRAIN = false;
    const bf16* gates; bf16* y; float* ya;
    __device__ __forceinline__ void mid(const A4 (&acc)[2][2][4][2], const pg8::Unit& u, int wr, int wc, int fr, int fq) const {
        const int row0 = u.pm * 256 + wr * 64 + fr, col0 = u.pn * 256 + wc * 32 + fq * 4;
#pragma unroll
        EPI_ROWS(ai, m) { const size_t row = (size_t)(row0 + ai * 128 + m * 16); const bf16* g = gates + row * 2048 + col0;
#pragma unroll
            for (int bj = 0; bj < 2; ++bj)
#pragma unroll
                for (int n = 0; n < 2; ++n) { const f32x4 ga = unpack4(*(const u32x2*)(g + bj * 128 + n * 16));
                    *(f32x4*)(ya + row * 1024 + col0 + bj * 128 + n * 16) = acc[ai][bj][m][n] * ga; }
            asm volatile("" ::: "memory");
        }
    }
    __device__ __forceinline__ void operator()(const A4 (&acc)[2][2][4][2], const pg8::Unit& u, int wr, int wc, int fr, int fq) const {
        const int row0 = (u.pm - 128) * 256 + wr * 64 + fr, col0 = (u.pn - 4) * 256 + wc * 32 + fq * 4;
#pragma unroll
        EPI_ROWS(ai, m) { const size_t row = (size_t)(row0 + ai * 128 + m * 16); const bf16* g = gates + row * 2048 + 1024 + col0;
#pragma unroll
            for (int bj = 0; bj < 2; ++bj)
#pragma unroll
                for (int n = 0; n < 2; ++n) { const f32x4 gb = unpack4(*(const u32x2*)(g + bj * 128 + n * 16)); const f32x4 pa = *(const f32x4*)(ya + row * 1024 + col0 + bj * 128 + n * 16);
                    *(u32x2*)(y + row * 1024 + col0 + bj * 128 + n * 16) = pack4(pa + acc[ai][bj][m][n] * gb); }
            asm volatile("" ::: "memory");
        }
    }
};

struct EpiT {
    static constexpr bool PERM = false, AFTER_DRAIN = false;
    bf16* o; float* part;
    __device__ __forceinline__ void mid(const A4 (&acc)[2][2][4][2], const pg8::Unit& u, int wr, int wc, int fr, int fq) const {}
    __device__ __forceinline__ void operator()(const A4 (&acc)[2][2][4][2], const pg8::Unit& u, int wr, int wc, int fr, int fq) const {
        const int row0 = u.pm * 256 + wr * 64 + fr, col0 = u.pn * 256 + wc * 32 + fq * 4;
#pragma unroll
        EPI_ROWS(ai, m) { const size_t row = (size_t)(row0 + ai * 128 + m * 16); float ss = 0.f;
#pragma unroll
            for (int bj = 0; bj < 2; ++bj)
#pragma unroll
                for (int n = 0; n < 2; ++n) { const A4 v = acc[ai][bj][m][n]; ss += dot4(v); *(u32x2*)(o + row * 1024 + col0 + bj * 128 + n * 16) = pack4(v); }
            ss += __shfl_xor(ss, 16); ss += __shfl_xor(ss, 32);
            if (fq == 0) part[row * 16 + u.pn * 4 + wc] = ss;
        }
    }
};

struct EpiRelu2 {
    static constexpr bool PERM = false, AFTER_DRAIN = false;
    bf16* o;
    __device__ __forceinline__ void mid(const A4 (&acc)[2][2][4][2], const pg8::Unit& u, int wr, int wc, int fr, int fq) const {}
    __device__ __forceinline__ void operator()(const A4 (&acc)[2][2][4][2], const pg8::Unit& u, int wr, int wc, int fr, int fq) const {
        const int row0 = u.pm * 256 + wr * 64 + fr, col0 = u.pn * 256 + wc * 32 + fq * 4;
#pragma unroll
        EPI_ROWS(ai, m) { const size_t row = (size_t)(row0 + ai * 128 + m * 16);
#pragma unroll
            for (int bj = 0; bj < 2; ++bj)
#pragma unroll
                for (int n = 0; n < 2; ++n) { A4 v = acc[ai][bj][m][n];
#pragma unroll
                    for (int e = 0; e < 4; ++e) { const float r = __builtin_fmaxf(v[e], 0.f); v[e] = r * r; }
                    *(u32x2*)(o + row * FF + col0 + bj * 128 + n * 16) = pack4(v); }
        }
    }
};

struct EpiOut {
    static constexpr bool PERM = false, AFTER_DRAIN = false;
    float* out; const bf16* eraw; const float* rstd_e; const float* gple;
    __device__ __forceinline__ void mid(const A4 (&acc)[2][2][4][2], const pg8::Unit& u, int wr, int wc, int fr, int fq) const {}
    __device__ __forceinline__ void operator()(const A4 (&acc)[2][2][4][2], const pg8::Unit& u, int wr, int wc, int fr, int fq) const {
        const int row0 = u.pm * 256 + wr * 64 + fr, col0 = u.pn * 256 + wc * 32 + fq * 4;
        f32x4 gv[2][2];
#pragma unroll
        for (int bj = 0; bj < 2; ++bj)
#pragma unroll
            for (int n = 0; n < 2; ++n) gv[bj][n] = *(const f32x4*)(gple + col0 + bj * 128 + n * 16);
#pragma unroll
        EPI_ROWS(ai, m) { const size_t row = (size_t)(row0 + ai * 128 + m * 16); const float rs = rstd_e[row];
#pragma unroll
            for (int bj = 0; bj < 2; ++bj)
#pragma unroll
                for (int n = 0; n < 2; ++n) { const size_t off = row * 1024 + col0 + bj * 128 + n * 16;
                    const f32x4 x2 = *(const f32x4*)(out + off), ev = unpack4(*(const u32x2*)(eraw + off));
                    *(f32x4*)(out + off) = x2 + sigmoid4(acc[ai][bj][m][n]) * (ev * rs * gv[bj][n]); }
        }
    }
};

namespace att {
constexpr int KP = 208, VP = 192, KBUF = 64 * KP, VBUF = 64 * VP, STAGE = KBUF + VBUF;
__device__ __forceinline__ float xhalf_max(float v) { auto rr = __builtin_amdgcn_permlane32_swap(__float_as_uint(v), __float_as_uint(v), false, false); return __builtin_fmaxf(__uint_as_float(rr[0]), __uint_as_float(rr[1])); }
__device__ __forceinline__ float xhalf_sum(float v) { auto rr = __builtin_amdgcn_permlane32_swap(__float_as_uint(v), __float_as_uint(v), false, false); return __uint_as_float(rr[0]) + __uint_as_float(rr[1]); }
__device__ __forceinline__ s16x4 vtr(const LAS unsigned char* p) { return __builtin_bit_cast(s16x4, __builtin_amdgcn_ds_read_tr16_b64_v4i16((LAS s16x4*)p)); }

template <int MODE>
__device__ __forceinline__ void unit(LAS unsigned char* lds, const bf16* __restrict__ Qa, const bf16* __restrict__ Qb, const bf16* __restrict__ Ka, const bf16* __restrict__ Kb, const bf16* __restrict__ Va, bf16* O,
                                     const float* __restrict__ sinks, int b, int h, int blk, int hp) {
    constexpr int NC = MODE == 0 ? 6 : 4;
    const int tid = threadIdx.x, lane = tid & 63, w = __builtin_amdgcn_readfirstlane(tid >> 6), l31 = lane & 31, hi = lane >> 5;
    int hq, qpos0w, t_beg, t_end, kpos_base; size_t krow_base; int kvpitch, kvcol;
    if (MODE == 0) { hq = h; qpos0w = blk * 256 + w * 32; t_beg = 0; t_end = 4 * blk + 4; kpos_base = 0; kvpitch = 1024; kvcol = h * 64; }
    else { hq = 8 * h + 2 * hp + (w >> 2); qpos0w = blk * 128 + (w & 3) * 32; t_beg = blk == 0 ? 2 : 0; t_end = 4; kpos_base = (blk - 1) * 128; kvpitch = 128; kvcol = h * 64; }
    const size_t seq0 = (size_t)b * SEQ;
    const int qpos = qpos0w + l31;
    bf16x8 qf[NC];
    { const bf16* qp = Qa + (seq0 + qpos) * 1024 + hq * 64 + hi * 8;
#pragma unroll
      for (int c = 0; c < 4; ++c) qf[c] = *(const bf16x8*)(qp + c * 16);
      if (MODE == 0) { const bf16* qp2 = Qb + (seq0 + qpos) * 512 + hq * 32 + hi * 8;
#pragma unroll
          for (int c = 4; c < NC; ++c) qf[c] = *(const bf16x8*)(qp2 + (c - 4) * 16); } }
    const int skey = tid >> 3, sch = tid & 7;
    const bf16* kg = Ka + ((long)seq0 + kpos_base + skey) * kvpitch + kvcol + sch * 8;
    const bf16* vg = Va + ((long)seq0 + kpos_base + skey) * kvpitch + kvcol + sch * 8;
    const bf16* rg = MODE == 0 ? Kb + (seq0 + (tid >> 2)) * 32 + (tid & 3) * 8 : nullptr;
    const int kw_off = skey * KP + sch * 16, vw_off = KBUF + skey * VP + sch * 16, rw_off = (tid >> 2) * KP + 128 + (tid & 3) * 16;
    const int pi = (l31 & 0x13) | ((l31 & 4) << 1) | ((l31 & 8) >> 1);
    const int kr_off = pi * KP + hi * 16;
    const int vr_off = KBUF + (8 * hi + ((lane & 15) >> 2)) * VP + (16 * ((lane >> 4) & 1) + 4 * (lane & 3)) * 2;
    float m_run, l_run;
    if (MODE == 0) { m_run = -1e30f; l_run = 0.f; } else { m_run = sinks[hq] * LOG2E; l_run = hi == 0 ? 1.f : 0.f; }
    f32x16 o0 = {}, o1 = {};
    u32x4 kreg, vreg, rreg = {};
    kreg = *(const u32x4*)(kg + (long)t_beg * 64 * kvpitch); vreg = *(const u32x4*)(vg + (long)t_beg * 64 * kvpitch);
    if (MODE == 0 && tid < 256) rreg = *(const u32x4*)(rg + (size_t)t_beg * 64 * 32);
    *(LAS u32x4*)(lds + kw_off) = kreg; *(LAS u32x4*)(lds + vw_off) = vreg;
    if (MODE == 0 && tid < 256) *(LAS u32x4*)(lds + rw_off) = rreg;
    __syncthreads();
    for (int t = t_beg; t < t_end; ++t) {
        const int st = ((t - t_beg) & 1) * STAGE, sn = STAGE - st;
        const bool more = t + 1 < t_end;
        if (more) { kreg = *(const u32x4*)(kg + (long)(t + 1) * 64 * kvpitch); vreg = *(const u32x4*)(vg + (long)(t + 1) * 64 * kvpitch);
            if (MODE == 0 && tid < 256) rreg = *(const u32x4*)(rg + (size_t)(t + 1) * 64 * 32); }
        const int kp0 = kpos_base + t * 64;
        bool doit, domask;
        if (MODE == 0) { doit = kp0 <= qpos0w + 31; domask = kp0 + 63 > qpos0w; }
        else { const int a = w & 3; doit = a < 2 ? (t <= 2) : (t >= 1); domask = true; }
        if (doit) {
            const LAS unsigned char* kb = lds + st + kr_off; const LAS unsigned char* vb = lds + st + vr_off;
            f32x16 s0 = {}, s1 = {};
#pragma unroll
            for (int c = 0; c < NC; ++c) { const bf16x8 k0 = *(const LAS bf16x8*)(kb + c * 32), k1 = *(const LAS bf16x8*)(kb + 32 * KP + c * 32);
                s0 = __builtin_amdgcn_mfma_f32_32x32x16_bf16(k0, qf[c], s0, 0, 0, 0); s1 = __builtin_amdgcn_mfma_f32_32x32x16_bf16(k1, qf[c], s1, 0, 0, 0); }
            if (domask) {
#pragma unroll
                for (int r = 0; r < 16; ++r) { const int kk = kp0 + 16 * (r >> 3) + 8 * hi + (r & 7); const int rel0 = qpos - kk, rel1 = rel0 - 32;
                    const bool ok0 = MODE == 0 ? rel0 >= 0 : (rel0 >= 0 && rel0 < 128), ok1 = MODE == 0 ? rel1 >= 0 : (rel1 >= 0 && rel1 < 128);
                    s0[r] = ok0 ? s0[r] : -1e30f; s1[r] = ok1 ? s1[r] : -1e30f; }
            }
            float mx = __builtin_fmaxf(s0[0], s1[0]);
#pragma unroll
            for (int r = 1; r < 16; ++r) mx = __builtin_fmaxf(mx, __builtin_fmaxf(s0[r], s1[r]));
            mx = xhalf_max(mx);
            const float mnew = __builtin_fmaxf(m_run, mx), alpha = __builtin_amdgcn_exp2f(m_run - mnew); m_run = mnew;
            float ps = 0.f;
#pragma unroll
            for (int r = 0; r < 16; ++r) { s0[r] = __builtin_amdgcn_exp2f(s0[r] - mnew); s1[r] = __builtin_amdgcn_exp2f(s1[r] - mnew); ps += s0[r] + s1[r]; }
            l_run = l_run * alpha + ps;
#pragma unroll
            for (int r = 0; r < 16; ++r) { o0[r] *= alpha; o1[r] *= alpha; }
            bf16x8 pk[4];
#pragma unroll
            for (int j = 0; j < 2; ++j) { u32x4 a, c2;
                a.x = cvtpk(s0[8 * j], s0[8 * j + 1]); a.y = cvtpk(s0[8 * j + 2], s0[8 * j + 3]); a.z = cvtpk(s0[8 * j + 4], s0[8 * j + 5]); a.w = cvtpk(s0[8 * j + 6], s0[8 * j + 7]);
                c2.x = cvtpk(s1[8 * j], s1[8 * j + 1]); c2.y = cvtpk(s1[8 * j + 2], s1[8 * j + 3]); c2.z = cvtpk(s1[8 * j + 4], s1[8 * j + 5]); c2.w = cvtpk(s1[8 * j + 6], s1[8 * j + 7]);
                pk[j] = __builtin_bit_cast(bf16x8, a); pk[2 + j] = __builtin_bit_cast(bf16x8, c2); }
#pragma unroll
            for (int j = 0; j < 4; ++j) {
                const s16x4 a0 = vtr(vb + (16 * j) * VP), a1 = vtr(vb + (16 * j + 4) * VP), b0 = vtr(vb + (16 * j) * VP + 64), b1 = vtr(vb + (16 * j + 4) * VP + 64);
                const bf16x8 va = {a0[0], a0[1], a0[2], a0[3], a1[0], a1[1], a1[2], a1[3]}, vb8 = {b0[0], b0[1], b0[2], b0[3], b1[0], b1[1], b1[2], b1[3]};
                o0 = __builtin_amdgcn_mfma_f32_32x32x16_bf16(va, pk[j], o0, 0, 0, 0); o1 = __builtin_amdgcn_mfma_f32_32x32x16_bf16(vb8, pk[j], o1, 0, 0, 0);
            }
        }
        if (more) { *(LAS u32x4*)(lds + sn + kw_off) = kreg; *(LAS u32x4*)(lds + sn + vw_off) = vreg;
            if (MODE == 0 && tid < 256) *(LAS u32x4*)(lds + sn + rw_off) = rreg; }
        __syncthreads();
    }
    const float inv = __builtin_amdgcn_rcpf(xhalf_sum(l_run));
    bf16* op = O + (seq0 + qpos) * 1024 + hq * 64 + 4 * hi;
#pragma unroll
    for (int g = 0; g < 4; ++g) { u32x2 w0, w1;
        w0.x = cvtpk(o0[4 * g] * inv, o0[4 * g + 1] * inv); w0.y = cvtpk(o0[4 * g + 2] * inv, o0[4 * g + 3] * inv);
        w1.x = cvtpk(o1[4 * g] * inv, o1[4 * g + 1] * inv); w1.y = cvtpk(o1[4 * g + 2] * inv, o1[4 * g + 3] * inv);
        *(u32x2*)(op + 8 * g) = w0; *(u32x2*)(op + 32 + 8 * g) = w1; }
}
}

__device__ __forceinline__ int swap45(int w) { return (w & 15) | (((w >> 4) & 1) << 5) | (((w >> 5) & 1) << 4); }
__device__ __forceinline__ int src_col(int which, int r) {
    switch (which) {
    case 0:
        if (r < 256) return r;
        if (r < 512) { const int p = r - 256; return p < 160 ? 256 + p : -1; }
        if (r < 1536) { const int p = r - 512; return 416 + (p & ~63) + swap45(p & 63); }
        if (r < 1792) { const int p = r - 1536; return p < 128 ? 1440 + (p & ~63) + swap45(p & 63) : 1568 + (p - 128); }
        return 1696 + (r - 1792);
    case 1:
        if (r < 1024) return (r >> 6) * 96 + (r & 63);
        { const int p = r - 1024; return (p >> 5) * 96 + 64 + (p & 31); }
    case 2:
        if (r < 1024) return (r >> 6) * 128 + (r & 63);
        { const int p = r - 1024; return (p >> 6) * 128 + 64 + (p & 63); }
    default: return r;
    }
}
__device__ __forceinline__ void transpose_item(const float* __restrict__ W, int Ks, int N, bf16* WT, int R, int Kd, int which, const float* __restrict__ gs, LAS float* scr, int item, int lane) {
    const int nblk = R / 32, kb = item / nblk, nb = item % nblk, k0 = 64 * kb, n0 = 32 * nb;
    const int sc = src_col(which, n0 + (lane & 31));
#pragma unroll 8
    for (int i = 0; i < 32; ++i) { const int kk = 2 * i + (lane >> 5), k = k0 + kk; float v = 0.f;
        if (sc >= 0 && k < Ks) { v = W[(size_t)k * N + sc]; if (gs) v *= gs[k]; }
        scr[kk * 33 + (lane & 31)] = v; }
    asm volatile("s_waitcnt lgkmcnt(0)" ::: "memory");
    const int c = lane & 7;
#pragma unroll
    for (int j = 0; j < 4; ++j) { const int n = (lane >> 3) + 8 * j; const LAS float* s = scr + (8 * c) * 33 + n;
        u32x4 o; o.x = cvtpk(s[0 * 33], s[1 * 33]); o.y = cvtpk(s[2 * 33], s[3 * 33]); o.z = cvtpk(s[4 * 33], s[5 * 33]); o.w = cvtpk(s[6 * 33], s[7 * 33]);
        *(u32x4*)(WT + (size_t)(n0 + n) * Kd + k0 + 8 * c) = o; }
    asm volatile("s_waitcnt lgkmcnt(0)" ::: "memory");
}

__global__ void __launch_bounds__(NWAVES * 64, 2) mega_fwd(Params P) {
    extern __shared__ __attribute__((aligned(16))) unsigned char lds_raw[];
    LAS unsigned char* lds = (LAS unsigned char*)lds_raw;
    const int tid = threadIdx.x, lane = tid & 63, wave = __builtin_amdgcn_readfirstlane(tid >> 6);
    const int G = gridDim.x, bx = blockIdx.x, vcu = (G % 8 == 0) ? (bx % 8) * (G / 8) + bx / 8 : bx;
    const int gw = vcu * NWAVES + wave, NGW = G * NWAVES;
    unsigned char* ws = P.ws;
    const int lo = P.ph_lo, hi = P.ph_hi;
#ifndef PH_MASK
#define PH_MASK 0x7ff
#endif
#define IN(k) (((PH_MASK >> (k)) & 1) && lo <= (k) && (k) < hi)
#define SEAM(k) do { if (IN(k) && IN((k) + 1)) cg::this_grid().sync(); } while (0)
    const f32x2* tab = (const f32x2*)(ws + WS_TAB);
    bf16* XN = (bf16*)(ws + WS_XN);
    float* part_q = (float*)(ws + WS_PQ); float* part_kv = (float*)(ws + WS_PKV); float* part_t = (float*)(ws + WS_PT); float* part_e = (float*)(ws + WS_PE); float* rstd_e = (float*)(ws + WS_RSTDE);
    bf16* gates = (bf16*)P.out;

    if (IN(0)) {
        LAS float* scr = (LAS float*)(lds + wave * 16384);
        int it = gw;
#define TR(IN_, KS, N_, R_, KD, WHICH, GSP, OFF) { const int nit = ((KD) / 64) * ((R_) / 32); for (; it < nit; it += NGW) transpose_item(P.in[IN_], KS, N_, (bf16*)(ws + (OFF)), R_, KD, WHICH, GSP, scr, it, lane); it -= nit; }
        TR(3, 1024, 3744, N_IN_PAD, 1024, 0, nullptr, WS_WIN)
        TR(5, 256, 1536, 1536, 256, 1, P.in[4], WS_WQKV)
        TR(7, 128, 2048, 2048, 256, 2, P.in[6], WS_WQKV + (size_t)1536 * 256 * 2)
        TR(17, 256, 1024, 1024, 256, 3, nullptr, WS_WPP)
        TR(9, 1024, 1024, 1024, 1024, 3, nullptr, WS_WUP)
        TR(10, 1024, 1024, 1024, 1024, 3, nullptr, WS_WUP + (size_t)1024 * 1024 * 2)
        TR(11, 1024, 1024, 1024, 1024, 3, nullptr, WS_WOUT)
        TR(14, 1024, 4096, 4096, 1024, 3, nullptr, WS_W1)
        TR(15, 4096, 1024, 1024, 4096, 3, nullptr, WS_W2)
        TR(19, 1024, 1024, 1024, 1024, 3, nullptr, WS_WPG)
#undef TR
        { const float* x = P.in[0]; const float* g = P.in[2];
          for (int row = gw; row < M; row += NGW) {
              const f32x4* xr = (const f32x4*)(x + (size_t)row * DM); f32x4 v[4]; float ss = 0.f;
#pragma unroll
              for (int j = 0; j < 4; ++j) { v[j] = xr[lane + 64 * j]; ss += dot4(v[j]); }
              const float rs = __builtin_amdgcn_rsqf(wave_sum(ss) * (1.0f / DM) + EPS);
#pragma unroll
              for (int j = 0; j < 4; ++j) { const f32x4 gg = ((const f32x4*)g)[lane + 64 * j]; *(u32x2*)(XN + (size_t)row * DM + 4 * (lane + 64 * j)) = pack4(v[j] * rs * gg); }
              const f32x4 pv = ((const f32x4*)(P.in[1] + (size_t)row * 256))[lane];
              *(u32x2*)((bf16*)(ws + WS_PB) + (size_t)row * 256 + 4 * lane) = pack4(pv);
          } }
        for (int i = (vcu * NWAVES + wave) * 64 + lane; i < SEQ * 32; i += NGW * 64) {
            const int pos = i >> 5, j = i & 31; const float inv = expf(-9.210340371976184f * (float)j * (2.0f / 64.0f)); const float ang = (float)pos * inv;
            ((f32x2*)(ws + WS_TAB))[i] = (f32x2){cosf(ang), sinf(ang)}; }
    }
    SEAM(0);
    if (IN(1)) {
        pg8::Gemm g{XN, (const bf16*)(ws + WS_WIN), M, N_IN_PAD, 1024}; Sched S = make_sched(G, bx, 15);
        EpiP1 E{(bf16*)(ws + WS_QA), (bf16*)(ws + WS_KVR), (bf16*)(ws + WS_KROPE), (bf16*)(ws + WS_QS), (bf16*)(ws + WS_KS), (bf16*)(ws + WS_VS), gates, part_q, part_kv, tab};
        pg8::gemm_phase<EpiP1, Sched, true, true>(lds, g, S, E);
    }
    SEAM(1);
    if (IN(2)) {
        pg8::Gemm g{(const bf16*)(ws + WS_QA), (const bf16*)(ws + WS_WQKV), 2 * M, 3584, 256};
        Sched S = make_sched(G, bx, 6); S.nseg = 2; S.nN[1] = 8; S.pmo[1] = 128; S.pno[1] = 6; S.start[1] = 768; S.start[2] = 768 + 1024;
        EpiP2 E{(bf16*)(ws + WS_QN), (bf16*)(ws + WS_QR), (bf16*)(ws + WS_KN), (bf16*)(ws + WS_VM), part_q, part_kv, tab};
        pg8::gemm_phase<EpiP2, Sched, true, true>(lds, g, S, E);
    }
    SEAM(2);
    if (IN(3)) {
        for (int U = vcu; U < 2048; U += G) {
            const int c8 = U & 255, i = U >> 8, bh = c8 >> 1, s = c8 & 1, k = i >> 1, qb = (i & 1) ? 15 - 2 * k - s : 2 * k + s;
            att::unit<0>(lds, (const bf16*)(ws + WS_QN), (const bf16*)(ws + WS_QR), (const bf16*)(ws + WS_KN), (const bf16*)(ws + WS_KROPE), (const bf16*)(ws + WS_VM), (bf16*)(ws + WS_QN), nullptr, bh >> 4, bh & 15, qb, 0);
        }
        for (int U = vcu; U < 2048; U += G) {
            const int hp = U & 3, n = (U >> 2) & 31, g = (U >> 7) & 1, b = U >> 8;
            att::unit<1>(lds, (const bf16*)(ws + WS_QS), nullptr, (const bf16*)(ws + WS_KS), nullptr, (const bf16*)(ws + WS_VS), (bf16*)(ws + WS_QS), P.in[8], b, g, n, hp);
        }
    }
    SEAM(3);
    if (IN(4)) {
        pg8::Gemm g{(const bf16*)(ws + WS_QN), (const bf16*)(ws + WS_WUP), 2 * M, 2048, 1024}; Sched S = make_sched(G, bx, 4); S.pairs = 1;
        EpiP4 E{gates, XN, (float*)(ws + WS_QA)};
        pg8::gemm_phase<EpiP4, Sched, true, true>(lds, g, S, E);
    }
    SEAM(4);
    if (IN(5)) {
        pg8::Gemm g{XN, (const bf16*)(ws + WS_WOUT), M, 1024, 1024}; Sched S = make_sched(G, bx, 4);
        EpiT E{(bf16*)(ws + WS_T), part_t};
        pg8::gemm_phase<EpiT, Sched, true, true>(lds, g, S, E);
    }
    SEAM(5);
#define ROWPASS(FIRST) do { \
        const float* gpost = P.in[(FIRST) ? 12 : 16]; const float* gpre = P.in[13]; const float* xin = (FIRST) ? P.in[0] : P.out; const bf16* T = (const bf16*)(ws + WS_T); \
        for (int row = gw; row < M; row += NGW) { \
            const f32x4* pp = (const f32x4*)(part_t + (size_t)row * 16); const f32x4 p0 = pp[0], p1 = pp[1], p2 = pp[2], p3 = pp[3]; \
            const float tot = ((p0[0] + p0[1]) + (p0[2] + p0[3])) + ((p1[0] + p1[1]) + (p1[2] + p1[3])) + ((p2[0] + p2[1]) + (p2[2] + p2[3])) + ((p3[0] + p3[1]) + (p3[2] + p3[3])); \
            const float rt = __builtin_amdgcn_rsqf(tot * (1.0f / DM) + EPS); \
            f32x4 xv[4]; float ss = 0.f; \
            _Pragma("unroll") for (int j = 0; j < 2; ++j) { const int col = 512 * j + 8 * lane; \
                const u32x4 tw = *(const u32x4*)(T + (size_t)row * DM + col); const f32x4 ta = unpack4((u32x2){tw.x, tw.y}), tb = unpack4((u32x2){tw.z, tw.w}); \
                const f32x4 xa = *(const f32x4*)(xin + (size_t)row * DM + col), xb = *(const f32x4*)(xin + (size_t)row * DM + col + 4); \
                const f32x4 ga = *(const f32x4*)(gpost + col), gb = *(const f32x4*)(gpost + col + 4); \
                xv[2 * j] = xa + ta * rt * ga; xv[2 * j + 1] = xb + tb * rt * gb; ss += dot4(xv[2 * j]) + dot4(xv[2 * j + 1]); \
                *(f32x4*)(P.out + (size_t)row * DM + col) = xv[2 * j]; *(f32x4*)(P.out + (size_t)row * DM + col + 4) = xv[2 * j + 1]; } \
            if (FIRST) { const float r1 = __builtin_amdgcn_rsqf(wave_sum(ss) * (1.0f / DM) + EPS); \
                _Pragma("unroll") for (int j = 0; j < 2; ++j) { const int col = 512 * j + 8 * lane; const f32x4 ga = *(const f32x4*)(gpre + col), gb = *(const f32x4*)(gpre + col + 4); \
                    const u32x2 a = pack4(xv[2 * j] * r1 * ga), b2 = pack4(xv[2 * j + 1] * r1 * gb); *(u32x4*)(XN + (size_t)row * DM + col) = (u32x4){a.x, a.y, b2.x, b2.y}; } \
            } else { \
                _Pragma("unroll") for (int j = 0; j < 2; ++j) { const int col = 512 * j + 8 * lane; const u32x2 a = pack4(xv[2 * j]), b2 = pack4(xv[2 * j + 1]); *(u32x4*)(XN + (size_t)row * DM + col) = (u32x4){a.x, a.y, b2.x, b2.y}; } \
                const f32x4* pe = (const f32x4*)(part_e + (size_t)row * 16); const f32x4 e0 = pe[0], e1 = pe[1], e2 = pe[2], e3 = pe[3]; \
                const float te = ((e0[0] + e0[1]) + (e0[2] + e0[3])) + ((e1[0] + e1[1]) + (e1[2] + e1[3])) + ((e2[0] + e2[1]) + (e2[2] + e2[3])) + ((e3[0] + e3[1]) + (e3[2] + e3[3])); \
                if (lane == 0) rstd_e[row] = __builtin_amdgcn_rsqf(te * (1.0f / DM) + EPS); } \
        } } while (0)
    if (IN(6)) ROWPASS(true);
    SEAM(6);
    if (IN(7)) {
        pg8::Gemm g{XN, (const bf16*)(ws + WS_W1), M, FF, 1024}; Sched S = make_sched(G, bx, 16);
        EpiRelu2 E{(bf16*)(ws + WS_U)};
        pg8::gemm_phase<EpiRelu2, Sched, true, true>(lds, g, S, E);
    }
    SEAM(7);
    if (IN(8)) {
        { pg8::Gemm g{(const bf16*)(ws + WS_U), (const bf16*)(ws + WS_W2), M, 1024, FF}; Sched S = make_sched(G, bx, 4);
          EpiT E{(bf16*)(ws + WS_T), part_t};
          pg8::gemm_phase<EpiT, Sched, true, true>(lds, g, S, E); }
        { pg8::Gemm g{(const bf16*)(ws + WS_PB), (const bf16*)(ws + WS_WPP), M, 1024, 256}; Sched S = make_sched(G, bx, 4);
          EpiT E{(bf16*)(ws + WS_ERAW), part_e};
          pg8::gemm_phase<EpiT, Sched, true, true>(lds, g, S, E); }
    }
    SEAM(8);
    if (IN(9)) ROWPASS(false);
    SEAM(9);
    if (IN(10)) {
        pg8::Gemm g{XN, (const bf16*)(ws + WS_WPG), M, 1024, 1024}; Sched S = make_sched(G, bx, 4);
        EpiOut E{P.out, (const bf16*)(ws + WS_ERAW), rstd_e, P.in[18]};
        pg8::gemm_phase<EpiOut, Sched, true, true>(lds, g, S, E);
    }
#undef IN
#undef SEAM
}

extern "C" void kernel_launch(void* const* d_in, const int* in_sizes, int n_in, void* d_out, int out_size, void* d_ws, size_t ws_size, hipStream_t stream) {
    static int grid = 0;
    if (grid == 0) {
        int dev = 0, cus = 0, per_cu = 0;
        hipGetDevice(&dev); hipDeviceGetAttribute(&cus, hipDeviceAttributeMultiprocessorCount, dev);
        if (hipFuncSetAttribute((const void*)mega_fwd, hipFuncAttributeMaxDynamicSharedMemorySize, LDS_BYTES) != hipSuccess) { fprintf(stderr, "hipFuncSetAttribute failed\n"); }
        if (hipOccupancyMaxActiveBlocksPerMultiprocessor(&per_cu, (const void*)mega_fwd, NWAVES * 64, LDS_BYTES) != hipSuccess || per_cu < 1) { fprintf(stderr, "occupancy query: %d\n", per_cu); per_cu = 1; }
        (void)hipGetLastError();
        grid = cus * per_cu;
        if (n_in != 20 || ws_size < WS_END) fprintf(stderr, "kernel_launch: unexpected n_in %d / ws %zu\n", n_in, ws_size);
    }
    Params p{};
    for (int i = 0; i < 20; ++i) p.in[i] = (const float*)d_in[i];
    p.out = (float*)d_out; p.ws = (unsigned char*)d_ws;
#if MK_N_LAUNCHES == 1
    p.ph_lo = 0; p.ph_hi = 11;
    void* args[] = {&p};
    hipError_t e = hipLaunchCooperativeKernel((const void*)mega_fwd, dim3(grid), dim3(NWAVES * 64), args, LDS_BYTES, stream);
    if (e != hipSuccess) fprintf(stderr, "cooperative launch failed: %s (grid %d)\n", hipGetErrorString(e), grid);
#else
    for (int k = 0; k < 11; ++k) { p.ph_lo = k; p.ph_hi = k + 1; hipLaunchKernelGGL(mega_fwd, dim3(grid), dim3(NWAVES * 64), LDS_BYTES, stream, p); }
#endif
}
```

```cpp
#include <hip/hip_runtime.h>
#include <hip/hip_cooperative_groups.h>
#include <cstdio>
#include <cstdint>
namespace cg = cooperative_groups;
#ifndef MK_N_LAUNCHES
#define MK_N_LAUNCHES 1
#endif
namespace pg8 {
#define PG8_LAS __attribute__((address_space(3)))
typedef unsigned short bf16_t;
typedef short bf16x8 __attribute__((ext_vector_type(8)));
typedef float f32x4 __attribute__((ext_vector_type(4)));
typedef unsigned u32x4 __attribute__((ext_vector_type(4)));
constexpr int BM = 256, BK = 64, HALF = 128, HTB = HALF * BK * 2  , STAGE_BYTES = 8 * HTB, NXCD = 8, WGM = 8;

__host__ __device__ __forceinline__ int lds_byte(int r, int c) { const int st = (r >> 4) * 2 + (c >> 5), rr = r & 15, cc = c & 31, ob = rr * 64 + cc * 2; return st * 1024 + (ob ^ (((ob >> 9) & 1) << 5)); }
__host__ __device__ __forceinline__ void stage_rc(int b, int& R, int& C) { const int st = b / 1024, sb = b % 1024, swz = sb ^ (((sb >> 9) & 1) << 5); R = (st >> 1) * 16 + swz / 64; C = (st & 1) * 32 + (swz % 64) / 2; }
__host__ __device__ __forceinline__ int perm32(int rho) { const int n = rho >> 4, i = rho & 15; return 8 * (i >> 2) + 4 * n + (i & 3); }

struct Unit { int pm, pn, kind; };
struct Gemm { const bf16_t* A; const bf16_t* Bt; int M, N, K; };

template <class Epi, class Sched, bool ALIGN_EPI = false, bool SP2 = false>
__device__ __forceinline__ void gemm_phase(PG8_LAS unsigned char* lds, const Gemm g, const Sched& S, const Epi& E) {
    const int tid = threadIdx.x, wid = __builtin_amdgcn_readfirstlane(tid >> 6), lane = tid & 63, wr = wid >> 2, wc = wid & 3, fr = lane & 15, fq = lane >> 4;
    int K_ = g.K; asm volatile("" : "+s"(K_));
    const int K = K_, nt = K / BK;
    unsigned voffA[2], voffB[2];
#pragma unroll
    for (int i = 0; i < 2; ++i) { int R, C; stage_rc(tid * 16 + i * 8192, R, C); const int Rb = Epi::PERM ? ((R & ~31) + perm32(R & 31)) : R;
        voffA[i] = (unsigned)(R * K + C) * 2u; voffB[i] = (unsigned)(Rb * K + C) * 2u; }
    const size_t kstep = (size_t)(BK * 2);
    const size_t hstep = (size_t)HALF * K * 2;
    const size_t tstep = 2 * hstep;
    const unsigned ldsw = (unsigned)wid * 1024u;
    const int aoff = lds_byte(wr * 64 + fr, fq * 8), boff = lds_byte(wc * 32 + fr, fq * 8);
#define PG8_SA(b, h) (((b) * 2 + (h)) * HTB)
#define PG8_SB(b, h) ((4 + (b) * 2 + (h)) * HTB)
#define PG8_STAGE(bufoff, gbase, voff) do { _Pragma("unroll") for (int _i = 0; _i < 2; ++_i) \
        __builtin_amdgcn_global_load_lds((const unsigned*)((const char*)(gbase) + (voff)[_i]), (PG8_LAS unsigned*)(lds + (bufoff) + ldsw + _i * 8192), 16, 0, 0); } while (0)
#define PG8_LDA(dst, b, h) do { _Pragma("unroll") for (int m = 0; m < 4; ++m) _Pragma("unroll") for (int k = 0; k < 2; ++k) dst[m][k] = *(const PG8_LAS bf16x8*)(lds + PG8_SA(b, h) + aoff + m * 2048 + k * 1024); } while (0)
#define PG8_LDB(dst, b, h) do { _Pragma("unroll") for (int n = 0; n < 2; ++n) _Pragma("unroll") for (int k = 0; k < 2; ++k) dst[n][k] = *(const PG8_LAS bf16x8*)(lds + PG8_SB(b, h) + boff + n * 2048 + k * 1024); } while (0)
#define PG8_MMA(ai, bj, At, Bt) do { __builtin_amdgcn_s_setprio(1); _Pragma("unroll") for (int m = 0; m < 4; ++m) _Pragma("unroll") for (int n = 0; n < 2; ++n) _Pragma("unroll") for (int k = 0; k < 2; ++k) \
        acc[ai][bj][m][n] = __builtin_amdgcn_mfma_f32_16x16x32_bf16(Bt[n][k], At[m][k], acc[ai][bj][m][n], 0, 0, 0); __builtin_amdgcn_s_setprio(0); } while (0)
#define PG8_WAIT_V(n) asm volatile("s_waitcnt vmcnt(" #n ")" ::: "memory")
#define PG8_WAIT_L(n) asm volatile("s_waitcnt lgkmcnt(" #n ")" ::: "memory")
#define PG8_BAR __builtin_amdgcn_s_barrier()
#define PG8_SCHED __builtin_amdgcn_sched_barrier(0)
    Unit cur, nxt; int ui = 0;
    if (!S.next(0, cur)) return;
    f32x4 acc[2][2][4][2];
#pragma unroll
    for (int a = 0; a < 2; ++a)
#pragma unroll
        for (int b = 0; b < 2; ++b)
#pragma unroll
            for (int m = 0; m < 4; ++m)
#pragma unroll
                for (int n = 0; n < 2; ++n) acc[a][b][m][n] = (f32x4){0.f, 0.f, 0.f, 0.f};
    bf16x8 At[4][2], B0[2][2], B1[2][2];
    const char* cA = (const char*)g.A + (size_t)cur.pm * tstep; const char* cB = (const char*)g.Bt + (size_t)cur.pn * tstep;
    S.a_ready(cur);
    if constexpr (SP2) {
        PG8_STAGE(PG8_SB(0, 0), cB, voffB); PG8_STAGE(PG8_SB(0, 1), cB + hstep, voffB); PG8_STAGE(PG8_SA(0, 0), cA, voffA); PG8_STAGE(PG8_SA(0, 1), cA + hstep, voffA);
        if (wr == 1) PG8_BAR;
        PG8_WAIT_V(2); PG8_BAR;
        PG8_STAGE(PG8_SB(1, 0), cB + kstep, voffB); PG8_STAGE(PG8_SA(1, 0), cA + kstep, voffA); PG8_STAGE(PG8_SB(1, 1), cB + hstep + kstep, voffB);
        PG8_WAIT_V(6); PG8_BAR;
    } else {
        PG8_STAGE(PG8_SB(0, 0), cB, voffB); PG8_STAGE(PG8_SA(0, 0), cA, voffA); PG8_STAGE(PG8_SB(0, 1), cB + hstep, voffB); PG8_STAGE(PG8_SA(0, 1), cA + hstep, voffA);
        if (wr == 1) PG8_BAR;
        PG8_WAIT_V(4); PG8_BAR;
        PG8_STAGE(PG8_SB(1, 0), cB + kstep, voffB); PG8_STAGE(PG8_SA(1, 0), cA + kstep, voffA); PG8_STAGE(PG8_SB(1, 1), cB + hstep + kstep, voffB);
        PG8_WAIT_V(6); PG8_BAR;
    }
    for (;;) {
        const bool has_next = S.next(ui + 1, nxt);
        const char* nA = has_next ? (const char*)g.A + (size_t)nxt.pm * tstep : cA; const char* nB = has_next ? (const char*)g.Bt + (size_t)nxt.pn * tstep : cB;
        for (int t = 0; t < nt; t += 2) {
            const bool last = (t == nt - 2);
            const char* a1 = cA + (size_t)(t + 1) * kstep;
            const char* a2 = last ? nA : cA + (size_t)(t + 2) * kstep; const char* b2 = last ? nB : cB + (size_t)(t + 2) * kstep;
            const char* a3 = a2 + kstep; const char* b3 = b2 + kstep;
            if (last && has_next) S.a_ready(nxt);
            if constexpr (SP2) {
            PG8_LDB(B0, 0, 0); PG8_LDB(B1, 0, 1); PG8_SCHED; PG8_LDA(At, 0, 0); PG8_STAGE(PG8_SA(1, 1), a1 + hstep, voffA);
            PG8_WAIT_V(8); PG8_WAIT_L(0); PG8_BAR; PG8_MMA(0, 0, At, B0); PG8_MMA(0, 1, At, B1); PG8_BAR; PG8_SCHED;
            PG8_LDA(At, 0, 1); PG8_STAGE(PG8_SB(0, 0), b2, voffB); PG8_STAGE(PG8_SB(0, 1), b2 + hstep, voffB); PG8_STAGE(PG8_SA(0, 0), a2, voffA);
            PG8_WAIT_V(8); PG8_WAIT_L(0); PG8_BAR; PG8_MMA(1, 0, At, B0); PG8_MMA(1, 1, At, B1); PG8_BAR; PG8_SCHED;
            PG8_LDB(B0, 1, 0); PG8_LDB(B1, 1, 1); PG8_SCHED; PG8_LDA(At, 1, 0); PG8_STAGE(PG8_SA(0, 1), a2 + hstep, voffA);
            PG8_WAIT_V(8); PG8_WAIT_L(0); PG8_BAR; PG8_MMA(0, 0, At, B0); PG8_MMA(0, 1, At, B1); PG8_BAR; PG8_SCHED;
            PG8_LDA(At, 1, 1); PG8_STAGE(PG8_SB(1, 0), b3, voffB); PG8_STAGE(PG8_SB(1, 1), b3 + hstep, voffB); PG8_STAGE(PG8_SA(1, 0), a3, voffA);
            PG8_WAIT_V(8); PG8_WAIT_L(0); PG8_BAR; PG8_MMA(1, 0, At, B0); PG8_MMA(1, 1, At, B1); PG8_BAR; PG8_SCHED;
            } else {
            PG8_LDB(B0, 0, 0); PG8_SCHED; PG8_LDA(At, 0, 0); PG8_STAGE(PG8_SA(1, 1), a1 + hstep, voffA);
            PG8_WAIT_L(8); PG8_BAR; PG8_WAIT_L(0); PG8_MMA(0, 0, At, B0); PG8_BAR; PG8_SCHED;
            PG8_LDB(B1, 0, 1); PG8_STAGE(PG8_SB(0, 0), b2, voffB);
            PG8_BAR; PG8_WAIT_L(0); PG8_MMA(0, 1, At, B1); PG8_BAR;
            PG8_LDA(At, 0, 1); PG8_STAGE(PG8_SA(0, 0), a2, voffA);
            PG8_BAR; PG8_WAIT_L(0); PG8_MMA(1, 0, At, B0); PG8_BAR; PG8_SCHED;
            PG8_STAGE(PG8_SB(0, 1), b2 + hstep, voffB);
            PG8_WAIT_V(6); PG8_BAR; PG8_MMA(1, 1, At, B1); PG8_BAR;
            PG8_LDB(B0, 1, 0); PG8_SCHED; PG8_LDA(At, 1, 0); PG8_STAGE(PG8_SA(0, 1), a2 + hstep, voffA);
            PG8_WAIT_L(8); PG8_BAR; PG8_WAIT_L(0); PG8_MMA(0, 0, At, B0); PG8_BAR; PG8_SCHED;
            PG8_LDB(B1, 1, 1); PG8_STAGE(PG8_SB(1, 0), b3, voffB);
            PG8_BAR; PG8_WAIT_L(0); PG8_MMA(0, 1, At, B1); PG8_BAR;
            PG8_LDA(At, 1, 1); PG8_STAGE(PG8_SA(1, 0), a3, voffA);
            PG8_BAR; PG8_WAIT_L(0); PG8_MMA(1, 0, At, B0); PG8_BAR; PG8_SCHED;
            PG8_STAGE(PG8_SB(1, 1), b3 + hstep, voffB);
            PG8_WAIT_V(6); PG8_BAR; PG8_MMA(1, 1, At, B1); PG8_BAR;
            }
        }
        if constexpr (ALIGN_EPI) { if (wr == 0) PG8_BAR; }
        if constexpr (!Epi::AFTER_DRAIN) { if (cur.kind & 0x100) E.mid(acc, cur, wr, wc, fr, fq); else E(acc, cur, wr, wc, fr, fq); S.done(cur); }
        if (!has_next) break;
        {
#pragma unroll
        for (int a = 0; a < 2; ++a)
#pragma unroll
            for (int b = 0; b < 2; ++b)
#pragma unroll
                for (int m = 0; m < 4; ++m)
#pragma unroll
                    for (int n = 0; n < 2; ++n) acc[a][b][m][n] = (f32x4){0.f, 0.f, 0.f, 0.f};
        }
        cur = nxt; cA = nA; cB = nB; ++ui;
        if constexpr (ALIGN_EPI) { if (wr == 1) PG8_BAR; }
    }
    PG8_WAIT_V(0);
    if constexpr (!ALIGN_EPI) { if (wr == 0) PG8_BAR; }
    PG8_BAR;
    if constexpr (Epi::AFTER_DRAIN) { E.fused(acc, cur, wr, wc, fr, fq, lds, wid, lane); S.done(cur); }
#undef PG8_SA
#undef PG8_SB
#undef PG8_STAGE
#undef PG8_LDA
#undef PG8_LDB
#undef PG8_MMA
#undef PG8_WAIT_V
#undef PG8_WAIT_L
#undef PG8_BAR
#undef PG8_SCHED
}
}

#define LAS __attribute__((address_space(3)))
typedef unsigned short bf16;
typedef float f32x4 __attribute__((ext_vector_type(4)));
typedef float f32x2 __attribute__((ext_vector_type(2)));
typedef float f32x16 __attribute__((ext_vector_type(16)));
typedef short bf16x8 __attribute__((ext_vector_type(8)));
typedef short s16x4 __attribute__((ext_vector_type(4)));
typedef unsigned u32x4 __attribute__((ext_vector_type(4)));
typedef unsigned u32x2 __attribute__((ext_vector_type(2)));
typedef __bf16 bf16x2_t __attribute__((ext_vector_type(2)));

constexpr int DM = 1024, SEQ = 4096, NB = 8, M = NB * SEQ, FF = 4096;
constexpr int NWAVES = 8;
constexpr float EPS = 1e-6f, LOG2E = 1.4426950408889634f;
constexpr float C2_MLA = 0.10206207261596575f * LOG2E;
constexpr float C2_SWA = 0.125f * LOG2E;
constexpr int N_IN_PAD = 3840;

constexpr size_t MiB = 1u << 20;
constexpr size_t WS_CTL = 0, CTL_BYTES = 65536;
constexpr size_t WS_TAB = 1 * MiB, WS_PQ = 2 * MiB, WS_PKV = 2 * MiB + 512 * 1024, WS_PT = 3 * MiB, WS_PE = 5 * MiB, WS_RSTDE = 7 * MiB;
constexpr size_t WS_WIN = 8 * MiB, WS_WQKV = 16 * MiB, WS_WPP = 18 * MiB, WS_WUP = 19 * MiB, WS_WOUT = 23 * MiB, WS_W1 = 25 * MiB, WS_W2 = 33 * MiB, WS_WPG = 41 * MiB;
constexpr size_t WS_XN = 48 * MiB, WS_QA = 112 * MiB, WS_KVR = 128 * MiB, WS_KS = 144 * MiB, WS_VS = 152 * MiB, WS_KROPE = 160 * MiB, WS_ERAW = 112 * MiB;
constexpr size_t WS_T = 176 * MiB, WS_QR = 176 * MiB, WS_PB = 240 * MiB;
constexpr size_t WS_QN = 256 * MiB, WS_QS = 320 * MiB, WS_KN = 384 * MiB, WS_VM = 448 * MiB, WS_U = 256 * MiB, WS_END = 512 * MiB;

constexpr int LDS_BYTES = 132 * 1024;

struct Params { const float* in[20]; float* out; unsigned char* ws; int ph_lo, ph_hi; };

__device__ __forceinline__ unsigned cvtpk(float lo, float hi) { f32x2 v = {lo, hi}; bf16x2_t b = __builtin_convertvector(v, bf16x2_t); return __builtin_bit_cast(unsigned, b); }
__device__ __forceinline__ u32x2 pack4(f32x4 v) { u32x2 r; r.x = cvtpk(v[0], v[1]); r.y = cvtpk(v[2], v[3]); return r; }
__device__ __forceinline__ float bf2f(unsigned short h) { return __builtin_bit_cast(float, (unsigned)h << 16); }
__device__ __forceinline__ f32x4 unpack4(u32x2 w) { f32x4 r; r[0] = __builtin_bit_cast(float, w.x << 16); r[1] = __builtin_bit_cast(float, w.x & 0xffff0000u); r[2] = __builtin_bit_cast(float, w.y << 16); r[3] = __builtin_bit_cast(float, w.y & 0xffff0000u); return r; }
__device__ __forceinline__ float sigmoidf_(float x) { return __builtin_amdgcn_rcpf(1.0f + __builtin_amdgcn_exp2f(-x * LOG2E)); }
__device__ __forceinline__ f32x4 sigmoid4(f32x4 v) { f32x4 r; r[0] = sigmoidf_(v[0]); r[1] = sigmoidf_(v[1]); r[2] = sigmoidf_(v[2]); r[3] = sigmoidf_(v[3]); return r; }
__device__ __forceinline__ float wave_sum(float v) {
#pragma unroll
    for (int o = 1; o < 64; o <<= 1) v += __shfl_xor(v, o);
    return v;
}
__device__ __forceinline__ float dot4(f32x4 v) { return (v[0] * v[0] + v[1] * v[1]) + (v[2] * v[2] + v[3] * v[3]); }

struct Sched {
    int G, c, nseg, pairs;
    int nN[2], pmo[2], pno[2], start[3];
    __device__ __forceinline__ bool next(int i, pg8::Unit& u) const {
        const int ii = pairs ? (i >> 1) : i;
        const long L = (long)ii * G + c; if (L >= start[nseg]) return false;
        const int s = (nseg > 1 && L >= start[1]) ? 1 : 0; const int l = (int)L - start[s];
        const int nwg = start[s + 1] - start[s], q = nwg >> 3, id = (l & 7) * q + (l >> 3);
        const int nig = 8 * nN[s], gid = id / nig, r = id % nig;
        const int pm = gid * 8 + (r & 7), pn = r >> 3;
        u.pm = pmo[s] + pm; u.pn = pno[s] + pn; u.kind = u.pn;
        if (pairs) { if (i & 1) { u.pm += 128; u.pn += 4; u.kind = 0; } else u.kind = 0x100; }
        return true;
    }
    __device__ __forceinline__ void a_ready(const pg8::Unit&) const {}
    __device__ __forceinline__ void done(const pg8::Unit&) const {}
};
__device__ __forceinline__ Sched make_sched(int G, int c, int nN0) { Sched s; s.G = G; s.c = c; s.nseg = 1; s.pairs = 0; s.nN[0] = nN0; s.nN[1] = 1; s.pmo[0] = s.pmo[1] = 0; s.pno[0] = s.pno[1] = 0; s.start[0] = 0; s.start[1] = 128 * nN0; s.start[2] = s.start[1]; return s; }

typedef pg8::f32x4 A4;
#define EPI_ROWS(ai, m) for (int ai = 0; ai < 2; ++ai) _Pragma("unroll") for (int m = 0; m < 4; ++m)

struct EpiP1 {
    static constexpr bool PERM = false, AFTER_DRAIN = false;
    bf16 *qa, *kvr, *krope, *qs, *ks, *vs, *gates; float *part_q, *part_kv; const f32x2* tab;
    __device__ __forceinline__ void mid(const A4 (&acc)[2][2][4][2], const pg8::Unit& u, int wr, int wc, int fr, int fq) const {}
    __device__ __forceinline__ void operator()(const A4 (&acc)[2][2][4][2], const pg8::Unit& u, int wr, int wc, int fr, int fq) const {
        const int pn = u.kind, row0 = u.pm * 256 + wr * 64 + fr, cl0 = wc * 32 + fq * 4;
        if (pn <= 1) {
            bf16* dst = pn == 0 ? qa : kvr; float* part = pn == 0 ? part_q : part_kv;
#pragma unroll
            EPI_ROWS(ai, m) { const int row = row0 + ai * 128 + m * 16; float ss = 0.f;
#pragma unroll
                for (int bj = 0; bj < 2; ++bj)
#pragma unroll
                    for (int n = 0; n < 2; ++n) { const A4 v = acc[ai][bj][m][n]; if (pn == 0 || bj == 0) ss += dot4(v);
                        *(u32x2*)(dst + (size_t)row * 256 + bj * 128 + cl0 + n * 16) = pack4(v); }
                ss += __shfl_xor(ss, 16); ss += __shfl_xor(ss, 32);
                if (fq == 0) part[(size_t)row * 4 + wc] = ss;
                if (pn == 1 && wc == 0) {
                    const int pos = row & (SEQ - 1); const A4 x1 = acc[ai][1][m][0], x2 = acc[ai][1][m][1]; A4 o1, o2;
#pragma unroll
                    for (int e = 0; e < 4; ++e) { const f32x2 cs = tab[pos * 32 + 2 * (4 * fq + e)]; o1[e] = x1[e] * cs.x - x2[e] * cs.y; o2[e] = x2[e] * cs.x + x1[e] * cs.y; }
                    *(u32x2*)(krope + (size_t)row * 32 + 4 * fq) = pack4(o1); *(u32x2*)(krope + (size_t)row * 32 + 16 + 4 * fq) = pack4(o2);
                }
            }
        } else if (pn <= 6) {
            const int d1 = 16 * (wc & 1) + 4 * fq;
            f32x4 tb[2][2];
            { const int pos = row0 & (SEQ - 1); tb[0][0] = *(const f32x4*)(tab + pos * 32 + d1); tb[0][1] = *(const f32x4*)(tab + pos * 32 + d1 + 2); }
#pragma unroll
            for (int it = 0; it < 8; ++it) { const int ai = it >> 2, m = it & 3; const int row = row0 + ai * 128 + m * 16;
                if (it + 1 < 8) { const int pos = (row0 + ((it + 1) >> 2) * 128 + ((it + 1) & 3) * 16) & (SEQ - 1); tb[(it + 1) & 1][0] = *(const f32x4*)(tab + pos * 32 + d1); tb[(it + 1) & 1][1] = *(const f32x4*)(tab + pos * 32 + d1 + 2); }
                asm volatile("" ::: "memory");
                const f32x4 t0 = tb[it & 1][0], t1 = tb[it & 1][1];
                const float cc[4] = {t0[0], t0[2], t1[0], t1[2]}, sn[4] = {t0[1], t0[3], t1[1], t1[3]};
#pragma unroll
                for (int bj = 0; bj < 2; ++bj) {
                    if (pn == 6 && bj == 1) {
#pragma unroll
                        for (int n = 0; n < 2; ++n) *(u32x2*)(vs + (size_t)row * 128 + cl0 + n * 16) = pack4(acc[ai][1][m][n]);
                    } else {
                        const A4 x1 = acc[ai][bj][m][0], x2 = acc[ai][bj][m][1]; A4 o1, o2; const float sc = pn == 6 ? 1.0f : C2_SWA;
#pragma unroll
                        for (int e = 0; e < 4; ++e) { o1[e] = (x1[e] * cc[e] - x2[e] * sn[e]) * sc; o2[e] = (x2[e] * cc[e] + x1[e] * sn[e]) * sc; }
                        bf16* d = pn == 6 ? ks + (size_t)row * 128 + (wc >> 1) * 64 : qs + (size_t)row * 1024 + ((pn - 2) * 4 + bj * 2 + (wc >> 1)) * 64;
                        *(u32x2*)(d + d1) = pack4(o1); *(u32x2*)(d + 32 + d1) = pack4(o2);
                    }
                }
            }
        } else {
#pragma unroll
            EPI_ROWS(ai, m) { const int row = row0 + ai * 128 + m * 16;
#pragma unroll
                for (int bj = 0; bj < 2; ++bj)
#pragma unroll
                    for (int n = 0; n < 2; ++n) *(u32x2*)(gates + (size_t)row * 2048 + (pn - 7) * 256 + bj * 128 + cl0 + n * 16) = pack4(sigmoid4(acc[ai][bj][m][n]));
            }
        }
    }
};

struct EpiP2 {
    static constexpr bool PERM = false, AFTER_DRAIN = false;
    bf16 *qn, *qr, *kn, *vm; const float *part_q, *part_kv; const f32x2* tab;
    __device__ __forceinline__ void mid(const A4 (&acc)[2][2][4][2], const pg8::Unit& u, int wr, int wc, int fr, int fq) const {}
    __device__ __forceinline__ void operator()(const A4 (&acc)[2][2][4][2], const pg8::Unit& u, int wr, int wc, int fr, int fq) const {
        const int pn = u.kind, row0 = (u.pm & 127) * 256 + wr * 64 + fr, cl0 = wc * 32 + fq * 4;
        const bool isq = pn < 6, isrope = pn == 4 || pn == 5; const float* part = isq ? part_q : part_kv; const float invn = isq ? (1.0f / 256.0f) : (1.0f / 128.0f);
        f32x4 pp[2]; f32x4 tb[2][2];
        pp[0] = *(const f32x4*)(part + (size_t)row0 * 4);
        if (isrope) { const int pos = row0 & (SEQ - 1); tb[0][0] = *(const f32x4*)(tab + pos * 32 + 8 * fq); tb[0][1] = *(const f32x4*)(tab + pos * 32 + 8 * fq + 4); }
        f32x4 tc[2][2];
        if (isrope) { const int pos = row0 & (SEQ - 1); tc[0][0] = *(const f32x4*)(tab + pos * 32 + 8 * fq + 2); tc[0][1] = *(const f32x4*)(tab + pos * 32 + 8 * fq + 6); }
#pragma unroll
        for (int it = 0; it < 8; ++it) { const int ai = it >> 2, m = it & 3; const int row = row0 + ai * 128 + m * 16;
            if (it + 1 < 8) { const int rn = row0 + ((it + 1) >> 2) * 128 + ((it + 1) & 3) * 16; pp[(it + 1) & 1] = *(const f32x4*)(part + (size_t)rn * 4);
                if (isrope) { const int pos = rn & (SEQ - 1); tb[(it + 1) & 1][0] = *(const f32x4*)(tab + pos * 32 + 8 * fq); tb[(it + 1) & 1][1] = *(const f32x4*)(tab + pos * 32 + 8 * fq + 4);
                    tc[(it + 1) & 1][0] = *(const f32x4*)(tab + pos * 32 + 8 * fq + 2); tc[(it + 1) & 1][1] = *(const f32x4*)(tab + pos * 32 + 8 * fq + 6); } }
            asm volatile("" ::: "memory");
            const f32x4 p4 = pp[it & 1];
            float rs = __builtin_amdgcn_rsqf(((p4[0] + p4[1]) + (p4[2] + p4[3])) * invn + EPS);
            if (isq) rs *= C2_MLA;
            if (isrope) {
                const float cc[4] = {tb[it & 1][0][0], tc[it & 1][0][0], tb[it & 1][1][0], tc[it & 1][1][0]}, sn[4] = {tb[it & 1][0][1], tc[it & 1][0][1], tb[it & 1][1][1], tc[it & 1][1][1]};
#pragma unroll
                for (int bj = 0; bj < 2; ++bj) { const A4 x1 = acc[ai][bj][m][0], x2 = acc[ai][bj][m][1]; A4 o1, o2;
#pragma unroll
                    for (int e = 0; e < 4; ++e) { o1[e] = (x1[e] * cc[e] - x2[e] * sn[e]) * rs; o2[e] = (x2[e] * cc[e] + x1[e] * sn[e]) * rs; }
                    bf16* d = qr + (size_t)row * 512 + ((pn - 4) * 8 + bj * 4 + wc) * 32;
                    *(u32x2*)(d + 4 * fq) = pack4(o1); *(u32x2*)(d + 16 + 4 * fq) = pack4(o2); }
            } else {
                bf16* d = pn < 4 ? qn + (size_t)row * 1024 + pn * 256 : (pn < 10 ? kn + (size_t)row * 1024 + (pn - 6) * 256 : vm + (size_t)row * 1024 + (pn - 10) * 256);
#pragma unroll
                for (int bj = 0; bj < 2; ++bj)
#pragma unroll
                    for (int n = 0; n < 2; ++n) *(u32x2*)(d + bj * 128 + cl0 + n * 16) = pack4(acc[ai][bj][m][n] * rs);
            }
        }
    }
};

struct EpiP4 {
    static constexpr bool PERM = false, AFTER_DRAIN = false;
    const bf16* gates; bf16* y; bf16* ya;
    __device__ __forceinline__ void mid(const A4 (&acc)[2][2][4][2], const pg8::Unit& u, int wr, int wc, int fr, int fq) const {
        const int row0 = u.pm * 256 + wr * 64 + fr, col0 = u.pn * 256 + wc * 32 + fq * 4;
        u32x2 gq[2][2][2];
#define P4_LD(buf, it_) do { const bf16* g_ = gates + (size_t)(row0 + ((it_) >> 2) * 128 + ((it_) & 3) * 16) * 2048 + col0; \
        _Pragma("unroll") for (int bj = 0; bj < 2; ++bj) _Pragma("unroll") for (int n = 0; n < 2; ++n) gq[buf][bj][n] = *(const u32x2*)(g_ + bj * 128 + n * 16); } while (0)
        P4_LD(0, 0);
#pragma unroll
        for (int it = 0; it < 8; ++it) { const int ai = it >> 2, m = it & 3; const size_t row = (size_t)(row0 + ai * 128 + m * 16);
            if (it + 1 < 8) P4_LD((it + 1) & 1, it + 1);
            asm volatile("" ::: "memory");
#pragma unroll
            for (int bj = 0; bj < 2; ++bj)
#pragma unroll
                for (int n = 0; n < 2; ++n) *(u32x2*)(ya + row * 1024 + col0 + bj * 128 + n * 16) = pack4(acc[ai][bj][m][n] * unpack4(gq[it & 1][bj][n]));
        }
#undef P4_LD
    }
    __device__ __forceinline__ void operator()(const A4 (&acc)[2][2][4][2], const pg8::Unit& u, int wr, int wc, int fr, int fq) const {
        const int row0 = (u.pm - 128) * 256 + wr * 64 + fr, col0 = (u.pn - 4) * 256 + wc * 32 + fq * 4;
        u32x2 gq[2][2][2], yq[2][2][2];
#define P4_LD(buf, it_) do { const size_t r_ = (size_t)(row0 + ((it_) >> 2) * 128 + ((it_) & 3) * 16); const bf16* g_ = gates + r_ * 2048 + 1024 + col0; const bf16* y_ = ya + r_ * 1024 + col0; \
        _Pragma("unroll") for (int bj = 0; bj < 2; ++bj) _Pragma("unroll") for (int n = 0; n < 2; ++n) { gq[buf][bj][n] = *(const u32x2*)(g_ + bj * 128 + n * 16); yq[buf][bj][n] = *(const u32x2*)(y_ + bj * 128 + n * 16); } } while (0)
        P4_LD(0, 0);
#pragma unroll
        for (int it = 0; it < 8; ++it) { const int ai = it >> 2, m = it & 3; const size_t row = (size_t)(row0 + ai * 128 + m * 16);
            if (it + 1 < 8) P4_LD((it + 1) & 1, it + 1);
            asm volatile("" ::: "memory");
#pragma unroll
            for (int bj = 0; bj < 2; ++bj)
#pragma unroll
                for (int n = 0; n < 2; ++n) *(u32x2*)(y + row * 1024 + col0 + bj * 128 + n * 16) = pack4(unpack4(yq[it & 1][bj][n]) + acc[ai][bj][m][n] * unpack4(gq[it & 1][bj][n]));
        }
#undef P4_LD
    }
};

struct EpiT {
    static constexpr bool PERM = false, AFTER_DRAIN = false;
    bf16* o; float* part;
    __device__ __forceinline__ void mid(const A4 (&acc)[2][2][4][2], const pg8::Unit& u, int wr, int wc, int fr, int fq) const {}
    __device__ __forceinline__ void operator()(const A4 (&acc)[2][2][4][2], const pg8::Unit& u, int wr, int wc, int fr, int fq) const {
        const int row0 = u.pm * 256 + wr * 64 + fr, col0 = u.pn * 256 + wc * 32 + fq * 4;
#pragma unroll
        EPI_ROWS(ai, m) { const size_t row = (size_t)(row0 + ai * 128 + m * 16); float ss = 0.f;
#pragma unroll
            for (int bj = 0; bj < 2; ++bj)
#pragma unroll
                for (int n = 0; n < 2; ++n) { const A4 v = acc[ai][bj][m][n]; ss += dot4(v); *(u32x2*)(o + row * 1024 + col0 + bj * 128 + n * 16) = pack4(v); }
            ss += __shfl_xor(ss, 16); ss += __shfl_xor(ss, 32);
            if (fq == 0) part[row * 16 + u.pn * 4 + wc] = ss;
        }
    }
};

struct EpiRelu2 {
    static constexpr bool PERM = false, AFTER_DRAIN = false;
    bf16* o;
    __device__ __forceinline__ void mid(const A4 (&acc)[2][2][4][2], const pg8::Unit& u, int wr, int wc, int fr, int fq) const {}
    __device__ __forceinline__ void operator()(const A4 (&acc)[2][2][4][2], const pg8::Unit& u, int wr, int wc, int fr, int fq) const {
        const int row0 = u.pm * 256 + wr * 64 + fr, col0 = u.pn * 256 + wc * 32 + fq * 4;
#pragma unroll
        EPI_ROWS(ai, m) { const size_t row = (size_t)(row0 + ai * 128 + m * 16);
#pragma unroll
            for (int bj = 0; bj < 2; ++bj)
#pragma unroll
                for (int n = 0; n < 2; ++n) { A4 v = acc[ai][bj][m][n];
#pragma unroll
                    for (int e = 0; e < 4; ++e) { const float r = __builtin_fmaxf(v[e], 0.f); v[e] = r * r; }
                    *(u32x2*)(o + row * FF + col0 + bj * 128 + n * 16) = pack4(v); }
        }
    }
};

struct EpiOut {
    static constexpr bool PERM = false, AFTER_DRAIN = false;
    float* out; const bf16* eraw; const float* rstd_e; const float* gple;
    __device__ __forceinline__ void mid(const A4 (&acc)[2][2][4][2], const pg8::Unit& u, int wr, int wc, int fr, int fq) const {}
    __device__ __forceinline__ void operator()(const A4 (&acc)[2][2][4][2], const pg8::Unit& u, int wr, int wc, int fr, int fq) const {
        const int row0 = u.pm * 256 + wr * 64 + fr, col0 = u.pn * 256 + wc * 32 + fq * 4;
        f32x4 gv[2][2];
#pragma unroll
        for (int bj = 0; bj < 2; ++bj)
#pragma unroll
            for (int n = 0; n < 2; ++n) gv[bj][n] = *(const f32x4*)(gple + col0 + bj * 128 + n * 16);
        f32x4 xq[2][2][2]; u32x2 eq[2][2][2]; float rq[2];
#define PO_LD(buf, it_) do { const size_t r_ = (size_t)(row0 + ((it_) >> 2) * 128 + ((it_) & 3) * 16); rq[buf] = rstd_e[r_]; \
        _Pragma("unroll") for (int bj = 0; bj < 2; ++bj) _Pragma("unroll") for (int n = 0; n < 2; ++n) { const size_t off_ = r_ * 1024 + col0 + bj * 128 + n * 16; xq[buf][bj][n] = *(const f32x4*)(out + off_); eq[buf][bj][n] = *(const u32x2*)(eraw + off_); } } while (0)
        PO_LD(0, 0);
#pragma unroll
        for (int it = 0; it < 8; ++it) { const int ai = it >> 2, m = it & 3; const size_t row = (size_t)(row0 + ai * 128 + m * 16);
            if (it + 1 < 8) PO_LD((it + 1) & 1, it + 1);
            asm volatile("" ::: "memory");
#pragma unroll
            for (int bj = 0; bj < 2; ++bj)
#pragma unroll
                for (int n = 0; n < 2; ++n) { const size_t off = row * 1024 + col0 + bj * 128 + n * 16;
                    *(f32x4*)(out + off) = xq[it & 1][bj][n] + sigmoid4(acc[ai][bj][m][n]) * (unpack4(eq[it & 1][bj][n]) * rq[it & 1] * gv[bj][n]); }
        }
#undef PO_LD
    }
};

namespace att {
constexpr int KP = 208, VP = 192, KBUF = 64 * KP, VBUF = 64 * VP, STAGE = KBUF + VBUF;
__device__ __forceinline__ float max3f(float a, float b, float c) { float r; asm("v_max3_f32 %0, %1, %2, %3" : "=v"(r) : "v"(a), "v"(b), "v"(c)); return r; }
__device__ __forceinline__ float max2f(float a, float b) { float r; asm("v_max_f32_e32 %0, %1, %2" : "=v"(r) : "v"(a), "v"(b)); return r; }
__device__ __forceinline__ float xhalf_max(float v) { auto rr = __builtin_amdgcn_permlane32_swap(__float_as_uint(v), __float_as_uint(v), false, false); return max2f(__uint_as_float(rr[0]), __uint_as_float(rr[1])); }
__device__ __forceinline__ float xhalf_sum(float v) { auto rr = __builtin_amdgcn_permlane32_swap(__float_as_uint(v), __float_as_uint(v), false, false); return __uint_as_float(rr[0]) + __uint_as_float(rr[1]); }
__device__ __forceinline__ s16x4 vtr(const LAS unsigned char* p) { return __builtin_bit_cast(s16x4, __builtin_amdgcn_ds_read_tr16_b64_v4i16((LAS s16x4*)p)); }

template <int MODE>
__device__ __forceinline__ void unit(LAS unsigned char* lds, const bf16* __restrict__ Qa, const bf16* __restrict__ Qb, const bf16* __restrict__ Ka, const bf16* __restrict__ Kb, const bf16* __restrict__ Va, bf16* O,
                                     const float* __restrict__ sinks, int b, int h, int blk, int hp) {
    constexpr int NC = MODE == 0 ? 6 : 4;
    const int tid = threadIdx.x, lane = tid & 63, w = __builtin_amdgcn_readfirstlane(tid >> 6), l31 = lane & 31, hi = lane >> 5;
    int hq, qpos0w, t_beg, t_end, kpos_base; size_t krow_base; int kvpitch, kvcol;
    if (MODE == 0) { hq = h; qpos0w = blk * 256 + w * 32; t_beg = 0; t_end = 4 * blk + 4; kpos_base = 0; kvpitch = 1024; kvcol = h * 64; }
    else { hq = 8 * h + 2 * hp + (w >> 2); qpos0w = blk * 128 + (w & 3) * 32; t_beg = blk == 0 ? 2 : 0; t_end = 4; kpos_base = (blk - 1) * 128; kvpitch = 128; kvcol = h * 64; }
    const size_t seq0 = (size_t)b * SEQ;
    const int qpos = qpos0w + l31;
    const LAS unsigned char* qlds = lds + 2 * KBUF + 2 * VBUF + (w * 64 + lane) * (NC * 16);
    { const bf16* qp = Qa + (seq0 + qpos) * 1024 + hq * 64 + hi * 8;
#pragma unroll
      for (int c = 0; c < 4; ++c) *(LAS bf16x8*)(qlds + c * 16) = *(const bf16x8*)(qp + c * 16);
      if (MODE == 0) { const bf16* qp2 = Qb + (seq0 + qpos) * 512 + hq * 32 + hi * 8;
#pragma unroll
          for (int c = 4; c < NC; ++c) *(LAS bf16x8*)(qlds + c * 16) = *(const bf16x8*)(qp2 + (c - 4) * 16); } }
    const int skey = tid >> 3, sch = tid & 7;
    const unsigned koff = (unsigned)(skey * kvpitch + sch * 8) * 2u, roff = (unsigned)((tid >> 2) * 32 + (tid & 3) * 8) * 2u;
    const char* kgb = (const char*)(Ka + ((long)seq0 + kpos_base) * kvpitch + kvcol);
    const char* vgb = (const char*)(Va + ((long)seq0 + kpos_base) * kvpitch + kvcol);
    const char* rgb = MODE == 0 ? (const char*)(Kb + (long)seq0 * 32) : nullptr;
    const int kw_off = skey * KP + sch * 16, vw_off = KBUF + skey * VP + sch * 16, rw_off = (tid >> 2) * KP + 128 + (tid & 3) * 16;
    const int pi = (l31 & 0x13) | ((l31 & 4) << 1) | ((l31 & 8) >> 1);
    const int kr_off = pi * KP + hi * 16;
    const int vr_off = KBUF + (8 * hi + ((lane & 15) >> 2)) * VP + (16 * ((lane >> 4) & 1) + 4 * (lane & 3)) * 2;
    float m_run, l_run;
    if (MODE == 0) { m_run = -1e30f; l_run = 0.f; } else { m_run = sinks[hq] * LOG2E; l_run = hi == 0 ? 1.f : 0.f; }
    f32x16 o0 = {}, o1 = {};
    u32x4 kreg, vreg, rreg = {};
    const int kw_k = skey * KP + sch * 16, kw_r = (tid >> 2) * KP + 128 + (tid & 3) * 16, vw_v = 2 * KBUF + skey * VP + sch * 16;
    const int kr_k = pi * KP + hi * 16;
    const int vr_v = 2 * KBUF + (8 * hi + ((lane & 15) >> 2)) * VP + (16 * ((lane >> 4) & 1) + 4 * (lane & 3)) * 2;
#define AT_LOADK(t) do { kreg = *(const u32x4*)(kgb + (long)(t) * 128 * kvpitch + koff); if (MODE == 0 && tid < 256) rreg = *(const u32x4*)(rgb + (long)(t) * 64 * 64 + roff); } while (0)
#define AT_LOADV(t) do { vreg = *(const u32x4*)(vgb + (long)(t) * 128 * kvpitch + koff); } while (0)
#define AT_STOREK(bi) do { *(LAS u32x4*)(lds + (bi) * KBUF + kw_k) = kreg; if (MODE == 0 && tid < 256) *(LAS u32x4*)(lds + (bi) * KBUF + kw_r) = rreg; } while (0)
#define AT_STOREV(bi) do { *(LAS u32x4*)(lds + (bi) * VBUF + vw_v) = vreg; } while (0)
#define AT_DOIT(t) (MODE == 0 ? ((t) * 64 <= qpos0w + 31) : ((w & 3) < 2 ? ((t) <= 2) : ((t) >= 1)))
#define AT_DOMASK(t) (MODE == 0 ? ((t) * 64 + 63 > qpos0w) : true)
#define AT_QK(S0, S1, bi) do { const LAS unsigned char* kb_ = lds + (bi) * KBUF + kr_k; bf16x8 ka_[2], kc_[2], qq_[2]; \
        ka_[0] = *(const LAS bf16x8*)(kb_); kc_[0] = *(const LAS bf16x8*)(kb_ + 32 * KP); qq_[0] = *(const LAS bf16x8*)(qlds); \
        _Pragma("unroll") for (int c = 0; c < NC; ++c) { \
            if (c + 1 < NC) { ka_[(c + 1) & 1] = *(const LAS bf16x8*)(kb_ + (c + 1) * 32); kc_[(c + 1) & 1] = *(const LAS bf16x8*)(kb_ + 32 * KP + (c + 1) * 32); qq_[(c + 1) & 1] = *(const LAS bf16x8*)(qlds + (c + 1) * 16); } \
            if (c == 0) { S0 = __builtin_amdgcn_mfma_f32_32x32x16_bf16(ka_[0], qq_[0], (f32x16){}, 0, 0, 0); S1 = __builtin_amdgcn_mfma_f32_32x32x16_bf16(kc_[0], qq_[0], (f32x16){}, 0, 0, 0); } \
            else { S0 = __builtin_amdgcn_mfma_f32_32x32x16_bf16(ka_[c & 1], qq_[c & 1], S0, 0, 0, 0); S1 = __builtin_amdgcn_mfma_f32_32x32x16_bf16(kc_[c & 1], qq_[c & 1], S1, 0, 0, 0); } \
            __builtin_amdgcn_sched_barrier(0); } } while (0)
#define AT_MASK(S0, S1, t) do { const int kp0_ = kpos_base + (t) * 64; \
        _Pragma("unroll") for (int r = 0; r < 16; ++r) { const int kk = kp0_ + 16 * (r >> 3) + 8 * hi + (r & 7); const int rel0 = qpos - kk, rel1 = rel0 - 32; \
            const bool ok0 = MODE == 0 ? rel0 >= 0 : (rel0 >= 0 && rel0 < 128), ok1 = MODE == 0 ? rel1 >= 0 : (rel1 >= 0 && rel1 < 128); \
            S0[r] = ok0 ? S0[r] : -1e30f; S1[r] = ok1 ? S1[r] : -1e30f; } } while (0)
#define AT_SB() __builtin_amdgcn_sched_barrier(0)
#define AT_PA(S0, S1) do { float mx = max2f(S0[0], S1[0]); \
        _Pragma("unroll") for (int r = 1; r < 16; ++r) mx = max3f(mx, S0[r], S1[r]); \
        mx = xhalf_max(mx); mnew = max2f(m_run, mx); alpha = __builtin_amdgcn_exp2f(m_run - mnew); m_run = mnew; ps = 0.f; } while (0)
#define AT_PE(S0, S1, k) do { u32x4 a_; \
        if ((k) == 0) { _Pragma("unroll") for (int r = 0; r < 8; ++r) { S0[r] = __builtin_amdgcn_exp2f(S0[r] - mnew); ps += S0[r]; } a_.x = cvtpk(S0[0], S0[1]); a_.y = cvtpk(S0[2], S0[3]); a_.z = cvtpk(S0[4], S0[5]); a_.w = cvtpk(S0[6], S0[7]); } \
        if ((k) == 1) { _Pragma("unroll") for (int r = 8; r < 16; ++r) { S0[r] = __builtin_amdgcn_exp2f(S0[r] - mnew); ps += S0[r]; } a_.x = cvtpk(S0[8], S0[9]); a_.y = cvtpk(S0[10], S0[11]); a_.z = cvtpk(S0[12], S0[13]); a_.w = cvtpk(S0[14], S0[15]); } \
        if ((k) == 2) { _Pragma("unroll") for (int r = 0; r < 8; ++r) { S1[r] = __builtin_amdgcn_exp2f(S1[r] - mnew); ps += S1[r]; } a_.x = cvtpk(S1[0], S1[1]); a_.y = cvtpk(S1[2], S1[3]); a_.z = cvtpk(S1[4], S1[5]); a_.w = cvtpk(S1[6], S1[7]); } \
        if ((k) == 3) { _Pragma("unroll") for (int r = 8; r < 16; ++r) { S1[r] = __builtin_amdgcn_exp2f(S1[r] - mnew); ps += S1[r]; } a_.x = cvtpk(S1[8], S1[9]); a_.y = cvtpk(S1[10], S1[11]); a_.z = cvtpk(S1[12], S1[13]); a_.w = cvtpk(S1[14], S1[15]); } \
        pk[k] = __builtin_bit_cast(bf16x8, a_); } while (0)
#define AT_PR() do { l_run = l_run * alpha + ps; _Pragma("unroll") for (int r = 0; r < 16; ++r) { o0[r] *= alpha; o1[r] *= alpha; } } while (0)
#define AT_SOFTMAX(S0, S1) do { AT_PA(S0, S1); AT_PE(S0, S1, 0); AT_PE(S0, S1, 1); AT_PE(S0, S1, 2); AT_PE(S0, S1, 3); AT_PR(); } while (0)
#define AT_FUSED(SA0, SA1, SB0, SB1, bi) do { const LAS unsigned char* kb_ = lds + (bi) * KBUF + kr_k; bf16x8 ka_[2], kc_[2], qq_[2]; \
        ka_[0] = *(const LAS bf16x8*)(kb_); kc_[0] = *(const LAS bf16x8*)(kb_ + 32 * KP); qq_[0] = *(const LAS bf16x8*)(qlds); \
        _Pragma("unroll") for (int c = 0; c < NC; ++c) { \
            if (c + 1 < NC) { ka_[(c + 1) & 1] = *(const LAS bf16x8*)(kb_ + (c + 1) * 32); kc_[(c + 1) & 1] = *(const LAS bf16x8*)(kb_ + 32 * KP + (c + 1) * 32); qq_[(c + 1) & 1] = *(const LAS bf16x8*)(qlds + (c + 1) * 16); } \
            if (c == 0) { SB0 = __builtin_amdgcn_mfma_f32_32x32x16_bf16(ka_[0], qq_[0], (f32x16){}, 0, 0, 0); SB1 = __builtin_amdgcn_mfma_f32_32x32x16_bf16(kc_[0], qq_[0], (f32x16){}, 0, 0, 0); } \
            else { SB0 = __builtin_amdgcn_mfma_f32_32x32x16_bf16(ka_[c & 1], qq_[c & 1], SB0, 0, 0, 0); SB1 = __builtin_amdgcn_mfma_f32_32x32x16_bf16(kc_[c & 1], qq_[c & 1], SB1, 0, 0, 0); } \
            if (c == 0) AT_PA(SA0, SA1); \
            if (NC == 6) { if (c >= 1 && c <= 4) AT_PE(SA0, SA1, c - 1); } \
            else { if (c == 1) { AT_PE(SA0, SA1, 0); AT_PE(SA0, SA1, 1); } if (c == 2) { AT_PE(SA0, SA1, 2); AT_PE(SA0, SA1, 3); } } \
            if (c == NC - 1) AT_PR(); \
            AT_SB(); } } while (0)
#define AT_PV(bi) do { const LAS unsigned char* vb_ = lds + (bi) * VBUF + vr_v; s16x4 va_[2][4]; \
        va_[0][0] = vtr(vb_); va_[0][1] = vtr(vb_ + 4 * VP); va_[0][2] = vtr(vb_ + 64); va_[0][3] = vtr(vb_ + 4 * VP + 64); \
        _Pragma("unroll") for (int j = 0; j < 4; ++j) { \
            if (j + 1 < 4) { va_[(j + 1) & 1][0] = vtr(vb_ + (16 * (j + 1)) * VP); va_[(j + 1) & 1][1] = vtr(vb_ + (16 * (j + 1) + 4) * VP); va_[(j + 1) & 1][2] = vtr(vb_ + (16 * (j + 1)) * VP + 64); va_[(j + 1) & 1][3] = vtr(vb_ + (16 * (j + 1) + 4) * VP + 64); } \
            const s16x4 a0 = va_[j & 1][0], a1 = va_[j & 1][1], b0 = va_[j & 1][2], b1 = va_[j & 1][3]; \
            const bf16x8 va = {a0[0], a0[1], a0[2], a0[3], a1[0], a1[1], a1[2], a1[3]}, vb8 = {b0[0], b0[1], b0[2], b0[3], b1[0], b1[1], b1[2], b1[3]}; \
            o0 = __builtin_amdgcn_mfma_f32_32x32x16_bf16(va, pk[j], o0, 0, 0, 0); o1 = __builtin_amdgcn_mfma_f32_32x32x16_bf16(vb8, pk[j], o1, 0, 0, 0); AT_SB(); } } while (0)
#define AT_STEP(SA0, SA1, SB0, SB1, t) do { const int i_ = (t) - t_beg; const bool more1 = (t) + 1 < t_end, more2 = (t) + 2 < t_end; \
        if (more2) AT_LOADK((t) + 2); if (more1) AT_LOADV((t) + 1); \
        const bool d_next = more1 && AT_DOIT((t) + 1); \
        if (d_cur && AT_DOMASK(t)) AT_MASK(SA0, SA1, t); \
        bf16x8 pk[4]; float mnew, alpha, ps; \
        if (d_cur && d_next) { AT_FUSED(SA0, SA1, SB0, SB1, (i_ + 1) & 1); AT_PV(i_ & 1); } \
        else if (d_cur) { AT_SOFTMAX(SA0, SA1); AT_PV(i_ & 1); } \
        else if (d_next) { AT_QK(SB0, SB1, (i_ + 1) & 1); } \
        if (more2) AT_STOREK(i_ & 1); if (more1) AT_STOREV((i_ + 1) & 1); \
        __syncthreads(); d_cur = d_next; } while (0)
    AT_LOADK(t_beg); AT_LOADV(t_beg); AT_STOREK(0); AT_STOREV(0);
    if (t_beg + 1 < t_end) { AT_LOADK(t_beg + 1); AT_STOREK(1); }
    __syncthreads();
    f32x16 sa0 = {}, sa1 = {}, sb0 = {}, sb1 = {};
    bool d_cur = AT_DOIT(t_beg);
    if (d_cur) AT_QK(sa0, sa1, 0);
    for (int t = t_beg; t < t_end; t += 2) {
        AT_STEP(sa0, sa1, sb0, sb1, t);
        if (t + 1 < t_end) AT_STEP(sb0, sb1, sa0, sa1, t + 1);
    }
#undef AT_LOADK
#undef AT_LOADV
#undef AT_STOREK
#undef AT_STOREV
#undef AT_DOIT
#undef AT_DOMASK
#undef AT_QK
#undef AT_MASK
#undef AT_SOFTMAX
#undef AT_PV
#undef AT_STEP
#undef AT_SB
#undef AT_PA
#undef AT_PE
#undef AT_PR
#undef AT_FUSED
    const float inv = __builtin_amdgcn_rcpf(xhalf_sum(l_run));
    bf16* op = O + (seq0 + qpos) * 1024 + hq * 64 + 4 * hi;
#pragma unroll
    for (int g = 0; g < 4; ++g) { u32x2 w0, w1;
        w0.x = cvtpk(o0[4 * g] * inv, o0[4 * g + 1] * inv); w0.y = cvtpk(o0[4 * g + 2] * inv, o0[4 * g + 3] * inv);
        w1.x = cvtpk(o1[4 * g] * inv, o1[4 * g + 1] * inv); w1.y = cvtpk(o1[4 * g + 2] * inv, o1[4 * g + 3] * inv);
        *(u32x2*)(op + 8 * g) = w0; *(u32x2*)(op + 32 + 8 * g) = w1; }
}
}

__device__ __forceinline__ int swap45(int w) { return (w & 15) | (((w >> 4) & 1) << 5) | (((w >> 5) & 1) << 4); }
__device__ __forceinline__ int src_col(int which, int r) {
    switch (which) {
    case 0:
        if (r < 256) return r;
        if (r < 512) { const int p = r - 256; return p < 160 ? 256 + p : -1; }
        if (r < 1536) { const int p = r - 512; return 416 + (p & ~63) + swap45(p & 63); }
        if (r < 1792) { const int p = r - 1536; return p < 128 ? 1440 + (p & ~63) + swap45(p & 63) : 1568 + (p - 128); }
        return 1696 + (r - 1792);
    case 1:
        if (r < 1024) return (r >> 6) * 96 + (r & 63);
        { const int p = r - 1024; return (p >> 5) * 96 + 64 + (p & 31); }
    case 2:
        if (r < 1024) return (r >> 6) * 128 + (r & 63);
        { const int p = r - 1024; return (p >> 6) * 128 + 64 + (p & 63); }
    default: return r;
    }
}
__device__ __forceinline__ void transpose_item(const float* __restrict__ W, int Ks, int N, bf16* WT, int R, int Kd, int which, const float* __restrict__ gs, LAS float* scr, int item, int lane) {
    const int nblk = R / 32, kb = item / nblk, nb = item % nblk, k0 = 64 * kb, n0 = 32 * nb;
    const int sc = src_col(which, n0 + (lane & 31));
    float vals[32];
#pragma unroll
    for (int i = 0; i < 32; ++i) { const int k = k0 + 2 * i + (lane >> 5); float v = 0.f;
        if (sc >= 0 && k < Ks) { v = W[(size_t)k * N + sc]; if (gs) v *= gs[k]; }
        vals[i] = v; }
#pragma unroll
    for (int i = 0; i < 32; ++i) scr[(2 * i + (lane >> 5)) * 33 + (lane & 31)] = vals[i];
    asm volatile("s_waitcnt lgkmcnt(0)" ::: "memory");
    const int c = lane & 7;
#pragma unroll
    for (int j = 0; j < 4; ++j) { const int n = (lane >> 3) + 8 * j; const LAS float* s = scr + (8 * c) * 33 + n;
        u32x4 o; o.x = cvtpk(s[0 * 33], s[1 * 33]); o.y = cvtpk(s[2 * 33], s[3 * 33]); o.z = cvtpk(s[4 * 33], s[5 * 33]); o.w = cvtpk(s[6 * 33], s[7 * 33]);
        *(u32x4*)(WT + (size_t)(n0 + n) * Kd + k0 + 8 * c) = o; }
    asm volatile("s_waitcnt lgkmcnt(0)" ::: "memory");
}


__device__ __forceinline__ float sum16(const float* p) { const f32x4* q = (const f32x4*)p; const f32x4 a = q[0], b = q[1], c = q[2], d = q[3];
    return (((a[0] + a[1]) + (a[2] + a[3])) + ((b[0] + b[1]) + (b[2] + b[3]))) + (((c[0] + c[1]) + (c[2] + c[3])) + ((d[0] + d[1]) + (d[2] + d[3]))); }
template <bool FIRST>
__device__ __forceinline__ void rowpass(const float* xin, float* xo, const bf16* T, const float* part_t, const float* gpost, const float* gpre, bf16* XN, const float* part_e, float* rstd_e, int gw, int NGW, int lane) {
    for (int row0 = gw; row0 < M; row0 += 2 * NGW) {
        f32x4 xv[2][4]; u32x4 tw[2][2]; float rt[2];
#pragma unroll
        for (int r2 = 0; r2 < 2; ++r2) { const size_t row = (size_t)(row0 + r2 * NGW);
#pragma unroll
            for (int j = 0; j < 2; ++j) { const int col = 512 * j + 8 * lane; tw[r2][j] = *(const u32x4*)(T + row * DM + col);
                xv[r2][2 * j] = *(const f32x4*)(xin + row * DM + col); xv[r2][2 * j + 1] = *(const f32x4*)(xin + row * DM + col + 4); }
            rt[r2] = __builtin_amdgcn_rsqf(sum16(part_t + row * 16) * (1.0f / DM) + EPS); }
#pragma unroll
        for (int r2 = 0; r2 < 2; ++r2) { const size_t row = (size_t)(row0 + r2 * NGW); float ss = 0.f;
#pragma unroll
            for (int j = 0; j < 2; ++j) { const int col = 512 * j + 8 * lane;
                const f32x4 ta = unpack4((u32x2){tw[r2][j].x, tw[r2][j].y}), tb = unpack4((u32x2){tw[r2][j].z, tw[r2][j].w});
                const f32x4 ga = *(const f32x4*)(gpost + col), gb = *(const f32x4*)(gpost + col + 4);
                xv[r2][2 * j] += ta * rt[r2] * ga; xv[r2][2 * j + 1] += tb * rt[r2] * gb; ss += dot4(xv[r2][2 * j]) + dot4(xv[r2][2 * j + 1]);
                *(f32x4*)(xo + row * DM + col) = xv[r2][2 * j]; *(f32x4*)(xo + row * DM + col + 4) = xv[r2][2 * j + 1]; }
            if (FIRST) { const float r1 = __builtin_amdgcn_rsqf(wave_sum(ss) * (1.0f / DM) + EPS);
#pragma unroll
                for (int j = 0; j < 2; ++j) { const int col = 512 * j + 8 * lane; const f32x4 ga = *(const f32x4*)(gpre + col), gb = *(const f32x4*)(gpre + col + 4);
                    const u32x2 a = pack4(xv[r2][2 * j] * r1 * ga), b2 = pack4(xv[r2][2 * j + 1] * r1 * gb); *(u32x4*)(XN + row * DM + col) = (u32x4){a.x, a.y, b2.x, b2.y}; }
            } else {
#pragma unroll
                for (int j = 0; j < 2; ++j) { const int col = 512 * j + 8 * lane; const u32x2 a = pack4(xv[r2][2 * j]), b2 = pack4(xv[r2][2 * j + 1]); *(u32x4*)(XN + row * DM + col) = (u32x4){a.x, a.y, b2.x, b2.y}; }
                if (lane == 0) rstd_e[row] = __builtin_amdgcn_rsqf(sum16(part_e + row * 16) * (1.0f / DM) + EPS); }
        }
    }
}

#define XB_TMO      128
#define XB_XCNT(j)  (256  + 64 * (j))
#define XB_XSUB(j)  (1280 + 64 * (j))
#define XB_XGEN(j)  (2304 + 64 * (j))
#define XB_TOP      3328
#define XB_TOPGEN   3392
#define XCD_BAR_WORDS 3456
#define XB_SPIN_CAP (1u << 18)

__device__ __forceinline__ unsigned xb_ld(unsigned* p)              { return __hip_atomic_load(p, __ATOMIC_RELAXED, __HIP_MEMORY_SCOPE_AGENT); }
__device__ __forceinline__ unsigned xb_add(unsigned* p, unsigned v) { return __hip_atomic_fetch_add(p, v, __ATOMIC_RELAXED, __HIP_MEMORY_SCOPE_AGENT); }
__device__ __forceinline__ unsigned xb_xcc_id() { return (unsigned)__builtin_amdgcn_s_getreg((3 << 11) | 20) & 0xFu; }
#define XB_SPIN(cond, bar) do { unsigned _sp = 0; while (cond) { __builtin_amdgcn_s_sleep(1); \
    if ((++_sp & 255u) == 0u) { if (xb_ld(&(bar)[XB_TMO])) break; if (_sp > XB_SPIN_CAP) { atomicAdd(&(bar)[XB_TMO], 1u); break; } } } } while (0)

struct XcdBarrier {
    unsigned* bar; unsigned x;
    volatile LAS unsigned* st;
};

__device__ __forceinline__ XcdBarrier xcd_barrier_post(unsigned* bar, volatile LAS unsigned* st) {
    XcdBarrier b; b.bar = bar; b.x = xb_xcc_id(); b.st = st;
    if (threadIdx.x == 0) (void)xb_add(&bar[XB_XCNT(b.x)], 1u);
    return b;
}
__device__ __forceinline__ void xcd_barrier_complete(unsigned* bar, unsigned x, unsigned& nloc, unsigned& nx) {
    const unsigned G = gridDim.x * gridDim.y * gridDim.z;
    unsigned sum, cnt, mine, sp = 0u;
    for (;;) {
        sum = 0u; cnt = 0u; mine = 0u;
#pragma unroll
        for (unsigned j = 0; j < 16; ++j) { const unsigned c = xb_ld(&bar[XB_XCNT(j)]); sum += c; cnt += (c > 0u) ? 1u : 0u; mine = (j == x) ? c : mine; }
        if (sum == G) break;
        __builtin_amdgcn_s_sleep(1);
        if ((++sp & 255u) == 0u) { if (xb_ld(&bar[XB_TMO])) break; if (sp > XB_SPIN_CAP) { atomicAdd(&bar[XB_TMO], 1u); break; } }
    }
    nloc = mine > 0u ? mine : 1u; nx = cnt > 0u ? cnt : 1u;
}

__device__ __forceinline__ void xcd_barrier(const XcdBarrier& b) {
    asm volatile("s_waitcnt vmcnt(0)" ::: "memory");
    __syncthreads();
    if (threadIdx.x == 0) {
        unsigned* bar = b.bar;
        __builtin_amdgcn_s_waitcnt(0);
        unsigned nloc = b.st[0], nx = b.st[1];
        if (nloc == 0u) { xcd_barrier_complete(bar, b.x, nloc, nx); b.st[0] = nloc; b.st[1] = nx; }
        const unsigned old = xb_add(&bar[XB_XSUB(b.x)], 1u);
        const unsigned gen = old / nloc;
        if (old + 1u == (gen + 1u) * nloc) {
            __builtin_amdgcn_fence(__ATOMIC_RELEASE, "agent");
            asm volatile("s_waitcnt vmcnt(0)" ::: "memory");
            const unsigned og = xb_add(&bar[XB_TOP], 1u);
            const unsigned tg = og / nx;
            if (og + 1u == (tg + 1u) * nx) xb_add(&bar[XB_TOPGEN], 1u);
            else XB_SPIN(xb_ld(&bar[XB_TOPGEN]) == tg, bar);
            __builtin_amdgcn_fence(__ATOMIC_ACQUIRE, "agent");
            xb_add(&bar[XB_XGEN(b.x)], 1u);
            asm volatile("s_waitcnt vmcnt(0)" ::: "memory");
        } else {
            XB_SPIN(xb_ld(&bar[XB_XGEN(b.x)]) == gen, bar);
            __builtin_amdgcn_fence(__ATOMIC_ACQUIRE, "agent");
            asm volatile("s_waitcnt vmcnt(0)" ::: "memory");
        }
    }
    __syncthreads();
}

__global__ void __launch_bounds__(NWAVES * 64, 2) mega_fwd(Params P) {
    extern __shared__ __attribute__((aligned(16))) unsigned char lds_raw[];
    LAS unsigned char* lds = (LAS unsigned char*)lds_raw;
    const int tid = threadIdx.x, lane = tid & 63, wave = __builtin_amdgcn_readfirstlane(tid >> 6);
    const int G = gridDim.x, bx = blockIdx.x, vcu = (G % 8 == 0) ? (bx % 8) * (G / 8) + bx / 8 : bx;
    const int gw = vcu * NWAVES + wave, NGW = G * NWAVES;
    const int lo = P.ph_lo, hi = P.ph_hi;
#ifndef PH_MASK
#define PH_MASK 0x7ff
#endif
#define IN(k) (((PH_MASK >> (k)) & 1) && lo <= (k) && (k) < hi)
#ifdef PROBE_A
    unsigned long long t_a = 0, t_b = 0;
#define STAMP(id) do { if ((id) == PROBE_A) t_a = __builtin_amdgcn_s_memrealtime(); if ((id) == PROBE_B) t_b = __builtin_amdgcn_s_memrealtime(); } while (0)
#else
#define STAMP(id) do { } while (0)
#endif
    volatile LAS unsigned* bst = (volatile LAS unsigned*)(lds + 128 * 1024);
    if (tid < 2) bst[tid] = 0u;
    __syncthreads();
    XcdBarrier xbar = xcd_barrier_post((unsigned*)(P.ws + WS_CTL) + 1024, bst);
#define SEAM(k) do { if (IN(k) && IN((k) + 1)) { if ((k) == 0) cg::this_grid().sync(); else xcd_barrier(xbar); } STAMP((k) + 1); } while (0)
    STAMP(0);
#define tab ((const f32x2*)(P.ws + WS_TAB))
#define XN ((bf16*)(P.ws + WS_XN))
#define part_q ((float*)(P.ws + WS_PQ))
#define part_kv ((float*)(P.ws + WS_PKV))
#define part_t ((float*)(P.ws + WS_PT))
#define part_e ((float*)(P.ws + WS_PE))
#define rstd_e ((float*)(P.ws + WS_RSTDE))
#define gates ((bf16*)P.out)

    if (IN(0)) {
        LAS float* scr = (LAS float*)(lds + wave * 16384);
        int it = gw;
#define TR(IN_, KS, N_, R_, KD, WHICH, GSP, OFF) { const int nit = ((KD) / 64) * ((R_) / 32); for (; it < nit; it += NGW) transpose_item(P.in[IN_], KS, N_, (bf16*)(P.ws + (OFF)), R_, KD, WHICH, GSP, scr, it, lane); it -= nit; }
        TR(3, 1024, 3744, N_IN_PAD, 1024, 0, nullptr, WS_WIN)
        TR(5, 256, 1536, 1536, 256, 1, P.in[4], WS_WQKV)
        TR(7, 128, 2048, 2048, 256, 2, P.in[6], WS_WQKV + (size_t)1536 * 256 * 2)
        TR(17, 256, 1024, 1024, 256, 3, nullptr, WS_WPP)
        TR(9, 1024, 1024, 1024, 1024, 3, nullptr, WS_WUP)
        TR(10, 1024, 1024, 1024, 1024, 3, nullptr, WS_WUP + (size_t)1024 * 1024 * 2)
        TR(11, 1024, 1024, 1024, 1024, 3, nullptr, WS_WOUT)
        TR(14, 1024, 4096, 4096, 1024, 3, nullptr, WS_W1)
        TR(15, 4096, 1024, 1024, 4096, 3, nullptr, WS_W2)
        TR(19, 1024, 1024, 1024, 1024, 3, nullptr, WS_WPG)
#undef TR
        { const float* x = P.in[0]; const float* g = P.in[2];
          for (int row0 = gw; row0 < M; row0 += 2 * NGW) {
              f32x4 v[2][4], pv[2]; float ss[2] = {0.f, 0.f};
#pragma unroll
              for (int r2 = 0; r2 < 2; ++r2) { const int row = row0 + r2 * NGW; const f32x4* xr = (const f32x4*)(x + (size_t)row * DM);
#pragma unroll
                  for (int j = 0; j < 4; ++j) v[r2][j] = xr[lane + 64 * j];
                  pv[r2] = ((const f32x4*)(P.in[1] + (size_t)row * 256))[lane]; }
#pragma unroll
              for (int r2 = 0; r2 < 2; ++r2) { const int row = row0 + r2 * NGW;
#pragma unroll
                  for (int j = 0; j < 4; ++j) ss[r2] += dot4(v[r2][j]);
                  const float rs = __builtin_amdgcn_rsqf(wave_sum(ss[r2]) * (1.0f / DM) + EPS);
#pragma unroll
                  for (int j = 0; j < 4; ++j) { const f32x4 gg = ((const f32x4*)g)[lane + 64 * j]; *(u32x2*)(XN + (size_t)row * DM + 4 * (lane + 64 * j)) = pack4(v[r2][j] * rs * gg); }
                  *(u32x2*)((bf16*)(P.ws + WS_PB) + (size_t)row * 256 + 4 * lane) = pack4(pv[r2]); }
          } }
        for (int i = (vcu * NWAVES + wave) * 64 + lane; i < SEQ * 32; i += NGW * 64) {
            const int pos = i >> 5, j = i & 31; const float inv = expf(-9.210340371976184f * (float)j * (2.0f / 64.0f)); const float ang = (float)pos * inv;
            ((f32x2*)(P.ws + WS_TAB))[i] = (f32x2){cosf(ang), sinf(ang)}; }
    }
    SEAM(0);
    if (IN(1)) {
        pg8::Gemm g{XN, (const bf16*)(P.ws + WS_WIN), M, N_IN_PAD, 1024}; Sched S = make_sched(G, bx, 15);
        EpiP1 E{(bf16*)(P.ws + WS_QA), (bf16*)(P.ws + WS_KVR), (bf16*)(P.ws + WS_KROPE), (bf16*)(P.ws + WS_QS), (bf16*)(P.ws + WS_KS), (bf16*)(P.ws + WS_VS), gates, part_q, part_kv, tab};
        pg8::gemm_phase<EpiP1, Sched, true, true>(lds, g, S, E);
    }
    SEAM(1);
    if (IN(2)) {
        pg8::Gemm g{(const bf16*)(P.ws + WS_QA), (const bf16*)(P.ws + WS_WQKV), 2 * M, 3584, 256};
        Sched S = make_sched(G, bx, 6); S.nseg = 2; S.nN[1] = 8; S.pmo[1] = 128; S.pno[1] = 6; S.start[1] = 768; S.start[2] = 768 + 1024;
        EpiP2 E{(bf16*)(P.ws + WS_QN), (bf16*)(P.ws + WS_QR), (bf16*)(P.ws + WS_KN), (bf16*)(P.ws + WS_VM), part_q, part_kv, tab};
        pg8::gemm_phase<EpiP2, Sched, true, true>(lds, g, S, E);
    }
    SEAM(2);
    if (IN(3)) {
        for (int U = vcu; U < 2048; U += G) {
            const int c8 = U & 255, i = U >> 8, bh = c8 >> 1, s = c8 & 1, k = i >> 1, qb = (i & 1) ? 15 - 2 * k - s : 2 * k + s;
            att::unit<0>(lds, (const bf16*)(P.ws + WS_QN), (const bf16*)(P.ws + WS_QR), (const bf16*)(P.ws + WS_KN), (const bf16*)(P.ws + WS_KROPE), (const bf16*)(P.ws + WS_VM), (bf16*)(P.ws + WS_QN), nullptr, bh >> 4, bh & 15, qb, 0);
        }
        STAMP(12);
        for (int U = vcu; U < 2048; U += G) {
            const int hp = U & 3, n = (U >> 2) & 31, g = (U >> 7) & 1, b = U >> 8;
            att::unit<1>(lds, (const bf16*)(P.ws + WS_QS), nullptr, (const bf16*)(P.ws + WS_KS), nullptr, (const bf16*)(P.ws + WS_VS), (bf16*)(P.ws + WS_QS), P.in[8], b, g, n, hp);
        }
    }
    SEAM(3);
    if (IN(4)) {
        pg8::Gemm g{(const bf16*)(P.ws + WS_QN), (const bf16*)(P.ws + WS_WUP), 2 * M, 2048, 1024}; Sched S = make_sched(G, bx, 4); S.pairs = 1;
        EpiP4 E{gates, XN, (bf16*)(P.ws + WS_QA)};
        pg8::gemm_phase<EpiP4, Sched, true, true>(lds, g, S, E);
    }
    SEAM(4);
    if (IN(5)) {
        pg8::Gemm g{XN, (const bf16*)(P.ws + WS_WOUT), M, 1024, 1024}; Sched S = make_sched(G, bx, 4);
        EpiT E{(bf16*)(P.ws + WS_T), part_t};
        pg8::gemm_phase<EpiT, Sched, true, true>(lds, g, S, E);
    }
    SEAM(5);
    if (IN(6)) rowpass<true>(P.in[0], P.out, (const bf16*)(P.ws + WS_T), part_t, P.in[12], P.in[13], XN, nullptr, nullptr, gw, NGW, lane);
    SEAM(6);
    if (IN(7)) {
        pg8::Gemm g{XN, (const bf16*)(P.ws + WS_W1), M, FF, 1024}; Sched S = make_sched(G, bx, 16);
        EpiRelu2 E{(bf16*)(P.ws + WS_U)};
        pg8::gemm_phase<EpiRelu2, Sched, true, true>(lds, g, S, E);
    }
    SEAM(7);
    if (IN(8)) {
        { pg8::Gemm g{(const bf16*)(P.ws + WS_U), (const bf16*)(P.ws + WS_W2), M, 1024, FF}; Sched S = make_sched(G, bx, 4);
          EpiT E{(bf16*)(P.ws + WS_T), part_t};
          pg8::gemm_phase<EpiT, Sched, true, true>(lds, g, S, E); }
        { pg8::Gemm g{(const bf16*)(P.ws + WS_PB), (const bf16*)(P.ws + WS_WPP), M, 1024, 256}; Sched S = make_sched(G, bx, 4);
          EpiT E{(bf16*)(P.ws + WS_ERAW), part_e};
          pg8::gemm_phase<EpiT, Sched, true, true>(lds, g, S, E); }
    }
    SEAM(8);
    if (IN(9)) rowpass<false>(P.out, P.out, (const bf16*)(P.ws + WS_T), part_t, P.in[16], nullptr, XN, part_e, rstd_e, gw, NGW, lane);
    SEAM(9);
    if (IN(10)) {
        pg8::Gemm g{XN, (const bf16*)(P.ws + WS_WPG), M, 1024, 1024}; Sched S = make_sched(G, bx, 4);
        EpiOut E{P.out, (const bf16*)(P.ws + WS_ERAW), rstd_e, P.in[18]};
        pg8::gemm_phase<EpiOut, Sched, true, true>(lds, g, S, E);
    }
    STAMP(11);
#ifdef PROBE_A
    cg::this_grid().sync();
    STAMP(13); cg::this_grid().sync(); cg::this_grid().sync(); cg::this_grid().sync(); cg::this_grid().sync(); STAMP(14);
    if (bx == 0 && tid == 0) P.out[0] += (float)(((t_b - t_a) / PROBE_Q) * (PROBE_Q / 100ull));
#endif
#undef IN
#undef SEAM
#undef tab
#undef XN
#undef part_q
#undef part_kv
#undef part_t
#undef part_e
#undef rstd_e
#undef gates
}

extern "C" void kernel_launch(void* const* d_in, const int* in_sizes, int n_in, void* d_out, int out_size, void* d_ws, size_t ws_size, hipStream_t stream) {
    static int grid = 0;
    if (grid == 0) {
        int dev = 0, cus = 0, per_cu = 0;
        hipGetDevice(&dev); hipDeviceGetAttribute(&cus, hipDeviceAttributeMultiprocessorCount, dev);
        if (hipFuncSetAttribute((const void*)mega_fwd, hipFuncAttributeMaxDynamicSharedMemorySize, LDS_BYTES) != hipSuccess) { fprintf(stderr, "hipFuncSetAttribute failed\n"); }
        if (hipOccupancyMaxActiveBlocksPerMultiprocessor(&per_cu, (const void*)mega_fwd, NWAVES * 64, LDS_BYTES) != hipSuccess || per_cu < 1) { fprintf(stderr, "occupancy query: %d\n", per_cu); per_cu = 1; }
        (void)hipGetLastError();
        grid = cus * per_cu;
        if (n_in != 20 || ws_size < WS_END) fprintf(stderr, "kernel_launch: unexpected n_in %d / ws %zu\n", n_in, ws_size);
    }
    Params p{};
    for (int i = 0; i < 20; ++i) p.in[i] = (const float*)d_in[i];
    p.out = (float*)d_out; p.ws = (unsigned char*)d_ws;
#if MK_N_LAUNCHES == 1
    (void)hipMemsetAsync((unsigned char*)d_ws + WS_CTL, 0, CTL_BYTES, stream);
    p.ph_lo = 0; p.ph_hi = 11;
    void* args[] = {&p};
    hipError_t e = hipLaunchCooperativeKernel((const void*)mega_fwd, dim3(grid), dim3(NWAVES * 64), args, LDS_BYTES, stream);
    if (e != hipSuccess) fprintf(stderr, "cooperative launch failed: %s (grid %d)\n", hipGetErrorString(e), grid);
#else
    for (int k = 0; k < 11; ++k) { p.ph_lo = k; p.ph_hi = k + 1; hipLaunchKernelGGL(mega_fwd, dim3(grid), dim3(NWAVES * 64), LDS_BYTES, stream, p); }
#endif
}
```

```cpp
#include <hip/hip_runtime.h>
#include <hip/hip_cooperative_groups.h>
#include <cstdio>
#include <cstdint>
namespace cg = cooperative_groups;
#ifndef MK_N_LAUNCHES
#define MK_N_LAUNCHES 1
#endif
namespace pg8 {
#define PG8_LAS __attribute__((address_space(3)))
typedef unsigned short bf16_t;
typedef short bf16x8 __attribute__((ext_vector_type(8)));
typedef float f32x4 __attribute__((ext_vector_type(4)));
typedef unsigned u32x4 __attribute__((ext_vector_type(4)));
constexpr int BM = 256, BK = 64, HALF = 128, HTB = HALF * BK * 2  , STAGE_BYTES = 8 * HTB, NXCD = 8, WGM = 8;

__host__ __device__ __forceinline__ int lds_byte(int r, int c) { const int st = (r >> 4) * 2 + (c >> 5), rr = r & 15, cc = c & 31, ob = rr * 64 + cc * 2; return st * 1024 + (ob ^ (((ob >> 9) & 1) << 5)); }
__host__ __device__ __forceinline__ void stage_rc(int b, int& R, int& C) { const int st = b / 1024, sb = b % 1024, swz = sb ^ (((sb >> 9) & 1) << 5); R = (st >> 1) * 16 + swz / 64; C = (st & 1) * 32 + (swz % 64) / 2; }
__host__ __device__ __forceinline__ int perm32(int rho) { const int n = rho >> 4, i = rho & 15; return 8 * (i >> 2) + 4 * n + (i & 3); }

struct Unit { int pm, pn, kind; };
struct Gemm { const bf16_t* A; const bf16_t* Bt; int M, N, K; };

template <class Epi, class Sched, bool ALIGN_EPI = false, bool SP2 = false>
__device__ __forceinline__ void gemm_phase(PG8_LAS unsigned char* lds, const Gemm g, const Sched& S, const Epi& E) {
    const int tid = threadIdx.x, wid = __builtin_amdgcn_readfirstlane(tid >> 6), lane = tid & 63, wr = wid >> 2, wc = wid & 3, fr = lane & 15, fq = lane >> 4;
    int K_ = g.K; asm volatile("" : "+s"(K_));
    const int K = K_, nt = K / BK;
    unsigned voffA[2], voffB[2];
#pragma unroll
    for (int i = 0; i < 2; ++i) { int R, C; stage_rc(tid * 16 + i * 8192, R, C); const int Rb = Epi::PERM ? ((R & ~31) + perm32(R & 31)) : R;
        voffA[i] = (unsigned)(R * K + C) * 2u; voffB[i] = (unsigned)(Rb * K + C) * 2u; }
    const size_t kstep = (size_t)(BK * 2);
    const size_t hstep = (size_t)HALF * K * 2;
    const size_t tstep = 2 * hstep;
    const unsigned ldsw = (unsigned)wid * 1024u;
    const int aoff = lds_byte(wr * 64 + fr, fq * 8), boff = lds_byte(wc * 32 + fr, fq * 8);
#define PG8_SA(b, h) (((b) * 2 + (h)) * HTB)
#define PG8_SB(b, h) ((4 + (b) * 2 + (h)) * HTB)
#define PG8_STAGE(bufoff, gbase, voff) do { _Pragma("unroll") for (int _i = 0; _i < 2; ++_i) \
        __builtin_amdgcn_global_load_lds((const unsigned*)((const char*)(gbase) + (voff)[_i]), (PG8_LAS unsigned*)(lds + (bufoff) + ldsw + _i * 8192), 16, 0, 0); } while (0)
#define PG8_LDA(dst, b, h) do { _Pragma("unroll") for (int m = 0; m < 4; ++m) _Pragma("unroll") for (int k = 0; k < 2; ++k) dst[m][k] = *(const PG8_LAS bf16x8*)(lds + PG8_SA(b, h) + aoff + m * 2048 + k * 1024); } while (0)
#define PG8_LDB(dst, b, h) do { _Pragma("unroll") for (int n = 0; n < 2; ++n) _Pragma("unroll") for (int k = 0; k < 2; ++k) dst[n][k] = *(const PG8_LAS bf16x8*)(lds + PG8_SB(b, h) + boff + n * 2048 + k * 1024); } while (0)
#define PG8_MMA(ai, bj, At, Bt) do { __builtin_amdgcn_s_setprio(1); _Pragma("unroll") for (int m = 0; m < 4; ++m) _Pragma("unroll") for (int n = 0; n < 2; ++n) _Pragma("unroll") for (int k = 0; k < 2; ++k) \
        acc[ai][bj][m][n] = __builtin_amdgcn_mfma_f32_16x16x32_bf16(Bt[n][k], At[m][k], acc[ai][bj][m][n], 0, 0, 0); __builtin_amdgcn_s_setprio(0); } while (0)
#define PG8_WAIT_V(n) asm volatile("s_waitcnt vmcnt(" #n ")" ::: "memory")
#define PG8_WAIT_L(n) asm volatile("s_waitcnt lgkmcnt(" #n ")" ::: "memory")
#define PG8_BAR __builtin_amdgcn_s_barrier()
#define PG8_SCHED __builtin_amdgcn_sched_barrier(0)
    Unit cur, nxt; int ui = 0;
    if (!S.next(0, cur)) return;
    f32x4 acc[2][2][4][2];
#pragma unroll
    for (int a = 0; a < 2; ++a)
#pragma unroll
        for (int b = 0; b < 2; ++b)
#pragma unroll
            for (int m = 0; m < 4; ++m)
#pragma unroll
                for (int n = 0; n < 2; ++n) acc[a][b][m][n] = (f32x4){0.f, 0.f, 0.f, 0.f};
    bf16x8 At[4][2], B0[2][2], B1[2][2];
    const char* cA = (const char*)g.A + (size_t)cur.pm * tstep; const char* cB = (const char*)g.Bt + (size_t)cur.pn * tstep;
    S.a_ready(cur);
    if constexpr (SP2) {
        PG8_STAGE(PG8_SB(0, 0), cB, voffB); PG8_STAGE(PG8_SB(0, 1), cB + hstep, voffB); PG8_STAGE(PG8_SA(0, 0), cA, voffA); PG8_STAGE(PG8_SA(0, 1), cA + hstep, voffA);
        if (wr == 1) PG8_BAR;
        PG8_WAIT_V(2); PG8_BAR;
        PG8_STAGE(PG8_SB(1, 0), cB + kstep, voffB); PG8_STAGE(PG8_SA(1, 0), cA + kstep, voffA); PG8_STAGE(PG8_SB(1, 1), cB + hstep + kstep, voffB);
        PG8_WAIT_V(6); PG8_BAR;
    } else {
        PG8_STAGE(PG8_SB(0, 0), cB, voffB); PG8_STAGE(PG8_SA(0, 0), cA, voffA); PG8_STAGE(PG8_SB(0, 1), cB + hstep, voffB); PG8_STAGE(PG8_SA(0, 1), cA + hstep, voffA);
        if (wr == 1) PG8_BAR;
        PG8_WAIT_V(4); PG8_BAR;
        PG8_STAGE(PG8_SB(1, 0), cB + kstep, voffB); PG8_STAGE(PG8_SA(1, 0), cA + kstep, voffA); PG8_STAGE(PG8_SB(1, 1), cB + hstep + kstep, voffB);
        PG8_WAIT_V(6); PG8_BAR;
    }
    for (;;) {
        const bool has_next = S.next(ui + 1, nxt);
        const char* nA = has_next ? (const char*)g.A + (size_t)nxt.pm * tstep : cA; const char* nB = has_next ? (const char*)g.Bt + (size_t)nxt.pn * tstep : cB;
        for (int t = 0; t < nt; t += 2) {
            const bool last = (t == nt - 2);
            const char* a1 = cA + (size_t)(t + 1) * kstep;
            const char* a2 = last ? nA : cA + (size_t)(t + 2) * kstep; const char* b2 = last ? nB : cB + (size_t)(t + 2) * kstep;
            const char* a3 = a2 + kstep; const char* b3 = b2 + kstep;
            if (last && has_next) S.a_ready(nxt);
            if constexpr (SP2) {
            PG8_LDB(B0, 0, 0); PG8_LDB(B1, 0, 1); PG8_SCHED; PG8_LDA(At, 0, 0); PG8_STAGE(PG8_SA(1, 1), a1 + hstep, voffA);
            PG8_WAIT_V(8); PG8_WAIT_L(0); PG8_BAR; PG8_MMA(0, 0, At, B0); PG8_MMA(0, 1, At, B1); PG8_BAR; PG8_SCHED;
            PG8_LDA(At, 0, 1); PG8_STAGE(PG8_SB(0, 0), b2, voffB); PG8_STAGE(PG8_SB(0, 1), b2 + hstep, voffB); PG8_STAGE(PG8_SA(0, 0), a2, voffA);
            PG8_WAIT_V(8); PG8_WAIT_L(0); PG8_BAR; PG8_MMA(1, 0, At, B0); PG8_MMA(1, 1, At, B1); PG8_BAR; PG8_SCHED;
            PG8_LDB(B0, 1, 0); PG8_LDB(B1, 1, 1); PG8_SCHED; PG8_LDA(At, 1, 0); PG8_STAGE(PG8_SA(0, 1), a2 + hstep, voffA);
            PG8_WAIT_V(8); PG8_WAIT_L(0); PG8_BAR; PG8_MMA(0, 0, At, B0); PG8_MMA(0, 1, At, B1); PG8_BAR; PG8_SCHED;
            PG8_LDA(At, 1, 1); PG8_STAGE(PG8_SB(1, 0), b3, voffB); PG8_STAGE(PG8_SB(1, 1), b3 + hstep, voffB); PG8_STAGE(PG8_SA(1, 0), a3, voffA);
            PG8_WAIT_V(8); PG8_WAIT_L(0); PG8_BAR; PG8_MMA(1, 0, At, B0); PG8_MMA(1, 1, At, B1); PG8_BAR; PG8_SCHED;
            } else {
            PG8_LDB(B0, 0, 0); PG8_SCHED; PG8_LDA(At, 0, 0); PG8_STAGE(PG8_SA(1, 1), a1 + hstep, voffA);
            PG8_WAIT_L(8); PG8_BAR; PG8_WAIT_L(0); PG8_MMA(0, 0, At, B0); PG8_BAR; PG8_SCHED;
            PG8_LDB(B1, 0, 1); PG8_STAGE(PG8_SB(0, 0), b2, voffB);
            PG8_BAR; PG8_WAIT_L(0); PG8_MMA(0, 1, At, B1); PG8_BAR;
            PG8_LDA(At, 0, 1); PG8_STAGE(PG8_SA(0, 0), a2, voffA);
            PG8_BAR; PG8_WAIT_L(0); PG8_MMA(1, 0, At, B0); PG8_BAR; PG8_SCHED;
            PG8_STAGE(PG8_SB(0, 1), b2 + hstep, voffB);
            PG8_WAIT_V(6); PG8_BAR; PG8_MMA(1, 1, At, B1); PG8_BAR;
            PG8_LDB(B0, 1, 0); PG8_SCHED; PG8_LDA(At, 1, 0); PG8_STAGE(PG8_SA(0, 1), a2 + hstep, voffA);
            PG8_WAIT_L(8); PG8_BAR; PG8_WAIT_L(0); PG8_MMA(0, 0, At, B0); PG8_BAR; PG8_SCHED;
            PG8_LDB(B1, 1, 1); PG8_STAGE(PG8_SB(1, 0), b3, voffB);
            PG8_BAR; PG8_WAIT_L(0); PG8_MMA(0, 1, At, B1); PG8_BAR;
            PG8_LDA(At, 1, 1); PG8_STAGE(PG8_SA(1, 0), a3, voffA);
            PG8_BAR; PG8_WAIT_L(0); PG8_MMA(1, 0, At, B0); PG8_BAR; PG8_SCHED;
            PG8_STAGE(PG8_SB(1, 1), b3 + hstep, voffB);
            PG8_WAIT_V(6); PG8_BAR; PG8_MMA(1, 1, At, B1); PG8_BAR;
            }
        }
        if constexpr (ALIGN_EPI) { if (wr == 0) PG8_BAR; }
        if constexpr (!Epi::AFTER_DRAIN) { if (cur.kind & 0x100) E.mid(acc, cur, wr, wc, fr, fq); else E(acc, cur, wr, wc, fr, fq); S.done(cur); }
        if (!has_next) break;
        {
#pragma unroll
        for (int a = 0; a < 2; ++a)
#pragma unroll
            for (int b = 0; b < 2; ++b)
#pragma unroll
                for (int m = 0; m < 4; ++m)
#pragma unroll
                    for (int n = 0; n < 2; ++n) acc[a][b][m][n] = (f32x4){0.f, 0.f, 0.f, 0.f};
        }
        cur = nxt; cA = nA; cB = nB; ++ui;
        if constexpr (ALIGN_EPI) { if (wr == 1) PG8_BAR; }
    }
    PG8_WAIT_V(0);
    if constexpr (!ALIGN_EPI) { if (wr == 0) PG8_BAR; }
    PG8_BAR;
    if constexpr (Epi::AFTER_DRAIN) { E.fused(acc, cur, wr, wc, fr, fq, lds, wid, lane); S.done(cur); }
#undef PG8_SA
#undef PG8_SB
#undef PG8_STAGE
#undef PG8_LDA
#undef PG8_LDB
#undef PG8_MMA
#undef PG8_WAIT_V
#undef PG8_WAIT_L
#undef PG8_BAR
#undef PG8_SCHED
}
}

#define LAS __attribute__((address_space(3)))
typedef unsigned short bf16;
typedef float f32x4 __attribute__((ext_vector_type(4)));
typedef float f32x2 __attribute__((ext_vector_type(2)));
typedef float f32x16 __attribute__((ext_vector_type(16)));
typedef short bf16x8 __attribute__((ext_vector_type(8)));
typedef short s16x4 __attribute__((ext_vector_type(4)));
typedef unsigned u32x4 __attribute__((ext_vector_type(4)));
typedef unsigned u32x2 __attribute__((ext_vector_type(2)));
typedef __bf16 bf16x2_t __attribute__((ext_vector_type(2)));

constexpr int DM = 1024, SEQ = 4096, NB = 8, M = NB * SEQ, FF = 4096;
constexpr int NWAVES = 8;
constexpr float EPS = 1e-6f, LOG2E = 1.4426950408889634f;
constexpr float C2_MLA = 0.10206207261596575f * LOG2E;
constexpr float C2_SWA = 0.125f * LOG2E;
constexpr int N_IN_PAD = 3840;

constexpr size_t MiB = 1u << 20;
constexpr size_t WS_CTL = 0, CTL_BYTES = 65536;
constexpr size_t WS_TAB = 1 * MiB, WS_PQ = 2 * MiB, WS_PKV = 2 * MiB + 512 * 1024, WS_PT = 3 * MiB, WS_PE = 5 * MiB, WS_RSTDE = 7 * MiB;
constexpr size_t WS_WIN = 8 * MiB, WS_WQKV = 16 * MiB, WS_WPP = 18 * MiB, WS_WUP = 19 * MiB, WS_WOUT = 23 * MiB, WS_W1 = 25 * MiB, WS_W2 = 33 * MiB, WS_WPG = 41 * MiB;
constexpr size_t WS_XN = 48 * MiB, WS_QA = 112 * MiB, WS_KVR = 128 * MiB, WS_KS = 144 * MiB, WS_VS = 152 * MiB, WS_KROPE = 160 * MiB, WS_ERAW = 112 * MiB;
constexpr size_t WS_T = 176 * MiB, WS_QR = 176 * MiB, WS_PB = 240 * MiB;
constexpr size_t WS_QN = 256 * MiB, WS_QS = 320 * MiB, WS_KN = 384 * MiB, WS_VM = 448 * MiB, WS_U = 256 * MiB, WS_END = 512 * MiB;

constexpr int LDS_BYTES = 132 * 1024;

struct Params { const float* in[20]; float* out; unsigned char* ws; int ph_lo, ph_hi; };

__device__ __forceinline__ unsigned cvtpk(float lo, float hi) { f32x2 v = {lo, hi}; bf16x2_t b = __builtin_convertvector(v, bf16x2_t); return __builtin_bit_cast(unsigned, b); }
__device__ __forceinline__ u32x2 pack4(f32x4 v) { u32x2 r; r.x = cvtpk(v[0], v[1]); r.y = cvtpk(v[2], v[3]); return r; }
__device__ __forceinline__ float bf2f(unsigned short h) { return __builtin_bit_cast(float, (unsigned)h << 16); }
__device__ __forceinline__ f32x4 unpack4(u32x2 w) { f32x4 r; r[0] = __builtin_bit_cast(float, w.x << 16); r[1] = __builtin_bit_cast(float, w.x & 0xffff0000u); r[2] = __builtin_bit_cast(float, w.y << 16); r[3] = __builtin_bit_cast(float, w.y & 0xffff0000u); return r; }
__device__ __forceinline__ float sigmoidf_(float x) { return __builtin_amdgcn_rcpf(1.0f + __builtin_amdgcn_exp2f(-x * LOG2E)); }
__device__ __forceinline__ f32x4 sigmoid4(f32x4 v) { f32x4 r; r[0] = sigmoidf_(v[0]); r[1] = sigmoidf_(v[1]); r[2] = sigmoidf_(v[2]); r[3] = sigmoidf_(v[3]); return r; }
__device__ __forceinline__ float wave_sum(float v) {
#pragma unroll
    for (int o = 1; o < 64; o <<= 1) v += __shfl_xor(v, o);
    return v;
}
__device__ __forceinline__ float dot4(f32x4 v) { return (v[0] * v[0] + v[1] * v[1]) + (v[2] * v[2] + v[3] * v[3]); }

struct Sched {
    int G, c, nseg, pairs;
    int nN[2], pmo[2], pno[2], start[3];
    __device__ __forceinline__ bool next(int i, pg8::Unit& u) const {
        const int ii = pairs ? (i >> 1) : i;
        const long L = (long)ii * G + c; if (L >= start[nseg]) return false;
        const int s = (nseg > 1 && L >= start[1]) ? 1 : 0; const int l = (int)L - start[s];
        const int nwg = start[s + 1] - start[s], q = nwg >> 3, id = (l & 7) * q + (l >> 3);
        const int nig = 8 * nN[s], gid = id / nig, r = id % nig;
        const int pm = gid * 8 + (r & 7), pn = r >> 3;
        u.pm = pmo[s] + pm; u.pn = pno[s] + pn; u.kind = u.pn;
        if (pairs) { if (i & 1) { u.pm += 128; u.pn += 4; u.kind = 0; } else u.kind = 0x100; }
        return true;
    }
    __device__ __forceinline__ void a_ready(const pg8::Unit&) const {}
    __device__ __forceinline__ void done(const pg8::Unit&) const {}
};
__device__ __forceinline__ Sched make_sched(int G, int c, int nN0) { Sched s; s.G = G; s.c = c; s.nseg = 1; s.pairs = 0; s.nN[0] = nN0; s.nN[1] = 1; s.pmo[0] = s.pmo[1] = 0; s.pno[0] = s.pno[1] = 0; s.start[0] = 0; s.start[1] = 128 * nN0; s.start[2] = s.start[1]; return s; }

typedef pg8::f32x4 A4;
#define EPI_ROWS(ai, m) for (int ai = 0; ai < 2; ++ai) _Pragma("unroll") for (int m = 0; m < 4; ++m)

struct EpiP1 {
    static constexpr bool PERM = false, AFTER_DRAIN = false;
    bf16 *qa, *kvr, *krope, *qs, *ks, *vs, *gates; float *part_q, *part_kv; const f32x2* tab;
    __device__ __forceinline__ void mid(const A4 (&acc)[2][2][4][2], const pg8::Unit& u, int wr, int wc, int fr, int fq) const {}
    __device__ __forceinline__ void operator()(const A4 (&acc)[2][2][4][2], const pg8::Unit& u, int wr, int wc, int fr, int fq) const {
        const int pn = u.kind, row0 = u.pm * 256 + wr * 64 + fr, cl0 = wc * 32 + fq * 4;
        if (pn <= 1) {
            bf16* dst = pn == 0 ? qa : kvr; float* part = pn == 0 ? part_q : part_kv;
#pragma unroll
            EPI_ROWS(ai, m) { const int row = row0 + ai * 128 + m * 16; float ss = 0.f;
#pragma unroll
                for (int bj = 0; bj < 2; ++bj)
#pragma unroll
                    for (int n = 0; n < 2; ++n) { const A4 v = acc[ai][bj][m][n]; if (pn == 0 || bj == 0) ss += dot4(v);
                        *(u32x2*)(dst + (size_t)row * 256 + bj * 128 + cl0 + n * 16) = pack4(v); }
                ss += __shfl_xor(ss, 16); ss += __shfl_xor(ss, 32);
                if (fq == 0) part[(size_t)row * 4 + wc] = ss;
                if (pn == 1 && wc == 0) {
                    const int pos = row & (SEQ - 1); const A4 x1 = acc[ai][1][m][0], x2 = acc[ai][1][m][1]; A4 o1, o2;
#pragma unroll
                    for (int e = 0; e < 4; ++e) { const f32x2 cs = tab[pos * 32 + 2 * (4 * fq + e)]; o1[e] = x1[e] * cs.x - x2[e] * cs.y; o2[e] = x2[e] * cs.x + x1[e] * cs.y; }
                    *(u32x2*)(krope + (size_t)row * 32 + 4 * fq) = pack4(o1); *(u32x2*)(krope + (size_t)row * 32 + 16 + 4 * fq) = pack4(o2);
                }
            }
        } else if (pn <= 6) {
            const int d1 = 16 * (wc & 1) + 4 * fq;
            f32x4 tb[2][2];
            { const int pos = row0 & (SEQ - 1); tb[0][0] = *(const f32x4*)(tab + pos * 32 + d1); tb[0][1] = *(const f32x4*)(tab + pos * 32 + d1 + 2); }
#pragma unroll
            for (int it = 0; it < 8; ++it) { const int ai = it >> 2, m = it & 3; const int row = row0 + ai * 128 + m * 16;
                if (it + 1 < 8) { const int pos = (row0 + ((it + 1) >> 2) * 128 + ((it + 1) & 3) * 16) & (SEQ - 1); tb[(it + 1) & 1][0] = *(const f32x4*)(tab + pos * 32 + d1); tb[(it + 1) & 1][1] = *(const f32x4*)(tab + pos * 32 + d1 + 2); }
                asm volatile("" ::: "memory");
                const f32x4 t0 = tb[it & 1][0], t1 = tb[it & 1][1];
                const float cc[4] = {t0[0], t0[2], t1[0], t1[2]}, sn[4] = {t0[1], t0[3], t1[1], t1[3]};
#pragma unroll
                for (int bj = 0; bj < 2; ++bj) {
                    if (pn == 6 && bj == 1) {
#pragma unroll
                        for (int n = 0; n < 2; ++n) *(u32x2*)(vs + (size_t)row * 128 + cl0 + n * 16) = pack4(acc[ai][1][m][n]);
                    } else {
                        const A4 x1 = acc[ai][bj][m][0], x2 = acc[ai][bj][m][1]; A4 o1, o2; const float sc = pn == 6 ? 1.0f : C2_SWA;
#pragma unroll
                        for (int e = 0; e < 4; ++e) { o1[e] = (x1[e] * cc[e] - x2[e] * sn[e]) * sc; o2[e] = (x2[e] * cc[e] + x1[e] * sn[e]) * sc; }
                        bf16* d = pn == 6 ? ks + (size_t)row * 128 + (wc >> 1) * 64 : qs + (size_t)row * 1024 + ((pn - 2) * 4 + bj * 2 + (wc >> 1)) * 64;
                        *(u32x2*)(d + d1) = pack4(o1); *(u32x2*)(d + 32 + d1) = pack4(o2);
                    }
                }
            }
        } else {
#pragma unroll
            EPI_ROWS(ai, m) { const int row = row0 + ai * 128 + m * 16;
#pragma unroll
                for (int bj = 0; bj < 2; ++bj)
#pragma unroll
                    for (int n = 0; n < 2; ++n) *(u32x2*)(gates + (size_t)row * 2048 + (pn - 7) * 256 + bj * 128 + cl0 + n * 16) = pack4(sigmoid4(acc[ai][bj][m][n]));
            }
        }
    }
};

struct EpiP2 {
    static constexpr bool PERM = false, AFTER_DRAIN = false;
    bf16 *qn, *qr, *kn, *vm; const float *part_q, *part_kv; const f32x2* tab;
    __device__ __forceinline__ void mid(const A4 (&acc)[2][2][4][2], const pg8::Unit& u, int wr, int wc, int fr, int fq) const {}
    __device__ __forceinline__ void operator()(const A4 (&acc)[2][2][4][2], const pg8::Unit& u, int wr, int wc, int fr, int fq) const {
        const int pn = u.kind, row0 = (u.pm & 127) * 256 + wr * 64 + fr, cl0 = wc * 32 + fq * 4;
        const bool isq = pn < 6, isrope = pn == 4 || pn == 5; const float* part = isq ? part_q : part_kv; const float invn = isq ? (1.0f / 256.0f) : (1.0f / 128.0f);
        f32x4 pp[2]; f32x4 tb[2][2];
        pp[0] = *(const f32x4*)(part + (size_t)row0 * 4);
        if (isrope) { const int pos = row0 & (SEQ - 1); tb[0][0] = *(const f32x4*)(tab + pos * 32 + 8 * fq); tb[0][1] = *(const f32x4*)(tab + pos * 32 + 8 * fq + 4); }
        f32x4 tc[2][2];
        if (isrope) { const int pos = row0 & (SEQ - 1); tc[0][0] = *(const f32x4*)(tab + pos * 32 + 8 * fq + 2); tc[0][1] = *(const f32x4*)(tab + pos * 32 + 8 * fq + 6); }
#pragma unroll
        for (int it = 0; it < 8; ++it) { const int ai = it >> 2, m = it & 3; const int row = row0 + ai * 128 + m * 16;
            if (it + 1 < 8) { const int rn = row0 + ((it + 1) >> 2) * 128 + ((it + 1) & 3) * 16; pp[(it + 1) & 1] = *(const f32x4*)(part + (size_t)rn * 4);
                if (isrope) { const int pos = rn & (SEQ - 1); tb[(it + 1) & 1][0] = *(const f32x4*)(tab + pos * 32 + 8 * fq); tb[(it + 1) & 1][1] = *(const f32x4*)(tab + pos * 32 + 8 * fq + 4);
                    tc[(it + 1) & 1][0] = *(const f32x4*)(tab + pos * 32 + 8 * fq + 2); tc[(it + 1) & 1][1] = *(const f32x4*)(tab + pos * 32 + 8 * fq + 6); } }
            asm volatile("" ::: "memory");
            const f32x4 p4 = pp[it & 1];
            float rs = __builtin_amdgcn_rsqf(((p4[0] + p4[1]) + (p4[2] + p4[3])) * invn + EPS);
            if (isq) rs *= C2_MLA;
            if (isrope) {
                const float cc[4] = {tb[it & 1][0][0], tc[it & 1][0][0], tb[it & 1][1][0], tc[it & 1][1][0]}, sn[4] = {tb[it & 1][0][1], tc[it & 1][0][1], tb[it & 1][1][1], tc[it & 1][1][1]};
#pragma unroll
                for (int bj = 0; bj < 2; ++bj) { const A4 x1 = acc[ai][bj][m][0], x2 = acc[ai][bj][m][1]; A4 o1, o2;
#pragma unroll
                    for (int e = 0; e < 4; ++e) { o1[e] = (x1[e] * cc[e] - x2[e] * sn[e]) * rs; o2[e] = (x2[e] * cc[e] + x1[e] * sn[e]) * rs; }
                    bf16* d = qr + (size_t)row * 512 + ((pn - 4) * 8 + bj * 4 + wc) * 32;
                    *(u32x2*)(d + 4 * fq) = pack4(o1); *(u32x2*)(d + 16 + 4 * fq) = pack4(o2); }
            } else {
                bf16* d = pn < 4 ? qn + (size_t)row * 1024 + pn * 256 : (pn < 10 ? kn + (size_t)row * 1024 + (pn - 6) * 256 : vm + (size_t)row * 1024 + (pn - 10) * 256);
#pragma unroll
                for (int bj = 0; bj < 2; ++bj)
#pragma unroll
                    for (int n = 0; n < 2; ++n) *(u32x2*)(d + bj * 128 + cl0 + n * 16) = pack4(acc[ai][bj][m][n] * rs);
            }
        }
    }
};

struct EpiP4 {
    static constexpr bool PERM = false, AFTER_DRAIN = false;
    const bf16* gates; bf16* y; bf16* ya;
    __device__ __forceinline__ void mid(const A4 (&acc)[2][2][4][2], const pg8::Unit& u, int wr, int wc, int fr, int fq) const {
        const int row0 = u.pm * 256 + wr * 64 + fr, col0 = u.pn * 256 + wc * 32 + fq * 4;
        u32x2 gq[2][2][2];
#define P4_LD(buf, it_) do { const bf16* g_ = gates + (size_t)(row0 + ((it_) >> 2) * 128 + ((it_) & 3) * 16) * 2048 + col0; \
        _Pragma("unroll") for (int bj = 0; bj < 2; ++bj) _Pragma("unroll") for (int n = 0; n < 2; ++n) gq[buf][bj][n] = *(const u32x2*)(g_ + bj * 128 + n * 16); } while (0)
        P4_LD(0, 0);
#pragma unroll
        for (int it = 0; it < 8; ++it) { const int ai = it >> 2, m = it & 3; const size_t row = (size_t)(row0 + ai * 128 + m * 16);
            if (it + 1 < 8) P4_LD((it + 1) & 1, it + 1);
            asm volatile("" ::: "memory");
#pragma unroll
            for (int bj = 0; bj < 2; ++bj)
#pragma unroll
                for (int n = 0; n < 2; ++n) *(u32x2*)(ya + row * 1024 + col0 + bj * 128 + n * 16) = pack4(acc[ai][bj][m][n] * unpack4(gq[it & 1][bj][n]));
        }
#undef P4_LD
    }
    __device__ __forceinline__ void operator()(const A4 (&acc)[2][2][4][2], const pg8::Unit& u, int wr, int wc, int fr, int fq) const {
        const int row0 = (u.pm - 128) * 256 + wr * 64 + fr, col0 = (u.pn - 4) * 256 + wc * 32 + fq * 4;
        u32x2 gq[2][2][2], yq[2][2][2];
#define P4_LD(buf, it_) do { const size_t r_ = (size_t)(row0 + ((it_) >> 2) * 128 + ((it_) & 3) * 16); const bf16* g_ = gates + r_ * 2048 + 1024 + col0; const bf16* y_ = ya + r_ * 1024 + col0; \
        _Pragma("unroll") for (int bj = 0; bj < 2; ++bj) _Pragma("unroll") for (int n = 0; n < 2; ++n) { gq[buf][bj][n] = *(const u32x2*)(g_ + bj * 128 + n * 16); yq[buf][bj][n] = *(const u32x2*)(y_ + bj * 128 + n * 16); } } while (0)
        P4_LD(0, 0);
#pragma unroll
        for (int it = 0; it < 8; ++it) { const int ai = it >> 2, m = it & 3; const size_t row = (size_t)(row0 + ai * 128 + m * 16);
            if (it + 1 < 8) P4_LD((it + 1) & 1, it + 1);
            asm volatile("" ::: "memory");
#pragma unroll
            for (int bj = 0; bj < 2; ++bj)
#pragma unroll
                for (int n = 0; n < 2; ++n) *(u32x2*)(y + row * 1024 + col0 + bj * 128 + n * 16) = pack4(unpack4(yq[it & 1][bj][n]) + acc[ai][bj][m][n] * unpack4(gq[it & 1][bj][n]));
        }
#undef P4_LD
    }
};

struct EpiT {
    static constexpr bool PERM = false, AFTER_DRAIN = false;
    bf16* o; float* part;
    __device__ __forceinline__ void mid(const A4 (&acc)[2][2][4][2], const pg8::Unit& u, int wr, int wc, int fr, int fq) const {}
    __device__ __forceinline__ void operator()(const A4 (&acc)[2][2][4][2], const pg8::Unit& u, int wr, int wc, int fr, int fq) const {
        const int row0 = u.pm * 256 + wr * 64 + fr, col0 = u.pn * 256 + wc * 32 + fq * 4;
#pragma unroll
        EPI_ROWS(ai, m) { const size_t row = (size_t)(row0 + ai * 128 + m * 16); float ss = 0.f;
#pragma unroll
            for (int bj = 0; bj < 2; ++bj)
#pragma unroll
                for (int n = 0; n < 2; ++n) { const A4 v = acc[ai][bj][m][n]; ss += dot4(v); *(u32x2*)(o + row * 1024 + col0 + bj * 128 + n * 16) = pack4(v); }
            ss += __shfl_xor(ss, 16); ss += __shfl_xor(ss, 32);
            if (fq == 0) part[row * 16 + u.pn * 4 + wc] = ss;
        }
    }
};

struct EpiRelu2 {
    static constexpr bool PERM = false, AFTER_DRAIN = false;
    bf16* o;
    __device__ __forceinline__ void mid(const A4 (&acc)[2][2][4][2], const pg8::Unit& u, int wr, int wc, int fr, int fq) const {}
    __device__ __forceinline__ void operator()(const A4 (&acc)[2][2][4][2], const pg8::Unit& u, int wr, int wc, int fr, int fq) const {
        const int row0 = u.pm * 256 + wr * 64 + fr, col0 = u.pn * 256 + wc * 32 + fq * 4;
#pragma unroll
        EPI_ROWS(ai, m) { const size_t row = (size_t)(row0 + ai * 128 + m * 16);
#pragma unroll
            for (int bj = 0; bj < 2; ++bj)
#pragma unroll
                for (int n = 0; n < 2; ++n) { A4 v = acc[ai][bj][m][n];
#pragma unroll
                    for (int e = 0; e < 4; ++e) { const float r = __builtin_fmaxf(v[e], 0.f); v[e] = r * r; }
                    *(u32x2*)(o + row * FF + col0 + bj * 128 + n * 16) = pack4(v); }
        }
    }
};

struct EpiOut {
    static constexpr bool PERM = false, AFTER_DRAIN = false;
    float* out; const bf16* eraw; const float* rstd_e; const float* gple;
    __device__ __forceinline__ void mid(const A4 (&acc)[2][2][4][2], const pg8::Unit& u, int wr, int wc, int fr, int fq) const {}
    __device__ __forceinline__ void operator()(const A4 (&acc)[2][2][4][2], const pg8::Unit& u, int wr, int wc, int fr, int fq) const {
        const int row0 = u.pm * 256 + wr * 64 + fr, col0 = u.pn * 256 + wc * 32 + fq * 4;
        f32x4 gv[2][2];
#pragma unroll
        for (int bj = 0; bj < 2; ++bj)
#pragma unroll
            for (int n = 0; n < 2; ++n) gv[bj][n] = *(const f32x4*)(gple + col0 + bj * 128 + n * 16);
        f32x4 xq[2][2][2]; u32x2 eq[2][2][2]; float rq[2];
#define PO_LD(buf, it_) do { const size_t r_ = (size_t)(row0 + ((it_) >> 2) * 128 + ((it_) & 3) * 16); rq[buf] = rstd_e[r_]; \
        _Pragma("unroll") for (int bj = 0; bj < 2; ++bj) _Pragma("unroll") for (int n = 0; n < 2; ++n) { const size_t off_ = r_ * 1024 + col0 + bj * 128 + n * 16; xq[buf][bj][n] = *(const f32x4*)(out + off_); eq[buf][bj][n] = *(const u32x2*)(eraw + off_); } } while (0)
        PO_LD(0, 0);
#pragma unroll
        for (int it = 0; it < 8; ++it) { const int ai = it >> 2, m = it & 3; const size_t row = (size_t)(row0 + ai * 128 + m * 16);
            if (it + 1 < 8) PO_LD((it + 1) & 1, it + 1);
            asm volatile("" ::: "memory");
#pragma unroll
            for (int bj = 0; bj < 2; ++bj)
#pragma unroll
                for (int n = 0; n < 2; ++n) { const size_t off = row * 1024 + col0 + bj * 128 + n * 16;
                    *(f32x4*)(out + off) = xq[it & 1][bj][n] + sigmoid4(acc[ai][bj][m][n]) * (unpack4(eq[it & 1][bj][n]) * rq[it & 1] * gv[bj][n]); }
        }
#undef PO_LD
    }
};

namespace att {
constexpr int KP = 208, VP = 192, KBUF = 64 * KP, VBUF = 64 * VP, STAGE = KBUF + VBUF;
__device__ __forceinline__ float max3f(float a, float b, float c) { float r; asm("v_max3_f32 %0, %1, %2, %3" : "=v"(r) : "v"(a), "v"(b), "v"(c)); return r; }
__device__ __forceinline__ float max2f(float a, float b) { float r; asm("v_max_f32_e32 %0, %1, %2" : "=v"(r) : "v"(a), "v"(b)); return r; }
__device__ __forceinline__ float xhalf_max(float v) { auto rr = __builtin_amdgcn_permlane32_swap(__float_as_uint(v), __float_as_uint(v), false, false); return max2f(__uint_as_float(rr[0]), __uint_as_float(rr[1])); }
__device__ __forceinline__ float xhalf_sum(float v) { auto rr = __builtin_amdgcn_permlane32_swap(__float_as_uint(v), __float_as_uint(v), false, false); return __uint_as_float(rr[0]) + __uint_as_float(rr[1]); }
__device__ __forceinline__ s16x4 vtr(const LAS unsigned char* p) { return __builtin_bit_cast(s16x4, __builtin_amdgcn_ds_read_tr16_b64_v4i16((LAS s16x4*)p)); }

template <int MODE>
__device__ __forceinline__ void unit(LAS unsigned char* lds, const bf16* __restrict__ Qa, const bf16* __restrict__ Qb, const bf16* __restrict__ Ka, const bf16* __restrict__ Kb, const bf16* __restrict__ Va, bf16* O,
                                     const float* __restrict__ sinks, int b, int h, int blk, int hp) {
    constexpr int NC = MODE == 0 ? 6 : 4;
    const int tid = threadIdx.x, lane = tid & 63, w = __builtin_amdgcn_readfirstlane(tid >> 6), l31 = lane & 31, hi = lane >> 5;
    int hq, qpos0w, t_beg, t_end, kpos_base; size_t krow_base; int kvpitch, kvcol;
    if (MODE == 0) { hq = h; qpos0w = blk * 256 + w * 32; t_beg = 0; t_end = 4 * blk + 4; kpos_base = 0; kvpitch = 1024; kvcol = h * 64; }
    else { hq = 8 * h + 2 * hp + (w >> 2); qpos0w = blk * 128 + (w & 3) * 32; t_beg = blk == 0 ? 2 : 0; t_end = 4; kpos_base = (blk - 1) * 128; kvpitch = 128; kvcol = h * 64; }
    const size_t seq0 = (size_t)b * SEQ;
    const int qpos = qpos0w + l31;
    const LAS unsigned char* qlds = lds + 2 * KBUF + 2 * VBUF + (w * 64 + lane) * (NC * 16);
    { const bf16* qp = Qa + (seq0 + qpos) * 1024 + hq * 64 + hi * 8;
#pragma unroll
      for (int c = 0; c < 4; ++c) *(LAS bf16x8*)(qlds + c * 16) = *(const bf16x8*)(qp + c * 16);
      if (MODE == 0) { const bf16* qp2 = Qb + (seq0 + qpos) * 512 + hq * 32 + hi * 8;
#pragma unroll
          for (int c = 4; c < NC; ++c) *(LAS bf16x8*)(qlds + c * 16) = *(const bf16x8*)(qp2 + (c - 4) * 16); } }
    const int skey = tid >> 3, sch = tid & 7;
    const unsigned koff = (unsigned)(skey * kvpitch + sch * 8) * 2u, roff = (unsigned)((tid >> 2) * 32 + (tid & 3) * 8) * 2u;
    const char* kgb = (const char*)(Ka + ((long)seq0 + kpos_base) * kvpitch + kvcol);
    const char* vgb = (const char*)(Va + ((long)seq0 + kpos_base) * kvpitch + kvcol);
    const char* rgb = MODE == 0 ? (const char*)(Kb + (long)seq0 * 32) : nullptr;
    const int kw_off = skey * KP + sch * 16, vw_off = KBUF + skey * VP + sch * 16, rw_off = (tid >> 2) * KP + 128 + (tid & 3) * 16;
    const int pi = (l31 & 0x13) | ((l31 & 4) << 1) | ((l31 & 8) >> 1);
    const int kr_off = pi * KP + hi * 16;
    const int vr_off = KBUF + (8 * hi + ((lane & 15) >> 2)) * VP + (16 * ((lane >> 4) & 1) + 4 * (lane & 3)) * 2;
    float m_run, l_run;
    if (MODE == 0) { m_run = -1e30f; l_run = 0.f; } else { m_run = sinks[hq] * LOG2E; l_run = hi == 0 ? 1.f : 0.f; }
    f32x16 o0 = {}, o1 = {};
    u32x4 kreg, vreg, rreg = {};
    const int kw_k = skey * KP + sch * 16, kw_r = (tid >> 2) * KP + 128 + (tid & 3) * 16, vw_v = 2 * KBUF + skey * VP + sch * 16;
    const int kr_k = pi * KP + hi * 16;
    const int vr_v = 2 * KBUF + (8 * hi + ((lane & 15) >> 2)) * VP + (16 * ((lane >> 4) & 1) + 4 * (lane & 3)) * 2;
#define AT_LOADK(t) do { kreg = *(const u32x4*)(kgb + (long)(t) * 128 * kvpitch + koff); if (MODE == 0 && tid < 256) rreg = *(const u32x4*)(rgb + (long)(t) * 64 * 64 + roff); } while (0)
#define AT_LOADV(t) do { vreg = *(const u32x4*)(vgb + (long)(t) * 128 * kvpitch + koff); } while (0)
#define AT_STOREK(bi) do { *(LAS u32x4*)(lds + (bi) * KBUF + kw_k) = kreg; if (MODE == 0 && tid < 256) *(LAS u32x4*)(lds + (bi) * KBUF + kw_r) = rreg; } while (0)
#define AT_STOREV(bi) do { *(LAS u32x4*)(lds + (bi) * VBUF + vw_v) = vreg; } while (0)
#define AT_DOIT(t) (MODE == 0 ? ((t) * 64 <= qpos0w + 31) : ((w & 3) < 2 ? ((t) <= 2) : ((t) >= 1)))
#define AT_DOMASK(t) (MODE == 0 ? ((t) * 64 + 63 > qpos0w) : true)
#define AT_QK(S0, S1, bi) do { const LAS unsigned char* kb_ = lds + (bi) * KBUF + kr_k; bf16x8 ka_[2], kc_[2], qq_[2]; \
        ka_[0] = *(const LAS bf16x8*)(kb_); kc_[0] = *(const LAS bf16x8*)(kb_ + 32 * KP); qq_[0] = *(const LAS bf16x8*)(qlds); \
        _Pragma("unroll") for (int c = 0; c < NC; ++c) { \
            if (c + 1 < NC) { ka_[(c + 1) & 1] = *(const LAS bf16x8*)(kb_ + (c + 1) * 32); kc_[(c + 1) & 1] = *(const LAS bf16x8*)(kb_ + 32 * KP + (c + 1) * 32); qq_[(c + 1) & 1] = *(const LAS bf16x8*)(qlds + (c + 1) * 16); } \
            if (c == 0) { S0 = __builtin_amdgcn_mfma_f32_32x32x16_bf16(ka_[0], qq_[0], (f32x16){}, 0, 0, 0); S1 = __builtin_amdgcn_mfma_f32_32x32x16_bf16(kc_[0], qq_[0], (f32x16){}, 0, 0, 0); } \
            else { S0 = __builtin_amdgcn_mfma_f32_32x32x16_bf16(ka_[c & 1], qq_[c & 1], S0, 0, 0, 0); S1 = __builtin_amdgcn_mfma_f32_32x32x16_bf16(kc_[c & 1], qq_[c & 1], S1, 0, 0, 0); } \
            __builtin_amdgcn_sched_barrier(0); } } while (0)
#define AT_MASK(S0, S1, t) do { const int kp0_ = kpos_base + (t) * 64; \
        _Pragma("unroll") for (int r = 0; r < 16; ++r) { const int kk = kp0_ + 16 * (r >> 3) + 8 * hi + (r & 7); const int rel0 = qpos - kk, rel1 = rel0 - 32; \
            const bool ok0 = MODE == 0 ? rel0 >= 0 : (rel0 >= 0 && rel0 < 128), ok1 = MODE == 0 ? rel1 >= 0 : (rel1 >= 0 && rel1 < 128); \
            S0[r] = ok0 ? S0[r] : -1e30f; S1[r] = ok1 ? S1[r] : -1e30f; } } while (0)
#define AT_SB() __builtin_amdgcn_sched_barrier(0)
#define AT_PA(S0, S1) do { float mx = max2f(S0[0], S1[0]); \
        _Pragma("unroll") for (int r = 1; r < 16; ++r) mx = max3f(mx, S0[r], S1[r]); \
        mx = xhalf_max(mx); mnew = max2f(m_run, mx); alpha = __builtin_amdgcn_exp2f(m_run - mnew); m_run = mnew; ps = 0.f; } while (0)
#define AT_PE(S0, S1, k) do { u32x4 a_; \
        if ((k) == 0) { _Pragma("unroll") for (int r = 0; r < 8; ++r) { S0[r] = __builtin_amdgcn_exp2f(S0[r] - mnew); ps += S0[r]; } a_.x = cvtpk(S0[0], S0[1]); a_.y = cvtpk(S0[2], S0[3]); a_.z = cvtpk(S0[4], S0[5]); a_.w = cvtpk(S0[6], S0[7]); } \
        if ((k) == 1) { _Pragma("unroll") for (int r = 8; r < 16; ++r) { S0[r] = __builtin_amdgcn_exp2f(S0[r] - mnew); ps += S0[r]; } a_.x = cvtpk(S0[8], S0[9]); a_.y = cvtpk(S0[10], S0[11]); a_.z = cvtpk(S0[12], S0[13]); a_.w = cvtpk(S0[14], S0[15]); } \
        if ((k) == 2) { _Pragma("unroll") for (int r = 0; r < 8; ++r) { S1[r] = __builtin_amdgcn_exp2f(S1[r] - mnew); ps += S1[r]; } a_.x = cvtpk(S1[0], S1[1]); a_.y = cvtpk(S1[2], S1[3]); a_.z = cvtpk(S1[4], S1[5]); a_.w = cvtpk(S1[6], S1[7]); } \
        if ((k) == 3) { _Pragma("unroll") for (int r = 8; r < 16; ++r) { S1[r] = __builtin_amdgcn_exp2f(S1[r] - mnew); ps += S1[r]; } a_.x = cvtpk(S1[8], S1[9]); a_.y = cvtpk(S1[10], S1[11]); a_.z = cvtpk(S1[12], S1[13]); a_.w = cvtpk(S1[14], S1[15]); } \
        pk[k] = __builtin_bit_cast(bf16x8, a_); } while (0)
#define AT_PR() do { l_run = l_run * alpha + ps; _Pragma("unroll") for (int r = 0; r < 16; ++r) { o0[r] *= alpha; o1[r] *= alpha; } } while (0)
#define AT_SOFTMAX(S0, S1) do { AT_PA(S0, S1); AT_PE(S0, S1, 0); AT_PE(S0, S1, 1); AT_PE(S0, S1, 2); AT_PE(S0, S1, 3); AT_PR(); } while (0)
#define AT_FUSED(SA0, SA1, SB0, SB1, bi) do { const LAS unsigned char* kb_ = lds + (bi) * KBUF + kr_k; bf16x8 ka_[2], kc_[2], qq_[2]; \
        ka_[0] = *(const LAS bf16x8*)(kb_); kc_[0] = *(const LAS bf16x8*)(kb_ + 32 * KP); qq_[0] = *(const LAS bf16x8*)(qlds); \
        _Pragma("unroll") for (int c = 0; c < NC; ++c) { \
            if (c + 1 < NC) { ka_[(c + 1) & 1] = *(const LAS bf16x8*)(kb_ + (c + 1) * 32); kc_[(c + 1) & 1] = *(const LAS bf16x8*)(kb_ + 32 * KP + (c + 1) * 32); qq_[(c + 1) & 1] = *(const LAS bf16x8*)(qlds + (c + 1) * 16); } \
            if (c == 0) { SB0 = __builtin_amdgcn_mfma_f32_32x32x16_bf16(ka_[0], qq_[0], (f32x16){}, 0, 0, 0); SB1 = __builtin_amdgcn_mfma_f32_32x32x16_bf16(kc_[0], qq_[0], (f32x16){}, 0, 0, 0); } \
            else { SB0 = __builtin_amdgcn_mfma_f32_32x32x16_bf16(ka_[c & 1], qq_[c & 1], SB0, 0, 0, 0); SB1 = __builtin_amdgcn_mfma_f32_32x32x16_bf16(kc_[c & 1], qq_[c & 1], SB1, 0, 0, 0); } \
            if (c == 0) AT_PA(SA0, SA1); \
            if (NC == 6) { if (c >= 1 && c <= 4) AT_PE(SA0, SA1, c - 1); } \
            else { if (c == 1) { AT_PE(SA0, SA1, 0); AT_PE(SA0, SA1, 1); } if (c == 2) { AT_PE(SA0, SA1, 2); AT_PE(SA0, SA1, 3); } } \
            if (c == NC - 1) AT_PR(); \
            AT_SB(); } } while (0)
#define AT_PV(bi) do { const LAS unsigned char* vb_ = lds + (bi) * VBUF + vr_v; s16x4 va_[2][4]; \
        va_[0][0] = vtr(vb_); va_[0][1] = vtr(vb_ + 4 * VP); va_[0][2] = vtr(vb_ + 64); va_[0][3] = vtr(vb_ + 4 * VP + 64); \
        _Pragma("unroll") for (int j = 0; j < 4; ++j) { \
            if (j + 1 < 4) { va_[(j + 1) & 1][0] = vtr(vb_ + (16 * (j + 1)) * VP); va_[(j + 1) & 1][1] = vtr(vb_ + (16 * (j + 1) + 4) * VP); va_[(j + 1) & 1][2] = vtr(vb_ + (16 * (j + 1)) * VP + 64); va_[(j + 1) & 1][3] = vtr(vb_ + (16 * (j + 1) + 4) * VP + 64); } \
            const s16x4 a0 = va_[j & 1][0], a1 = va_[j & 1][1], b0 = va_[j & 1][2], b1 = va_[j & 1][3]; \
            const bf16x8 va = {a0[0], a0[1], a0[2], a0[3], a1[0], a1[1], a1[2], a1[3]}, vb8 = {b0[0], b0[1], b0[2], b0[3], b1[0], b1[1], b1[2], b1[3]}; \
            o0 = __builtin_amdgcn_mfma_f32_32x32x16_bf16(va, pk[j], o0, 0, 0, 0); o1 = __builtin_amdgcn_mfma_f32_32x32x16_bf16(vb8, pk[j], o1, 0, 0, 0); AT_SB(); } } while (0)
#define AT_STEP(SA0, SA1, SB0, SB1, t) do { const int i_ = (t) - t_beg; const bool more1 = (t) + 1 < t_end, more2 = (t) + 2 < t_end; \
        if (more2) AT_LOADK((t) + 2); if (more1) AT_LOADV((t) + 1); \
        const bool d_next = more1 && AT_DOIT((t) + 1); \
        if (d_cur && AT_DOMASK(t)) AT_MASK(SA0, SA1, t); \
        bf16x8 pk[4]; float mnew, alpha, ps; \
        if (d_cur && d_next) { AT_FUSED(SA0, SA1, SB0, SB1, (i_ + 1) & 1); AT_PV(i_ & 1); } \
        else if (d_cur) { AT_SOFTMAX(SA0, SA1); AT_PV(i_ & 1); } \
        else if (d_next) { AT_QK(SB0, SB1, (i_ + 1) & 1); } \
        if (more2) AT_STOREK(i_ & 1); if (more1) AT_STOREV((i_ + 1) & 1); \
        __syncthreads(); d_cur = d_next; } while (0)
    AT_LOADK(t_beg); AT_LOADV(t_beg); AT_STOREK(0); AT_STOREV(0);
    if (t_beg + 1 < t_end) { AT_LOADK(t_beg + 1); AT_STOREK(1); }
    __syncthreads();
    f32x16 sa0 = {}, sa1 = {}, sb0 = {}, sb1 = {};
    bool d_cur = AT_DOIT(t_beg);
    if (d_cur) AT_QK(sa0, sa1, 0);
    for (int t = t_beg; t < t_end; t += 2) {
        AT_STEP(sa0, sa1, sb0, sb1, t);
        if (t + 1 < t_end) AT_STEP(sb0, sb1, sa0, sa1, t + 1);
    }
#undef AT_LOADK
#undef AT_LOADV
#undef AT_STOREK
#undef AT_STOREV
#undef AT_DOIT
#undef AT_DOMASK
#undef AT_QK
#undef AT_MASK
#undef AT_SOFTMAX
#undef AT_PV
#undef AT_STEP
#undef AT_SB
#undef AT_PA
#undef AT_PE
#undef AT_PR
#undef AT_FUSED
    const float inv = __builtin_amdgcn_rcpf(xhalf_sum(l_run));
    bf16* op = O + (seq0 + qpos) * 1024 + hq * 64 + 4 * hi;
#pragma unroll
    for (int g = 0; g < 4; ++g) { u32x2 w0, w1;
        w0.x = cvtpk(o0[4 * g] * inv, o0[4 * g + 1] * inv); w0.y = cvtpk(o0[4 * g + 2] * inv, o0[4 * g + 3] * inv);
        w1.x = cvtpk(o1[4 * g] * inv, o1[4 * g + 1] * inv); w1.y = cvtpk(o1[4 * g + 2] * inv, o1[4 * g + 3] * inv);
        *(u32x2*)(op + 8 * g) = w0; *(u32x2*)(op + 32 + 8 * g) = w1; }
}
}


__device__ __forceinline__ void swa_unit(LAS unsigned char* lds, const bf16* __restrict__ Qs, const bf16* __restrict__ Ks, const bf16* __restrict__ Vs, bf16* O, const float* __restrict__ sinks, int b, int g, int n) {
    using namespace att;
    constexpr int STG = KBUF + VBUF;
    const int tid = threadIdx.x, lane = tid & 63, w = __builtin_amdgcn_readfirstlane(tid >> 6), l31 = lane & 31, hi = lane >> 5;
    const int tb = n == 0 ? 2 : 0, kpos_base = (n - 1) * 128; const long seq0 = (long)b * SEQ;
    { const int skey = tid >> 3, sch = tid & 7; u32x4 kr[4], vr[4];
#pragma unroll
      for (int t = 0; t < 4; ++t) if (t >= tb) { const long off = (seq0 + kpos_base + t * 64 + skey) * 128 + g * 64 + sch * 8; kr[t] = *(const u32x4*)(Ks + off); vr[t] = *(const u32x4*)(Vs + off); }
#pragma unroll
      for (int t = 0; t < 4; ++t) if (t >= tb) { *(LAS u32x4*)(lds + t * STG + skey * KP + sch * 16) = kr[t]; *(LAS u32x4*)(lds + t * STG + KBUF + skey * VP + sch * 16) = vr[t]; } }
    __syncthreads();
    const int pi = (l31 & 0x13) | ((l31 & 4) << 1) | ((l31 & 8) >> 1);
    const int kr_k = pi * KP + hi * 16;
    const int vr_v = KBUF + (8 * hi + ((lane & 15) >> 2)) * VP + (16 * ((lane >> 4) & 1) + 4 * (lane & 3)) * 2;
    const int a = w & 3, qpos = n * 128 + a * 32 + l31;
    const int t0 = a < 2 ? tb : (tb > 1 ? tb : 1), t1 = a < 2 ? 2 : 3;
#pragma unroll 1
    for (int hp = 0; hp < 4; ++hp) {
        const int hq = 8 * g + 2 * hp + (w >> 2);
        bf16x8 qf[4];
        { const bf16* qp = Qs + (seq0 + qpos) * 1024 + hq * 64 + hi * 8;
#pragma unroll
          for (int c = 0; c < 4; ++c) qf[c] = *(const bf16x8*)(qp + c * 16); }
        float m_run = sinks[hq] * LOG2E, l_run = hi == 0 ? 1.f : 0.f;
        f32x16 o0 = {}, o1 = {};
#pragma unroll 1
        for (int t = t0; t <= t1; ++t) {
            const LAS unsigned char* kb = lds + t * STG + kr_k; const LAS unsigned char* vb = lds + t * STG + vr_v;
            f32x16 s0 = {}, s1 = {};
#pragma unroll
            for (int c = 0; c < 4; ++c) { const bf16x8 k0 = *(const LAS bf16x8*)(kb + c * 32), k1 = *(const LAS bf16x8*)(kb + 32 * KP + c * 32);
                s0 = __builtin_amdgcn_mfma_f32_32x32x16_bf16(k0, qf[c], s0, 0, 0, 0); s1 = __builtin_amdgcn_mfma_f32_32x32x16_bf16(k1, qf[c], s1, 0, 0, 0); }
            const int kp0 = kpos_base + t * 64;
#pragma unroll
            for (int r = 0; r < 16; ++r) { const int rel0 = qpos - (kp0 + 16 * (r >> 3) + 8 * hi + (r & 7)), rel1 = rel0 - 32;
                s0[r] = (rel0 >= 0 && rel0 < 128) ? s0[r] : -1e30f; s1[r] = (rel1 >= 0 && rel1 < 128) ? s1[r] : -1e30f; }
            float mx = max2f(s0[0], s1[0]);
#pragma unroll
            for (int r = 1; r < 16; ++r) mx = max3f(mx, s0[r], s1[r]);
            mx = xhalf_max(mx);
            const float mnew = max2f(m_run, mx), alpha = __builtin_amdgcn_exp2f(m_run - mnew); m_run = mnew;
            float ps = 0.f;
#pragma unroll
            for (int r = 0; r < 16; ++r) { s0[r] = __builtin_amdgcn_exp2f(s0[r] - mnew); s1[r] = __builtin_amdgcn_exp2f(s1[r] - mnew); ps += s0[r] + s1[r]; }
            l_run = l_run * alpha + ps;
#pragma unroll
            for (int r = 0; r < 16; ++r) { o0[r] *= alpha; o1[r] *= alpha; }
            bf16x8 pk[4];
#pragma unroll
            for (int j = 0; j < 2; ++j) { u32x4 a_, c_;
                a_.x = cvtpk(s0[8 * j], s0[8 * j + 1]); a_.y = cvtpk(s0[8 * j + 2], s0[8 * j + 3]); a_.z = cvtpk(s0[8 * j + 4], s0[8 * j + 5]); a_.w = cvtpk(s0[8 * j + 6], s0[8 * j + 7]);
                c_.x = cvtpk(s1[8 * j], s1[8 * j + 1]); c_.y = cvtpk(s1[8 * j + 2], s1[8 * j + 3]); c_.z = cvtpk(s1[8 * j + 4], s1[8 * j + 5]); c_.w = cvtpk(s1[8 * j + 6], s1[8 * j + 7]);
                pk[j] = __builtin_bit_cast(bf16x8, a_); pk[2 + j] = __builtin_bit_cast(bf16x8, c_); }
#pragma unroll
            for (int j = 0; j < 4; ++j) {
                const s16x4 a0 = vtr(vb + (16 * j) * VP), a1 = vtr(vb + (16 * j + 4) * VP), b0 = vtr(vb + (16 * j) * VP + 64), b1 = vtr(vb + (16 * j + 4) * VP + 64);
                const bf16x8 va = {a0[0], a0[1], a0[2], a0[3], a1[0], a1[1], a1[2], a1[3]}, vb8 = {b0[0], b0[1], b0[2], b0[3], b1[0], b1[1], b1[2], b1[3]};
                o0 = __builtin_amdgcn_mfma_f32_32x32x16_bf16(va, pk[j], o0, 0, 0, 0); o1 = __builtin_amdgcn_mfma_f32_32x32x16_bf16(vb8, pk[j], o1, 0, 0, 0); }
        }
        const float inv = __builtin_amdgcn_rcpf(xhalf_sum(l_run));
        bf16* op = O + (seq0 + qpos) * 1024 + hq * 64 + 4 * hi;
#pragma unroll
        for (int q4 = 0; q4 < 4; ++q4) { u32x2 w0, w1;
            w0.x = cvtpk(o0[4 * q4] * inv, o0[4 * q4 + 1] * inv); w0.y = cvtpk(o0[4 * q4 + 2] * inv, o0[4 * q4 + 3] * inv);
            w1.x = cvtpk(o1[4 * q4] * inv, o1[4 * q4 + 1] * inv); w1.y = cvtpk(o1[4 * q4 + 2] * inv, o1[4 * q4 + 3] * inv);
            *(u32x2*)(op + 8 * q4) = w0; *(u32x2*)(op + 32 + 8 * q4) = w1; }
    }
    __syncthreads();
}

__device__ __forceinline__ int swap45(int w) { return (w & 15) | (((w >> 4) & 1) << 5) | (((w >> 5) & 1) << 4); }
__device__ __forceinline__ int src_col(int which, int r) {
    switch (which) {
    case 0:
        if (r < 256) return r;
        if (r < 512) { const int p = r - 256; return p < 160 ? 256 + p : -1; }
        if (r < 1536) { const int p = r - 512; return 416 + (p & ~63) + swap45(p & 63); }
        if (r < 1792) { const int p = r - 1536; return p < 128 ? 1440 + (p & ~63) + swap45(p & 63) : 1568 + (p - 128); }
        return 1696 + (r - 1792);
    case 1:
        if (r < 1024) return (r >> 6) * 96 + (r & 63);
        { const int p = r - 1024; return (p >> 5) * 96 + 64 + (p & 31); }
    case 2:
        if (r < 1024) return (r >> 6) * 128 + (r & 63);
        { const int p = r - 1024; return (p >> 6) * 128 + 64 + (p & 63); }
    default: return r;
    }
}
__device__ __forceinline__ void transpose_item(const float* __restrict__ W, int Ks, int N, bf16* WT, int R, int Kd, int which, const float* __restrict__ gs, LAS float* scr, int item, int lane) {
    const int nblk = R / 32, kb = item / nblk, nb = item % nblk, k0 = 64 * kb, n0 = 32 * nb;
    const int sc = src_col(which, n0 + (lane & 31));
    float vals[32];
#pragma unroll
    for (int i = 0; i < 32; ++i) { const int k = k0 + 2 * i + (lane >> 5); float v = 0.f;
        if (sc >= 0 && k < Ks) { v = W[(size_t)k * N + sc]; if (gs) v *= gs[k]; }
        vals[i] = v; }
#pragma unroll
    for (int i = 0; i < 32; ++i) scr[(2 * i + (lane >> 5)) * 33 + (lane & 31)] = vals[i];
    asm volatile("s_waitcnt lgkmcnt(0)" ::: "memory");
    const int c = lane & 7;
#pragma unroll
    for (int j = 0; j < 4; ++j) { const int n = (lane >> 3) + 8 * j; const LAS float* s = scr + (8 * c) * 33 + n;
        u32x4 o; o.x = cvtpk(s[0 * 33], s[1 * 33]); o.y = cvtpk(s[2 * 33], s[3 * 33]); o.z = cvtpk(s[4 * 33], s[5 * 33]); o.w = cvtpk(s[6 * 33], s[7 * 33]);
        *(u32x4*)(WT + (size_t)(n0 + n) * Kd + k0 + 8 * c) = o; }
    asm volatile("s_waitcnt lgkmcnt(0)" ::: "memory");
}


__device__ __forceinline__ float sum16(const float* p) { const f32x4* q = (const f32x4*)p; const f32x4 a = q[0], b = q[1], c = q[2], d = q[3];
    return (((a[0] + a[1]) + (a[2] + a[3])) + ((b[0] + b[1]) + (b[2] + b[3]))) + (((c[0] + c[1]) + (c[2] + c[3])) + ((d[0] + d[1]) + (d[2] + d[3]))); }
template <bool FIRST>
__device__ __forceinline__ void rowpass(const float* xin, float* xo, const bf16* T, const float* part_t, const float* gpost, const float* gpre, bf16* XN, const float* part_e, float* rstd_e, int gw, int NGW, int lane) {
    for (int row0 = gw; row0 < M; row0 += 2 * NGW) {
        f32x4 xv[2][4]; u32x4 tw[2][2]; float rt[2];
#pragma unroll
        for (int r2 = 0; r2 < 2; ++r2) { const size_t row = (size_t)(row0 + r2 * NGW);
#pragma unroll
            for (int j = 0; j < 2; ++j) { const int col = 512 * j + 8 * lane; tw[r2][j] = *(const u32x4*)(T + row * DM + col);
                xv[r2][2 * j] = *(const f32x4*)(xin + row * DM + col); xv[r2][2 * j + 1] = *(const f32x4*)(xin + row * DM + col + 4); }
            rt[r2] = __builtin_amdgcn_rsqf(sum16(part_t + row * 16) * (1.0f / DM) + EPS); }
#pragma unroll
        for (int r2 = 0; r2 < 2; ++r2) { const size_t row = (size_t)(row0 + r2 * NGW); float ss = 0.f;
#pragma unroll
            for (int j = 0; j < 2; ++j) { const int col = 512 * j + 8 * lane;
                const f32x4 ta = unpack4((u32x2){tw[r2][j].x, tw[r2][j].y}), tb = unpack4((u32x2){tw[r2][j].z, tw[r2][j].w});
                const f32x4 ga = *(const f32x4*)(gpost + col), gb = *(const f32x4*)(gpost + col + 4);
                xv[r2][2 * j] += ta * rt[r2] * ga; xv[r2][2 * j + 1] += tb * rt[r2] * gb; ss += dot4(xv[r2][2 * j]) + dot4(xv[r2][2 * j + 1]);
                *(f32x4*)(xo + row * DM + col) = xv[r2][2 * j]; *(f32x4*)(xo + row * DM + col + 4) = xv[r2][2 * j + 1]; }
            if (FIRST) { const float r1 = __builtin_amdgcn_rsqf(wave_sum(ss) * (1.0f / DM) + EPS);
#pragma unroll
                for (int j = 0; j < 2; ++j) { const int col = 512 * j + 8 * lane; const f32x4 ga = *(const f32x4*)(gpre + col), gb = *(const f32x4*)(gpre + col + 4);
                    const u32x2 a = pack4(xv[r2][2 * j] * r1 * ga), b2 = pack4(xv[r2][2 * j + 1] * r1 * gb); *(u32x4*)(XN + row * DM + col) = (u32x4){a.x, a.y, b2.x, b2.y}; }
            } else {
#pragma unroll
                for (int j = 0; j < 2; ++j) { const int col = 512 * j + 8 * lane; const u32x2 a = pack4(xv[r2][2 * j]), b2 = pack4(xv[r2][2 * j + 1]); *(u32x4*)(XN + row * DM + col) = (u32x4){a.x, a.y, b2.x, b2.y}; }
                if (lane == 0) rstd_e[row] = __builtin_amdgcn_rsqf(sum16(part_e + row * 16) * (1.0f / DM) + EPS); }
        }
    }
}

#define XB_TMO      128
#define XB_XCNT(j)  (256  + 64 * (j))
#define XB_XSUB(j)  (1280 + 64 * (j))
#define XB_XGEN(j)  (2304 + 64 * (j))
#define XB_TOP      3328
#define XB_TOPGEN   3392
#define XCD_BAR_WORDS 3456
#define XB_SPIN_CAP (1u << 18)

__device__ __forceinline__ unsigned xb_ld(unsigned* p)              { return __hip_atomic_load(p, __ATOMIC_RELAXED, __HIP_MEMORY_SCOPE_AGENT); }
__device__ __forceinline__ unsigned xb_add(unsigned* p, unsigned v) { return __hip_atomic_fetch_add(p, v, __ATOMIC_RELAXED, __HIP_MEMORY_SCOPE_AGENT); }
__device__ __forceinline__ unsigned xb_xcc_id() { return (unsigned)__builtin_amdgcn_s_getreg((3 << 11) | 20) & 0xFu; }
#define XB_SPIN(cond, bar) do { unsigned _sp = 0; while (cond) { __builtin_amdgcn_s_sleep(1); \
    if ((++_sp & 255u) == 0u) { if (xb_ld(&(bar)[XB_TMO])) break; if (_sp > XB_SPIN_CAP) { atomicAdd(&(bar)[XB_TMO], 1u); break; } } } } while (0)

struct XcdBarrier {
    unsigned* bar; unsigned x;
    volatile LAS unsigned* st;
};

__device__ __forceinline__ XcdBarrier xcd_barrier_post(unsigned* bar, volatile LAS unsigned* st) {
    XcdBarrier b; b.bar = bar; b.x = xb_xcc_id(); b.st = st;
    if (threadIdx.x == 0) (void)xb_add(&bar[XB_XCNT(b.x)], 1u);
    return b;
}
__device__ __forceinline__ void xcd_barrier_complete(unsigned* bar, unsigned x, unsigned& nloc, unsigned& nx) {
    const unsigned G = gridDim.x * gridDim.y * gridDim.z;
    unsigned sum, cnt, mine, sp = 0u;
    for (;;) {
        sum = 0u; cnt = 0u; mine = 0u;
#pragma unroll
        for (unsigned j = 0; j < 16; ++j) { const unsigned c = xb_ld(&bar[XB_XCNT(j)]); sum += c; cnt += (c > 0u) ? 1u : 0u; mine = (j == x) ? c : mine; }
        if (sum == G) break;
        __builtin_amdgcn_s_sleep(1);
        if ((++sp & 255u) == 0u) { if (xb_ld(&bar[XB_TMO])) break; if (sp > XB_SPIN_CAP) { atomicAdd(&bar[XB_TMO], 1u); break; } }
    }
    nloc = mine > 0u ? mine : 1u; nx = cnt > 0u ? cnt : 1u;
}

__device__ __forceinline__ void xcd_barrier(const XcdBarrier& b) {
    asm volatile("s_waitcnt vmcnt(0)" ::: "memory");
    __syncthreads();
    if (threadIdx.x == 0) {
        unsigned* bar = b.bar;
        __builtin_amdgcn_s_waitcnt(0);
        unsigned nloc = b.st[0], nx = b.st[1];
        if (nloc == 0u) { xcd_barrier_complete(bar, b.x, nloc, nx); b.st[0] = nloc; b.st[1] = nx; }
        const unsigned old = xb_add(&bar[XB_XSUB(b.x)], 1u);
        const unsigned gen = old / nloc;
        if (old + 1u == (gen + 1u) * nloc) {
            __builtin_amdgcn_fence(__ATOMIC_RELEASE, "agent");
            asm volatile("s_waitcnt vmcnt(0)" ::: "memory");
            const unsigned og = xb_add(&bar[XB_TOP], 1u);
            const unsigned tg = og / nx;
            if (og + 1u == (tg + 1u) * nx) xb_add(&bar[XB_TOPGEN], 1u);
            else XB_SPIN(xb_ld(&bar[XB_TOPGEN]) == tg, bar);
            __builtin_amdgcn_fence(__ATOMIC_ACQUIRE, "agent");
            xb_add(&bar[XB_XGEN(b.x)], 1u);
            asm volatile("s_waitcnt vmcnt(0)" ::: "memory");
        } else {
            XB_SPIN(xb_ld(&bar[XB_XGEN(b.x)]) == gen, bar);
            __builtin_amdgcn_fence(__ATOMIC_ACQUIRE, "agent");
            asm volatile("s_waitcnt vmcnt(0)" ::: "memory");
        }
    }
    __syncthreads();
}

__global__ void __launch_bounds__(NWAVES * 64, 2) mega_fwd(Params P) {
    extern __shared__ __attribute__((aligned(16))) unsigned char lds_raw[];
    LAS unsigned char* lds = (LAS unsigned char*)lds_raw;
    const int tid = threadIdx.x, lane = tid & 63, wave = __builtin_amdgcn_readfirstlane(tid >> 6);
    const int G = gridDim.x, bx = blockIdx.x, vcu = (G % 8 == 0) ? (bx % 8) * (G / 8) + bx / 8 : bx;
    const int gw = vcu * NWAVES + wave, NGW = G * NWAVES;
    const int lo = P.ph_lo, hi = P.ph_hi;
#ifndef PH_MASK
#define PH_MASK 0x7ff
#endif
#define IN(k) (((PH_MASK >> (k)) & 1) && lo <= (k) && (k) < hi)
#ifdef PROBE_A
    unsigned long long t_a = 0, t_b = 0;
#define STAMP(id) do { if ((id) == PROBE_A) t_a = __builtin_amdgcn_s_memrealtime(); if ((id) == PROBE_B) t_b = __builtin_amdgcn_s_memrealtime(); } while (0)
#else
#define STAMP(id) do { } while (0)
#endif
    volatile LAS unsigned* bst = (volatile LAS unsigned*)(lds + 128 * 1024);
    if (tid < 2) bst[tid] = 0u;
    __syncthreads();
    XcdBarrier xbar = xcd_barrier_post((unsigned*)(P.ws + WS_CTL) + 1024, bst);
#define SEAM(k) do { if (IN(k) && IN((k) + 1)) { if (P.ph_hi > 64) cg::this_grid().sync(); else xcd_barrier(xbar); } STAMP((k) + 1); } while (0)
    STAMP(0);
#define tab ((const f32x2*)(P.ws + WS_TAB))
#define XN ((bf16*)(P.ws + WS_XN))
#define part_q ((float*)(P.ws + WS_PQ))
#define part_kv ((float*)(P.ws + WS_PKV))
#define part_t ((float*)(P.ws + WS_PT))
#define part_e ((float*)(P.ws + WS_PE))
#define rstd_e ((float*)(P.ws + WS_RSTDE))
#define gates ((bf16*)P.out)

    if (IN(0)) {
        LAS float* scr = (LAS float*)(lds + wave * 16384);
        int it = gw;
#define TR(IN_, KS, N_, R_, KD, WHICH, GSP, OFF) { const int nit = ((KD) / 64) * ((R_) / 32); for (; it < nit; it += NGW) transpose_item(P.in[IN_], KS, N_, (bf16*)(P.ws + (OFF)), R_, KD, WHICH, GSP, scr, it, lane); it -= nit; }
        TR(3, 1024, 3744, N_IN_PAD, 1024, 0, nullptr, WS_WIN)
        TR(5, 256, 1536, 1536, 256, 1, P.in[4], WS_WQKV)
        TR(7, 128, 2048, 2048, 256, 2, P.in[6], WS_WQKV + (size_t)1536 * 256 * 2)
        TR(17, 256, 1024, 1024, 256, 3, nullptr, WS_WPP)
        TR(9, 1024, 1024, 1024, 1024, 3, nullptr, WS_WUP)
        TR(10, 1024, 1024, 1024, 1024, 3, nullptr, WS_WUP + (size_t)1024 * 1024 * 2)
        TR(11, 1024, 1024, 1024, 1024, 3, nullptr, WS_WOUT)
        TR(14, 1024, 4096, 4096, 1024, 3, nullptr, WS_W1)
        TR(15, 4096, 1024, 1024, 4096, 3, nullptr, WS_W2)
        TR(19, 1024, 1024, 1024, 1024, 3, nullptr, WS_WPG)
#undef TR
        { const float* x = P.in[0]; const float* g = P.in[2];
          for (int row0 = gw; row0 < M; row0 += 2 * NGW) {
              f32x4 v[2][4], pv[2]; float ss[2] = {0.f, 0.f};
#pragma unroll
              for (int r2 = 0; r2 < 2; ++r2) { const int row = row0 + r2 * NGW; const f32x4* xr = (const f32x4*)(x + (size_t)row * DM);
#pragma unroll
                  for (int j = 0; j < 4; ++j) v[r2][j] = xr[lane + 64 * j];
                  pv[r2] = ((const f32x4*)(P.in[1] + (size_t)row * 256))[lane]; }
#pragma unroll
              for (int r2 = 0; r2 < 2; ++r2) { const int row = row0 + r2 * NGW;
#pragma unroll
                  for (int j = 0; j < 4; ++j) ss[r2] += dot4(v[r2][j]);
                  const float rs = __builtin_amdgcn_rsqf(wave_sum(ss[r2]) * (1.0f / DM) + EPS);
#pragma unroll
                  for (int j = 0; j < 4; ++j) { const f32x4 gg = ((const f32x4*)g)[lane + 64 * j]; *(u32x2*)(XN + (size_t)row * DM + 4 * (lane + 64 * j)) = pack4(v[r2][j] * rs * gg); }
                  *(u32x2*)((bf16*)(P.ws + WS_PB) + (size_t)row * 256 + 4 * lane) = pack4(pv[r2]); }
          } }
        for (int i = (vcu * NWAVES + wave) * 64 + lane; i < SEQ * 32; i += NGW * 64) {
            const int pos = i >> 5, j = i & 31; const float inv = expf(-9.210340371976184f * (float)j * (2.0f / 64.0f)); const float ang = (float)pos * inv;
            ((f32x2*)(P.ws + WS_TAB))[i] = (f32x2){cosf(ang), sinf(ang)}; }
    }
    SEAM(0);
    if (IN(1)) {
        pg8::Gemm g{XN, (const bf16*)(P.ws + WS_WIN), M, N_IN_PAD, 1024}; Sched S = make_sched(G, bx, 15);
        EpiP1 E{(bf16*)(P.ws + WS_QA), (bf16*)(P.ws + WS_KVR), (bf16*)(P.ws + WS_KROPE), (bf16*)(P.ws + WS_QS), (bf16*)(P.ws + WS_KS), (bf16*)(P.ws + WS_VS), gates, part_q, part_kv, tab};
        pg8::gemm_phase<EpiP1, Sched, true, true>(lds, g, S, E);
    }
    SEAM(1);
    if (IN(2)) {
        pg8::Gemm g{(const bf16*)(P.ws + WS_QA), (const bf16*)(P.ws + WS_WQKV), 2 * M, 3584, 256};
        Sched S = make_sched(G, bx, 6); S.nseg = 2; S.nN[1] = 8; S.pmo[1] = 128; S.pno[1] = 6; S.start[1] = 768; S.start[2] = 768 + 1024;
        EpiP2 E{(bf16*)(P.ws + WS_QN), (bf16*)(P.ws + WS_QR), (bf16*)(P.ws + WS_KN), (bf16*)(P.ws + WS_VM), part_q, part_kv, tab};
        pg8::gemm_phase<EpiP2, Sched, true, true>(lds, g, S, E);
    }
    SEAM(2);
    if (IN(3)) {
        for (int U = vcu; U < 2048; U += G) {
            const int c8 = U & 255, i = U >> 8, bh = c8 >> 1, s = c8 & 1, k = i >> 1, qb = (i & 1) ? 15 - 2 * k - s : 2 * k + s;
            att::unit<0>(lds, (const bf16*)(P.ws + WS_QN), (const bf16*)(P.ws + WS_QR), (const bf16*)(P.ws + WS_KN), (const bf16*)(P.ws + WS_KROPE), (const bf16*)(P.ws + WS_VM), (bf16*)(P.ws + WS_QN), nullptr, bh >> 4, bh & 15, qb, 0);
        }
        STAMP(12);
        for (int U = vcu; U < 512; U += G) swa_unit(lds, (const bf16*)(P.ws + WS_QS), (const bf16*)(P.ws + WS_KS), (const bf16*)(P.ws + WS_VS), (bf16*)(P.ws + WS_QS), P.in[8], U >> 6, (U >> 5) & 1, U & 31);
    }
    SEAM(3);
    if (IN(4)) {
        pg8::Gemm g{(const bf16*)(P.ws + WS_QN), (const bf16*)(P.ws + WS_WUP), 2 * M, 2048, 1024}; Sched S = make_sched(G, bx, 4); S.pairs = 1;
        EpiP4 E{gates, XN, (bf16*)(P.ws + WS_QA)};
        pg8::gemm_phase<EpiP4, Sched, true, true>(lds, g, S, E);
    }
    SEAM(4);
    if (IN(5)) {
        pg8::Gemm g{XN, (const bf16*)(P.ws + WS_WOUT), M, 1024, 1024}; Sched S = make_sched(G, bx, 4);
        EpiT E{(bf16*)(P.ws + WS_T), part_t};
        pg8::gemm_phase<EpiT, Sched, true, true>(lds, g, S, E);
    }
    SEAM(5);
    if (IN(6)) rowpass<true>(P.in[0], P.out, (const bf16*)(P.ws + WS_T), part_t, P.in[12], P.in[13], XN, nullptr, nullptr, gw, NGW, lane);
    SEAM(6);
    if (IN(7)) {
        pg8::Gemm g{XN, (const bf16*)(P.ws + WS_W1), M, FF, 1024}; Sched S = make_sched(G, bx, 16);
        EpiRelu2 E{(bf16*)(P.ws + WS_U)};
        pg8::gemm_phase<EpiRelu2, Sched, true, true>(lds, g, S, E);
    }
    SEAM(7);
    if (IN(8)) {
        { pg8::Gemm g{(const bf16*)(P.ws + WS_U), (const bf16*)(P.ws + WS_W2), M, 1024, FF}; Sched S = make_sched(G, bx, 4);
          EpiT E{(bf16*)(P.ws + WS_T), part_t};
          pg8::gemm_phase<EpiT, Sched, true, true>(lds, g, S, E); }
        { pg8::Gemm g{(const bf16*)(P.ws + WS_PB), (const bf16*)(P.ws + WS_WPP), M, 1024, 256}; Sched S = make_sched(G, bx, 4);
          EpiT E{(bf16*)(P.ws + WS_ERAW), part_e};
          pg8::gemm_phase<EpiT, Sched, true, true>(lds, g, S, E); }
    }
    SEAM(8);
    if (IN(9)) rowpass<false>(P.out, P.out, (const bf16*)(P.ws + WS_T), part_t, P.in[16], nullptr, XN, part_e, rstd_e, gw, NGW, lane);
    SEAM(9);
    if (IN(10)) {
        pg8::Gemm g{XN, (const bf16*)(P.ws + WS_WPG), M, 1024, 1024}; Sched S = make_sched(G, bx, 4);
        EpiOut E{P.out, (const bf16*)(P.ws + WS_ERAW), rstd_e, P.in[18]};
        pg8::gemm_phase<EpiOut, Sched, true, true>(lds, g, S, E);
    }
    STAMP(11);
#ifdef PROBE_A
    cg::this_grid().sync();
    STAMP(13); cg::this_grid().sync(); cg::this_grid().sync(); cg::this_grid().sync(); cg::this_grid().sync(); STAMP(14);
    if (bx == 0 && tid == 0) P.out[0] += (float)(((t_b - t_a) / PROBE_Q) * (PROBE_Q / 100ull));
#endif
#undef IN
#undef SEAM
#undef tab
#undef XN
#undef part_q
#undef part_kv
#undef part_t
#undef part_e
#undef rstd_e
#undef gates
}

extern "C" void kernel_launch(void* const* d_in, const int* in_sizes, int n_in, void* d_out, int out_size, void* d_ws, size_t ws_size, hipStream_t stream) {
    static int grid = 0;
    if (grid == 0) {
        int dev = 0, cus = 0, per_cu = 0;
        hipGetDevice(&dev); hipDeviceGetAttribute(&cus, hipDeviceAttributeMultiprocessorCount, dev);
        if (hipFuncSetAttribute((const void*)mega_fwd, hipFuncAttributeMaxDynamicSharedMemorySize, LDS_BYTES) != hipSuccess) { fprintf(stderr, "hipFuncSetAttribute failed\n"); }
        if (hipOccupancyMaxActiveBlocksPerMultiprocessor(&per_cu, (const void*)mega_fwd, NWAVES * 64, LDS_BYTES) != hipSuccess || per_cu < 1) { fprintf(stderr, "occupancy query: %d\n", per_cu); per_cu = 1; }
        (void)hipGetLastError();
        grid = cus * per_cu;
        if (n_in != 20 || ws_size < WS_END) fprintf(stderr, "kernel_launch: unexpected n_in %d / ws %zu\n", n_in, ws_size);
    }
    Params p{};
    for (int i = 0; i < 20; ++i) p.in[i] = (const float*)d_in[i];
    p.out = (float*)d_out; p.ws = (unsigned char*)d_ws;
#if MK_N_LAUNCHES == 1
    (void)hipMemsetAsync((unsigned char*)d_ws + WS_CTL, 0, CTL_BYTES, stream);
    p.ph_lo = 0; p.ph_hi = 11;
    void* args[] = {&p};
    hipError_t e = hipLaunchCooperativeKernel((const void*)mega_fwd, dim3(grid), dim3(NWAVES * 64), args, LDS_BYTES, stream);
    if (e != hipSuccess) fprintf(stderr, "cooperative launch failed: %s (grid %d)\n", hipGetErrorString(e), grid);
#else
    for (int k = 0; k < 11; ++k) { p.ph_lo = k; p.ph_hi = k + 1; hipLaunchKernelGGL(mega_fwd, dim3(grid), dim3(NWAVES * 64), LDS_BYTES, stream, p); }
#endif
}
```

```cpp
#include <hip/hip_runtime.h>
#include <hip/hip_cooperative_groups.h>
#include <cstdio>
#include <cstdint>
namespace cg = cooperative_groups;
#ifndef MK_N_LAUNCHES
#define MK_N_LAUNCHES 1
#endif
namespace pg8 {
#define PG8_LAS __attribute__((address_space(3)))
typedef unsigned short bf16_t;
typedef short bf16x8 __attribute__((ext_vector_type(8)));
typedef float f32x4 __attribute__((ext_vector_type(4)));
typedef unsigned u32x4 __attribute__((ext_vector_type(4)));
constexpr int BM = 256, BK = 64, HALF = 128, HTB = HALF * BK * 2  , STAGE_BYTES = 8 * HTB, NXCD = 8, WGM = 8;

__host__ __device__ __forceinline__ int lds_byte(int r, int c) { const int st = (r >> 4) * 2 + (c >> 5), rr = r & 15, cc = c & 31, ob = rr * 64 + cc * 2; return st * 1024 + (ob ^ (((ob >> 9) & 1) << 5)); }
__host__ __device__ __forceinline__ void stage_rc(int b, int& R, int& C) { const int st = b / 1024, sb = b % 1024, swz = sb ^ (((sb >> 9) & 1) << 5); R = (st >> 1) * 16 + swz / 64; C = (st & 1) * 32 + (swz % 64) / 2; }
__host__ __device__ __forceinline__ int perm32(int rho) { const int n = rho >> 4, i = rho & 15; return 8 * (i >> 2) + 4 * n + (i & 3); }

struct Unit { int pm, pn, kind; };
struct Gemm { const bf16_t* A; const bf16_t* Bt; int M, N, K; };

template <class Epi, class Sched, bool ALIGN_EPI = false, bool SP2 = false>
__device__ __forceinline__ void gemm_phase(PG8_LAS unsigned char* lds, const Gemm g, const Sched& S, const Epi& E) {
    const int tid = threadIdx.x, wid = __builtin_amdgcn_readfirstlane(tid >> 6), lane = tid & 63, wr = wid >> 2, wc = wid & 3, fr = lane & 15, fq = lane >> 4;
    int K_ = g.K; asm volatile("" : "+s"(K_));
    const int K = K_, nt = K / BK;
    unsigned voffA[2], voffB[2];
#pragma unroll
    for (int i = 0; i < 2; ++i) { int R, C; stage_rc(tid * 16 + i * 8192, R, C); const int Rb = Epi::PERM ? ((R & ~31) + perm32(R & 31)) : R;
        voffA[i] = (unsigned)(R * K + C) * 2u; voffB[i] = (unsigned)(Rb * K + C) * 2u; }
    const size_t kstep = (size_t)(BK * 2);
    const size_t hstep = (size_t)HALF * K * 2;
    const size_t tstep = 2 * hstep;
    const unsigned ldsw = (unsigned)wid * 1024u;
    const int aoff = lds_byte(wr * 64 + fr, fq * 8), boff = lds_byte(wc * 32 + fr, fq * 8);
#define PG8_SA(b, h) (((b) * 2 + (h)) * HTB)
#define PG8_SB(b, h) ((4 + (b) * 2 + (h)) * HTB)
#define PG8_STAGE(bufoff, gbase, voff) do { _Pragma("unroll") for (int _i = 0; _i < 2; ++_i) \
        __builtin_amdgcn_global_load_lds((const unsigned*)((const char*)(gbase) + (voff)[_i]), (PG8_LAS unsigned*)(lds + (bufoff) + ldsw + _i * 8192), 16, 0, 0); } while (0)
#define PG8_LDA(dst, b, h) do { _Pragma("unroll") for (int m = 0; m < 4; ++m) _Pragma("unroll") for (int k = 0; k < 2; ++k) dst[m][k] = *(const PG8_LAS bf16x8*)(lds + PG8_SA(b, h) + aoff + m * 2048 + k * 1024); } while (0)
#define PG8_LDB(dst, b, h) do { _Pragma("unroll") for (int n = 0; n < 2; ++n) _Pragma("unroll") for (int k = 0; k < 2; ++k) dst[n][k] = *(const PG8_LAS bf16x8*)(lds + PG8_SB(b, h) + boff + n * 2048 + k * 1024); } while (0)
#define PG8_MMA(ai, bj, At, Bt) do { __builtin_amdgcn_s_setprio(1); _Pragma("unroll") for (int m = 0; m < 4; ++m) _Pragma("unroll") for (int n = 0; n < 2; ++n) _Pragma("unroll") for (int k = 0; k < 2; ++k) \
        acc[ai][bj][m][n] = __builtin_amdgcn_mfma_f32_16x16x32_bf16(Bt[n][k], At[m][k], acc[ai][bj][m][n], 0, 0, 0); __builtin_amdgcn_s_setprio(0); } while (0)
#define PG8_WAIT_V(n) asm volatile("s_waitcnt vmcnt(" #n ")" ::: "memory")
#define PG8_WAIT_L(n) asm volatile("s_waitcnt lgkmcnt(" #n ")" ::: "memory")
#define PG8_BAR __builtin_amdgcn_s_barrier()
#define PG8_SCHED __builtin_amdgcn_sched_barrier(0)
    Unit cur, nxt; int ui = 0;
    if (!S.next(0, cur)) return;
    f32x4 acc[2][2][4][2];
#pragma unroll
    for (int a = 0; a < 2; ++a)
#pragma unroll
        for (int b = 0; b < 2; ++b)
#pragma unroll
            for (int m = 0; m < 4; ++m)
#pragma unroll
                for (int n = 0; n < 2; ++n) acc[a][b][m][n] = (f32x4){0.f, 0.f, 0.f, 0.f};
    bf16x8 At[4][2], B0[2][2], B1[2][2];
    const char* cA = (const char*)g.A + (size_t)cur.pm * tstep; const char* cB = (const char*)g.Bt + (size_t)cur.pn * tstep;
    S.a_ready(cur);
    if constexpr (SP2) {
        PG8_STAGE(PG8_SB(0, 0), cB, voffB); PG8_STAGE(PG8_SB(0, 1), cB + hstep, voffB); PG8_STAGE(PG8_SA(0, 0), cA, voffA); PG8_STAGE(PG8_SA(0, 1), cA + hstep, voffA);
        if (wr == 1) PG8_BAR;
        PG8_WAIT_V(2); PG8_BAR;
        PG8_STAGE(PG8_SB(1, 0), cB + kstep, voffB); PG8_STAGE(PG8_SA(1, 0), cA + kstep, voffA); PG8_STAGE(PG8_SB(1, 1), cB + hstep + kstep, voffB);
        PG8_WAIT_V(6); PG8_BAR;
    } else {
        PG8_STAGE(PG8_SB(0, 0), cB, voffB); PG8_STAGE(PG8_SA(0, 0), cA, voffA); PG8_STAGE(PG8_SB(0, 1), cB + hstep, voffB); PG8_STAGE(PG8_SA(0, 1), cA + hstep, voffA);
        if (wr == 1) PG8_BAR;
        PG8_WAIT_V(4); PG8_BAR;
        PG8_STAGE(PG8_SB(1, 0), cB + kstep, voffB); PG8_STAGE(PG8_SA(1, 0), cA + kstep, voffA); PG8_STAGE(PG8_SB(1, 1), cB + hstep + kstep, voffB);
        PG8_WAIT_V(6); PG8_BAR;
    }
    for (;;) {
        const bool has_next = S.next(ui + 1, nxt);
        const char* nA = has_next ? (const char*)g.A + (size_t)nxt.pm * tstep : cA; const char* nB = has_next ? (const char*)g.Bt + (size_t)nxt.pn * tstep : cB;
        for (int t = 0; t < nt; t += 2) {
            const bool last = (t == nt - 2);
            const char* a1 = cA + (size_t)(t + 1) * kstep;
            const char* a2 = last ? nA : cA + (size_t)(t + 2) * kstep; const char* b2 = last ? nB : cB + (size_t)(t + 2) * kstep;
            const char* a3 = a2 + kstep; const char* b3 = b2 + kstep;
            if (last && has_next) S.a_ready(nxt);
            if constexpr (SP2) {
            PG8_LDB(B0, 0, 0); PG8_LDB(B1, 0, 1); PG8_SCHED; PG8_LDA(At, 0, 0); PG8_STAGE(PG8_SA(1, 1), a1 + hstep, voffA);
            PG8_WAIT_V(8); PG8_WAIT_L(0); PG8_BAR; PG8_MMA(0, 0, At, B0); PG8_MMA(0, 1, At, B1); PG8_BAR; PG8_SCHED;
            PG8_LDA(At, 0, 1); PG8_STAGE(PG8_SB(0, 0), b2, voffB); PG8_STAGE(PG8_SB(0, 1), b2 + hstep, voffB); PG8_STAGE(PG8_SA(0, 0), a2, voffA);
            PG8_WAIT_V(8); PG8_WAIT_L(0); PG8_BAR; PG8_MMA(1, 0, At, B0); PG8_MMA(1, 1, At, B1); PG8_BAR; PG8_SCHED;
            PG8_LDB(B0, 1, 0); PG8_LDB(B1, 1, 1); PG8_SCHED; PG8_LDA(At, 1, 0); PG8_STAGE(PG8_SA(0, 1), a2 + hstep, voffA);
            PG8_WAIT_V(8); PG8_WAIT_L(0); PG8_BAR; PG8_MMA(0, 0, At, B0); PG8_MMA(0, 1, At, B1); PG8_BAR; PG8_SCHED;
            PG8_LDA(At, 1, 1); PG8_STAGE(PG8_SB(1, 0), b3, voffB); PG8_STAGE(PG8_SB(1, 1), b3 + hstep, voffB); PG8_STAGE(PG8_SA(1, 0), a3, voffA);
            PG8_WAIT_V(8); PG8_WAIT_L(0); PG8_BAR; PG8_MMA(1, 0, At, B0); PG8_MMA(1, 1, At, B1); PG8_BAR; PG8_SCHED;
            } else {
            PG8_LDB(B0, 0, 0); PG8_SCHED; PG8_LDA(At, 0, 0); PG8_STAGE(PG8_SA(1, 1), a1 + hstep, voffA);
            PG8_WAIT_L(8); PG8_BAR; PG8_WAIT_L(0); PG8_MMA(0, 0, At, B0); PG8_BAR; PG8_SCHED;
            PG8_LDB(B1, 0, 1); PG8_STAGE(PG8_SB(0, 0), b2, voffB);
            PG8_BAR; PG8_WAIT_L(0); PG8_MMA(0, 1, At, B1); PG8_BAR;
            PG8_LDA(At, 0, 1); PG8_STAGE(PG8_SA(0, 0), a2, voffA);
            PG8_BAR; PG8_WAIT_L(0); PG8_MMA(1, 0, At, B0); PG8_BAR; PG8_SCHED;
            PG8_STAGE(PG8_SB(0, 1), b2 + hstep, voffB);
            PG8_WAIT_V(6); PG8_BAR; PG8_MMA(1, 1, At, B1); PG8_BAR;
            PG8_LDB(B0, 1, 0); PG8_SCHED; PG8_LDA(At, 1, 0); PG8_STAGE(PG8_SA(0, 1), a2 + hstep, voffA);
            PG8_WAIT_L(8); PG8_BAR; PG8_WAIT_L(0); PG8_MMA(0, 0, At, B0); PG8_BAR; PG8_SCHED;
            PG8_LDB(B1, 1, 1); PG8_STAGE(PG8_SB(1, 0), b3, voffB);
            PG8_BAR; PG8_WAIT_L(0); PG8_MMA(0, 1, At, B1); PG8_BAR;
            PG8_LDA(At, 1, 1); PG8_STAGE(PG8_SA(1, 0), a3, voffA);
            PG8_BAR; PG8_WAIT_L(0); PG8_MMA(1, 0, At, B0); PG8_BAR; PG8_SCHED;
            PG8_STAGE(PG8_SB(1, 1), b3 + hstep, voffB);
            PG8_WAIT_V(6); PG8_BAR; PG8_MMA(1, 1, At, B1); PG8_BAR;
            }
        }
        if constexpr (ALIGN_EPI) { if (wr == 0) PG8_BAR; }
        if constexpr (!Epi::AFTER_DRAIN) { if (cur.kind & 0x100) E.mid(acc, cur, wr, wc, fr, fq); else E(acc, cur, wr, wc, fr, fq); S.done(cur); }
        if (!has_next) break;
        {
#pragma unroll
        for (int a = 0; a < 2; ++a)
#pragma unroll
            for (int b = 0; b < 2; ++b)
#pragma unroll
                for (int m = 0; m < 4; ++m)
#pragma unroll
                    for (int n = 0; n < 2; ++n) acc[a][b][m][n] = (f32x4){0.f, 0.f, 0.f, 0.f};
        }
        cur = nxt; cA = nA; cB = nB; ++ui;
        if constexpr (ALIGN_EPI) { if (wr == 1) PG8_BAR; }
    }
    PG8_WAIT_V(0);
    if constexpr (!ALIGN_EPI) { if (wr == 0) PG8_BAR; }
    PG8_BAR;
    if constexpr (Epi::AFTER_DRAIN) { E.fused(acc, cur, wr, wc, fr, fq, lds, wid, lane); S.done(cur); }
#undef PG8_SA
#undef PG8_SB
#undef PG8_STAGE
#undef PG8_LDA
#undef PG8_LDB
#undef PG8_MMA
#undef PG8_WAIT_V
#undef PG8_WAIT_L
#undef PG8_BAR
#undef PG8_SCHED
}
}

#define LAS __attribute__((address_space(3)))
typedef unsigned short bf16;
typedef float f32x4 __attribute__((ext_vector_type(4)));
typedef float f32x2 __attribute__((ext_vector_type(2)));
typedef float f32x16 __attribute__((ext_vector_type(16)));
typedef short bf16x8 __attribute__((ext_vector_type(8)));
typedef short s16x4 __attribute__((ext_vector_type(4)));
typedef unsigned u32x4 __attribute__((ext_vector_type(4)));
typedef unsigned u32x2 __attribute__((ext_vector_type(2)));
typedef __bf16 bf16x2_t __attribute__((ext_vector_type(2)));

constexpr int DM = 1024, SEQ = 4096, NB = 8, M = NB * SEQ, FF = 4096;
constexpr int NWAVES = 8;
constexpr float EPS = 1e-6f, LOG2E = 1.4426950408889634f;
constexpr float C2_MLA = 0.10206207261596575f * LOG2E;
constexpr float C2_SWA = 0.125f * LOG2E;
constexpr int N_IN_PAD = 3840;

constexpr size_t MiB = 1u << 20;
constexpr size_t WS_CTL = 0, CTL_BYTES = 65536;
constexpr size_t WS_TAB = 1 * MiB, WS_PQ = 2 * MiB, WS_PKV = 2 * MiB + 512 * 1024, WS_PT = 3 * MiB, WS_PE = 5 * MiB, WS_RSTDE = 7 * MiB;
constexpr size_t WS_WIN = 8 * MiB, WS_WQKV = 16 * MiB, WS_WPP = 18 * MiB, WS_WUP = 19 * MiB, WS_WOUT = 23 * MiB, WS_W1 = 25 * MiB, WS_W2 = 33 * MiB, WS_WPG = 41 * MiB;
constexpr size_t WS_XN = 48 * MiB, WS_QA = 112 * MiB, WS_KVR = 128 * MiB, WS_KS = 144 * MiB, WS_VS = 152 * MiB, WS_KROPE = 160 * MiB, WS_ERAW = 112 * MiB;
constexpr size_t WS_T = 176 * MiB, WS_QR = 176 * MiB, WS_PB = 240 * MiB;
constexpr size_t WS_QN = 256 * MiB, WS_QS = 320 * MiB, WS_KN = 384 * MiB, WS_VM = 448 * MiB, WS_U = 256 * MiB, WS_END = 512 * MiB;

constexpr int LDS_BYTES = 132 * 1024;

struct Params { const float* in[20]; float* out; unsigned char* ws; int ph_lo, ph_hi; };

__device__ __forceinline__ unsigned cvtpk(float lo, float hi) { f32x2 v = {lo, hi}; bf16x2_t b = __builtin_convertvector(v, bf16x2_t); return __builtin_bit_cast(unsigned, b); }
__device__ __forceinline__ u32x2 pack4(f32x4 v) { u32x2 r; r.x = cvtpk(v[0], v[1]); r.y = cvtpk(v[2], v[3]); return r; }
__device__ __forceinline__ float bf2f(unsigned short h) { return __builtin_bit_cast(float, (unsigned)h << 16); }
__device__ __forceinline__ f32x4 unpack4(u32x2 w) { f32x4 r; r[0] = __builtin_bit_cast(float, w.x << 16); r[1] = __builtin_bit_cast(float, w.x & 0xffff0000u); r[2] = __builtin_bit_cast(float, w.y << 16); r[3] = __builtin_bit_cast(float, w.y & 0xffff0000u); return r; }
__device__ __forceinline__ float sigmoidf_(float x) { return __builtin_amdgcn_rcpf(1.0f + __builtin_amdgcn_exp2f(-x * LOG2E)); }
__device__ __forceinline__ f32x4 sigmoid4(f32x4 v) { f32x4 r; r[0] = sigmoidf_(v[0]); r[1] = sigmoidf_(v[1]); r[2] = sigmoidf_(v[2]); r[3] = sigmoidf_(v[3]); return r; }
__device__ __forceinline__ float wave_sum(float v) {
#pragma unroll
    for (int o = 1; o < 64; o <<= 1) v += __shfl_xor(v, o);
    return v;
}
__device__ __forceinline__ float dot4(f32x4 v) { return (v[0] * v[0] + v[1] * v[1]) + (v[2] * v[2] + v[3] * v[3]); }

struct Sched {
    int G, c, nseg, pairs;
    int nN[2], pmo[2], pno[2], start[3];
    __device__ __forceinline__ bool next(int i, pg8::Unit& u) const {
        const int ii = pairs ? (i >> 1) : i;
        const long L = (long)ii * G + c; if (L >= start[nseg]) return false;
        const int s = (nseg > 1 && L >= start[1]) ? 1 : 0; const int l = (int)L - start[s];
        const int nwg = start[s + 1] - start[s], q = nwg >> 3, id = (l & 7) * q + (l >> 3);
        const int nig = 8 * nN[s], gid = id / nig, r = id % nig;
        const int pm = gid * 8 + (r & 7), pn = r >> 3;
        u.pm = pmo[s] + pm; u.pn = pno[s] + pn; u.kind = u.pn;
        if (pairs) { if (i & 1) { u.pm += 128; u.pn += 4; u.kind = 0; } else u.kind = 0x100; }
        return true;
    }
    __device__ __forceinline__ void a_ready(const pg8::Unit&) const {}
    __device__ __forceinline__ void done(const pg8::Unit&) const {}
};
__device__ __forceinline__ Sched make_sched(int G, int c, int nN0) { Sched s; s.G = G; s.c = c; s.nseg = 1; s.pairs = 0; s.nN[0] = nN0; s.nN[1] = 1; s.pmo[0] = s.pmo[1] = 0; s.pno[0] = s.pno[1] = 0; s.start[0] = 0; s.start[1] = 128 * nN0; s.start[2] = s.start[1]; return s; }

typedef pg8::f32x4 A4;
#define EPI_ROWS(ai, m) for (int ai = 0; ai < 2; ++ai) _Pragma("unroll") for (int m = 0; m < 4; ++m)

struct EpiP1 {
    static constexpr bool PERM = false, AFTER_DRAIN = false;
    bf16 *qa, *kvr, *krope, *qs, *ks, *vs, *gates; float *part_q, *part_kv; const f32x2* tab;
    __device__ __forceinline__ void mid(const A4 (&acc)[2][2][4][2], const pg8::Unit& u, int wr, int wc, int fr, int fq) const {}
    __device__ __forceinline__ void operator()(const A4 (&acc)[2][2][4][2], const pg8::Unit& u, int wr, int wc, int fr, int fq) const {
        const int pn = u.kind, row0 = u.pm * 256 + wr * 64 + fr, cl0 = wc * 32 + fq * 4;
        if (pn <= 1) {
            bf16* dst = pn == 0 ? qa : kvr; float* part = pn == 0 ? part_q : part_kv;
#pragma unroll
            EPI_ROWS(ai, m) { const int row = row0 + ai * 128 + m * 16; float ss = 0.f;
#pragma unroll
                for (int bj = 0; bj < 2; ++bj)
#pragma unroll
                    for (int n = 0; n < 2; ++n) { const A4 v = acc[ai][bj][m][n]; if (pn == 0 || bj == 0) ss += dot4(v);
                        *(u32x2*)(dst + (size_t)row * 256 + bj * 128 + cl0 + n * 16) = pack4(v); }
                ss += __shfl_xor(ss, 16); ss += __shfl_xor(ss, 32);
                if (fq == 0) part[(size_t)row * 4 + wc] = ss;
                if (pn == 1 && wc == 0) {
                    const int pos = row & (SEQ - 1); const A4 x1 = acc[ai][1][m][0], x2 = acc[ai][1][m][1]; A4 o1, o2;
#pragma unroll
                    for (int e = 0; e < 4; ++e) { const f32x2 cs = tab[pos * 32 + 2 * (4 * fq + e)]; o1[e] = x1[e] * cs.x - x2[e] * cs.y; o2[e] = x2[e] * cs.x + x1[e] * cs.y; }
                    *(u32x2*)(krope + (size_t)row * 32 + 4 * fq) = pack4(o1); *(u32x2*)(krope + (size_t)row * 32 + 16 + 4 * fq) = pack4(o2);
                }
            }
        } else if (pn <= 6) {
            const int d1 = 16 * (wc & 1) + 4 * fq;
            f32x4 tb[2][2];
            { const int pos = row0 & (SEQ - 1); tb[0][0] = *(const f32x4*)(tab + pos * 32 + d1); tb[0][1] = *(const f32x4*)(tab + pos * 32 + d1 + 2); }
#pragma unroll
            for (int it = 0; it < 8; ++it) { const int ai = it >> 2, m = it & 3; const int row = row0 + ai * 128 + m * 16;
                if (it + 1 < 8) { const int pos = (row0 + ((it + 1) >> 2) * 128 + ((it + 1) & 3) * 16) & (SEQ - 1); tb[(it + 1) & 1][0] = *(const f32x4*)(tab + pos * 32 + d1); tb[(it + 1) & 1][1] = *(const f32x4*)(tab + pos * 32 + d1 + 2); }
                asm volatile("" ::: "memory");
                const f32x4 t0 = tb[it & 1][0], t1 = tb[it & 1][1];
                const float cc[4] = {t0[0], t0[2], t1[0], t1[2]}, sn[4] = {t0[1], t0[3], t1[1], t1[3]};
#pragma unroll
                for (int bj = 0; bj < 2; ++bj) {
                    if (pn == 6 && bj == 1) {
#pragma unroll
                        for (int n = 0; n < 2; ++n) *(u32x2*)(vs + (size_t)row * 128 + cl0 + n * 16) = pack4(acc[ai][1][m][n]);
                    } else {
                        const A4 x1 = acc[ai][bj][m][0], x2 = acc[ai][bj][m][1]; A4 o1, o2; const float sc = pn == 6 ? 1.0f : C2_SWA;
#pragma unroll
                        for (int e = 0; e < 4; ++e) { o1[e] = (x1[e] * cc[e] - x2[e] * sn[e]) * sc; o2[e] = (x2[e] * cc[e] + x1[e] * sn[e]) * sc; }
                        bf16* d = pn == 6 ? ks + (size_t)row * 128 + (wc >> 1) * 64 : qs + (size_t)row * 1024 + ((pn - 2) * 4 + bj * 2 + (wc >> 1)) * 64;
                        *(u32x2*)(d + d1) = pack4(o1); *(u32x2*)(d + 32 + d1) = pack4(o2);
                    }
                }
            }
        } else {
#pragma unroll
            EPI_ROWS(ai, m) { const int row = row0 + ai * 128 + m * 16;
#pragma unroll
                for (int bj = 0; bj < 2; ++bj)
#pragma unroll
                    for (int n = 0; n < 2; ++n) *(u32x2*)(gates + (size_t)row * 2048 + (pn - 7) * 256 + bj * 128 + cl0 + n * 16) = pack4(sigmoid4(acc[ai][bj][m][n]));
            }
        }
    }
};

struct EpiP2 {
    static constexpr bool PERM = false, AFTER_DRAIN = false;
    bf16 *qn, *qr, *kn, *vm; const float *part_q, *part_kv; const f32x2* tab;
    __device__ __forceinline__ void mid(const A4 (&acc)[2][2][4][2], const pg8::Unit& u, int wr, int wc, int fr, int fq) const {}
    __device__ __forceinline__ void operator()(const A4 (&acc)[2][2][4][2], const pg8::Unit& u, int wr, int wc, int fr, int fq) const {
        const int pn = u.kind, row0 = (u.pm & 127) * 256 + wr * 64 + fr, cl0 = wc * 32 + fq * 4;
        const bool isq = pn < 6, isrope = pn == 4 || pn == 5; const float* part = isq ? part_q : part_kv; const float invn = isq ? (1.0f / 256.0f) : (1.0f / 128.0f);
        f32x4 pp[2]; f32x4 tb[2][2];
        pp[0] = *(const f32x4*)(part + (size_t)row0 * 4);
        if (isrope) { const int pos = row0 & (SEQ - 1); tb[0][0] = *(const f32x4*)(tab + pos * 32 + 8 * fq); tb[0][1] = *(const f32x4*)(tab + pos * 32 + 8 * fq + 4); }
        f32x4 tc[2][2];
        if (isrope) { const int pos = row0 & (SEQ - 1); tc[0][0] = *(const f32x4*)(tab + pos * 32 + 8 * fq + 2); tc[0][1] = *(const f32x4*)(tab + pos * 32 + 8 * fq + 6); }
#pragma unroll
        for (int it = 0; it < 8; ++it) { const int ai = it >> 2, m = it & 3; const int row = row0 + ai * 128 + m * 16;
            if (it + 1 < 8) { const int rn = row0 + ((it + 1) >> 2) * 128 + ((it + 1) & 3) * 16; pp[(it + 1) & 1] = *(const f32x4*)(part + (size_t)rn * 4);
                if (isrope) { const int pos = rn & (SEQ - 1); tb[(it + 1) & 1][0] = *(const f32x4*)(tab + pos * 32 + 8 * fq); tb[(it + 1) & 1][1] = *(const f32x4*)(tab + pos * 32 + 8 * fq + 4);
                    tc[(it + 1) & 1][0] = *(const f32x4*)(tab + pos * 32 + 8 * fq + 2); tc[(it + 1) & 1][1] = *(const f32x4*)(tab + pos * 32 + 8 * fq + 6); } }
            asm volatile("" ::: "memory");
            const f32x4 p4 = pp[it & 1];
            float rs = __builtin_amdgcn_rsqf(((p4[0] + p4[1]) + (p4[2] + p4[3])) * invn + EPS);
            if (isq) rs *= C2_MLA;
            if (isrope) {
                const float cc[4] = {tb[it & 1][0][0], tc[it & 1][0][0], tb[it & 1][1][0], tc[it & 1][1][0]}, sn[4] = {tb[it & 1][0][1], tc[it & 1][0][1], tb[it & 1][1][1], tc[it & 1][1][1]};
#pragma unroll
                for (int bj = 0; bj < 2; ++bj) { const A4 x1 = acc[ai][bj][m][0], x2 = acc[ai][bj][m][1]; A4 o1, o2;
#pragma unroll
                    for (int e = 0; e < 4; ++e) { o1[e] = (x1[e] * cc[e] - x2[e] * sn[e]) * rs; o2[e] = (x2[e] * cc[e] + x1[e] * sn[e]) * rs; }
                    bf16* d = qr + (size_t)row * 512 + ((pn - 4) * 8 + bj * 4 + wc) * 32;
                    *(u32x2*)(d + 4 * fq) = pack4(o1); *(u32x2*)(d + 16 + 4 * fq) = pack4(o2); }
            } else {
                bf16* d = pn < 4 ? qn + (size_t)row * 1024 + pn * 256 : (pn < 10 ? kn + (size_t)row * 1024 + (pn - 6) * 256 : vm + (size_t)row * 1024 + (pn - 10) * 256);
#pragma unroll
                for (int bj = 0; bj < 2; ++bj)
#pragma unroll
                    for (int n = 0; n < 2; ++n) *(u32x2*)(d + bj * 128 + cl0 + n * 16) = pack4(acc[ai][bj][m][n] * rs);
            }
        }
    }
};

struct EpiP4 {
    static constexpr bool PERM = false, AFTER_DRAIN = false;
    const bf16* gates; bf16* y; bf16* ya;
    __device__ __forceinline__ void mid(const A4 (&acc)[2][2][4][2], const pg8::Unit& u, int wr, int wc, int fr, int fq) const {
        const int row0 = u.pm * 256 + wr * 64 + fr, col0 = u.pn * 256 + wc * 32 + fq * 4;
        u32x2 gq[2][2][2];
#define P4_LD(buf, it_) do { const bf16* g_ = gates + (size_t)(row0 + ((it_) >> 2) * 128 + ((it_) & 3) * 16) * 2048 + col0; \
        _Pragma("unroll") for (int bj = 0; bj < 2; ++bj) _Pragma("unroll") for (int n = 0; n < 2; ++n) gq[buf][bj][n] = *(const u32x2*)(g_ + bj * 128 + n * 16); } while (0)
        P4_LD(0, 0);
#pragma unroll
        for (int it = 0; it < 8; ++it) { const int ai = it >> 2, m = it & 3; const size_t row = (size_t)(row0 + ai * 128 + m * 16);
            if (it + 1 < 8) P4_LD((it + 1) & 1, it + 1);
            asm volatile("" ::: "memory");
#pragma unroll
            for (int bj = 0; bj < 2; ++bj)
#pragma unroll
                for (int n = 0; n < 2; ++n) *(u32x2*)(ya + row * 1024 + col0 + bj * 128 + n * 16) = pack4(acc[ai][bj][m][n] * unpack4(gq[it & 1][bj][n]));
        }
#undef P4_LD
    }
    __device__ __forceinline__ void operator()(const A4 (&acc)[2][2][4][2], const pg8::Unit& u, int wr, int wc, int fr, int fq) const {
        const int row0 = (u.pm - 128) * 256 + wr * 64 + fr, col0 = (u.pn - 4) * 256 + wc * 32 + fq * 4;
        u32x2 gq[2][2][2], yq[2][2][2];
#define P4_LD(buf, it_) do { const size_t r_ = (size_t)(row0 + ((it_) >> 2) * 128 + ((it_) & 3) * 16); const bf16* g_ = gates + r_ * 2048 + 1024 + col0; const bf16* y_ = ya + r_ * 1024 + col0; \
        _Pragma("unroll") for (int bj = 0; bj < 2; ++bj) _Pragma("unroll") for (int n = 0; n < 2; ++n) { gq[buf][bj][n] = *(const u32x2*)(g_ + bj * 128 + n * 16); yq[buf][bj][n] = *(const u32x2*)(y_ + bj * 128 + n * 16); } } while (0)
        P4_LD(0, 0);
#pragma unroll
        for (int it = 0; it < 8; ++it) { const int ai = it >> 2, m = it & 3; const size_t row = (size_t)(row0 + ai * 128 + m * 16);
            if (it + 1 < 8) P4_LD((it + 1) & 1, it + 1);
            asm volatile("" ::: "memory");
#pragma unroll
            for (int bj = 0; bj < 2; ++bj)
#pragma unroll
                for (int n = 0; n < 2; ++n) *(u32x2*)(y + row * 1024 + col0 + bj * 128 + n * 16) = pack4(unpack4(yq[it & 1][bj][n]) + acc[ai][bj][m][n] * unpack4(gq[it & 1][bj][n]));
        }
#undef P4_LD
    }
};

struct EpiT {
    static constexpr bool PERM = false, AFTER_DRAIN = false;
    bf16* o; float* part;
    __device__ __forceinline__ void mid(const A4 (&acc)[2][2][4][2], const pg8::Unit& u, int wr, int wc, int fr, int fq) const {}
    __device__ __forceinline__ void operator()(const A4 (&acc)[2][2][4][2], const pg8::Unit& u, int wr, int wc, int fr, int fq) const {
        const int row0 = u.pm * 256 + wr * 64 + fr, col0 = u.pn * 256 + wc * 32 + fq * 4;
#pragma unroll
        EPI_ROWS(ai, m) { const size_t row = (size_t)(row0 + ai * 128 + m * 16); float ss = 0.f;
#pragma unroll
            for (int bj = 0; bj < 2; ++bj)
#pragma unroll
                for (int n = 0; n < 2; ++n) { const A4 v = acc[ai][bj][m][n]; ss += dot4(v); *(u32x2*)(o + row * 1024 + col0 + bj * 128 + n * 16) = pack4(v); }
            ss += __shfl_xor(ss, 16); ss += __shfl_xor(ss, 32);
            if (fq == 0) part[row * 16 + u.pn * 4 + wc] = ss;
        }
    }
};

struct EpiRelu2 {
    static constexpr bool PERM = false, AFTER_DRAIN = false;
    bf16* o;
    __device__ __forceinline__ void mid(const A4 (&acc)[2][2][4][2], const pg8::Unit& u, int wr, int wc, int fr, int fq) const {}
    __device__ __forceinline__ void operator()(const A4 (&acc)[2][2][4][2], const pg8::Unit& u, int wr, int wc, int fr, int fq) const {
        const int row0 = u.pm * 256 + wr * 64 + fr, col0 = u.pn * 256 + wc * 32 + fq * 4;
#pragma unroll
        EPI_ROWS(ai, m) { const size_t row = (size_t)(row0 + ai * 128 + m * 16);
#pragma unroll
            for (int bj = 0; bj < 2; ++bj)
#pragma unroll
                for (int n = 0; n < 2; ++n) { A4 v = acc[ai][bj][m][n];
#pragma unroll
                    for (int e = 0; e < 4; ++e) { const float r = __builtin_fmaxf(v[e], 0.f); v[e] = r * r; }
                    *(u32x2*)(o + row * FF + col0 + bj * 128 + n * 16) = pack4(v); }
        }
    }
};

struct EpiOut {
    static constexpr bool PERM = false, AFTER_DRAIN = false;
    float* out; const bf16* eraw; const float* rstd_e; const float* gple;
    __device__ __forceinline__ void mid(const A4 (&acc)[2][2][4][2], const pg8::Unit& u, int wr, int wc, int fr, int fq) const {}
    __device__ __forceinline__ void operator()(const A4 (&acc)[2][2][4][2], const pg8::Unit& u, int wr, int wc, int fr, int fq) const {
        const int row0 = u.pm * 256 + wr * 64 + fr, col0 = u.pn * 256 + wc * 32 + fq * 4;
        f32x4 gv[2][2];
#pragma unroll
        for (int bj = 0; bj < 2; ++bj)
#pragma unroll
            for (int n = 0; n < 2; ++n) gv[bj][n] = *(const f32x4*)(gple + col0 + bj * 128 + n * 16);
        f32x4 xq[2][2][2]; u32x2 eq[2][2][2]; float rq[2];
#define PO_LD(buf, it_) do { const size_t r_ = (size_t)(row0 + ((it_) >> 2) * 128 + ((it_) & 3) * 16); rq[buf] = rstd_e[r_]; \
        _Pragma("unroll") for (int bj = 0; bj < 2; ++bj) _Pragma("unroll") for (int n = 0; n < 2; ++n) { const size_t off_ = r_ * 1024 + col0 + bj * 128 + n * 16; xq[buf][bj][n] = *(const f32x4*)(out + off_); eq[buf][bj][n] = *(const u32x2*)(eraw + off_); } } while (0)
        PO_LD(0, 0);
#pragma unroll
        for (int it = 0; it < 8; ++it) { const int ai = it >> 2, m = it & 3; const size_t row = (size_t)(row0 + ai * 128 + m * 16);
            if (it + 1 < 8) PO_LD((it + 1) & 1, it + 1);
            asm volatile("" ::: "memory");
#pragma unroll
            for (int bj = 0; bj < 2; ++bj)
#pragma unroll
                for (int n = 0; n < 2; ++n) { const size_t off = row * 1024 + col0 + bj * 128 + n * 16;
                    *(f32x4*)(out + off) = xq[it & 1][bj][n] + sigmoid4(acc[ai][bj][m][n]) * (unpack4(eq[it & 1][bj][n]) * rq[it & 1] * gv[bj][n]); }
        }
#undef PO_LD
    }
};

namespace att {
constexpr int KP = 208, VP = 192, KBUF = 64 * KP, VBUF = 64 * VP, STAGE = KBUF + VBUF;
__device__ __forceinline__ float max3f(float a, float b, float c) { float r; asm("v_max3_f32 %0, %1, %2, %3" : "=v"(r) : "v"(a), "v"(b), "v"(c)); return r; }
__device__ __forceinline__ float max2f(float a, float b) { float r; asm("v_max_f32_e32 %0, %1, %2" : "=v"(r) : "v"(a), "v"(b)); return r; }
__device__ __forceinline__ float xhalf_max(float v) { auto rr = __builtin_amdgcn_permlane32_swap(__float_as_uint(v), __float_as_uint(v), false, false); return max2f(__uint_as_float(rr[0]), __uint_as_float(rr[1])); }
__device__ __forceinline__ float xhalf_sum(float v) { auto rr = __builtin_amdgcn_permlane32_swap(__float_as_uint(v), __float_as_uint(v), false, false); return __uint_as_float(rr[0]) + __uint_as_float(rr[1]); }
__device__ __forceinline__ s16x4 vtr(const LAS unsigned char* p) { return __builtin_bit_cast(s16x4, __builtin_amdgcn_ds_read_tr16_b64_v4i16((LAS s16x4*)p)); }

template <int MODE>
__device__ __forceinline__ void unit(LAS unsigned char* lds, const bf16* __restrict__ Qa, const bf16* __restrict__ Qb, const bf16* __restrict__ Ka, const bf16* __restrict__ Kb, const bf16* __restrict__ Va, bf16* O,
                                     const float* __restrict__ sinks, int b, int h, int blk, int hp) {
    constexpr int NC = MODE == 0 ? 6 : 4;
    const int tid = threadIdx.x, lane = tid & 63, w = __builtin_amdgcn_readfirstlane(tid >> 6), l31 = lane & 31, hi = lane >> 5;
    int hq, qpos0w, t_beg, t_end, kpos_base; size_t krow_base; int kvpitch, kvcol;
    if (MODE == 0) { hq = h; qpos0w = blk * 256 + w * 32; t_beg = 0; t_end = 4 * blk + 4; kpos_base = 0; kvpitch = 1024; kvcol = h * 64; }
    else { hq = 8 * h + 2 * hp + (w >> 2); qpos0w = blk * 128 + (w & 3) * 32; t_beg = blk == 0 ? 2 : 0; t_end = 4; kpos_base = (blk - 1) * 128; kvpitch = 128; kvcol = h * 64; }
    const size_t seq0 = (size_t)b * SEQ;
    const int qpos = qpos0w + l31;
    bf16x8 qf[NC];
    { const bf16* qp = Qa + (seq0 + qpos) * 1024 + hq * 64 + hi * 8;
#pragma unroll
      for (int c = 0; c < 4; ++c) qf[c] = *(const bf16x8*)(qp + c * 16);
      if (MODE == 0) { const bf16* qp2 = Qb + (seq0 + qpos) * 512 + hq * 32 + hi * 8;
#pragma unroll
          for (int c = 4; c < NC; ++c) qf[c] = *(const bf16x8*)(qp2 + (c - 4) * 16); } }
    const int skey = tid >> 3, sch = tid & 7;
    const bf16* kg = Ka + ((long)seq0 + kpos_base + skey) * kvpitch + kvcol + sch * 8;
    const bf16* vg = Va + ((long)seq0 + kpos_base + skey) * kvpitch + kvcol + sch * 8;
    const bf16* rg = MODE == 0 ? Kb + (seq0 + (tid >> 2)) * 32 + (tid & 3) * 8 : nullptr;
    const int kw_off = skey * KP + sch * 16, vw_off = KBUF + skey * VP + sch * 16, rw_off = (tid >> 2) * KP + 128 + (tid & 3) * 16;
    const int pi = (l31 & 0x13) | ((l31 & 4) << 1) | ((l31 & 8) >> 1);
    const int kr_off = pi * KP + hi * 16;
    const int vr_off = KBUF + (8 * hi + ((lane & 15) >> 2)) * VP + (16 * ((lane >> 4) & 1) + 4 * (lane & 3)) * 2;
    float m_run, l_run;
    if (MODE == 0) { m_run = -1e30f; l_run = 0.f; } else { m_run = sinks[hq] * LOG2E; l_run = hi == 0 ? 1.f : 0.f; }
    f32x16 o0 = {}, o1 = {};
    u32x4 kreg, vreg, rreg = {};
    kreg = *(const u32x4*)(kg + (long)t_beg * 64 * kvpitch); vreg = *(const u32x4*)(vg + (long)t_beg * 64 * kvpitch);
    if (MODE == 0 && tid < 256) rreg = *(const u32x4*)(rg + (size_t)t_beg * 64 * 32);
    *(LAS u32x4*)(lds + kw_off) = kreg; *(LAS u32x4*)(lds + vw_off) = vreg;
    if (MODE == 0 && tid < 256) *(LAS u32x4*)(lds + rw_off) = rreg;
    __syncthreads();
    for (int t = t_beg; t < t_end; ++t) {
        const int st = ((t - t_beg) & 1) * STAGE, sn = STAGE - st;
        const bool more = t + 1 < t_end;
        if (more) { kreg = *(const u32x4*)(kg + (long)(t + 1) * 64 * kvpitch); vreg = *(const u32x4*)(vg + (long)(t + 1) * 64 * kvpitch);
            if (MODE == 0 && tid < 256) rreg = *(const u32x4*)(rg + (size_t)(t + 1) * 64 * 32); }
        const int kp0 = kpos_base + t * 64;
        bool doit, domask;
        if (MODE == 0) { doit = kp0 <= qpos0w + 31; domask = kp0 + 63 > qpos0w; }
        else { const int a = w & 3; doit = a < 2 ? (t <= 2) : (t >= 1); domask = true; }
        if (doit) {
            const LAS unsigned char* kb = lds + st + kr_off; const LAS unsigned char* vb = lds + st + vr_off;
            f32x16 s0 = {}, s1 = {};
#pragma unroll
            for (int c = 0; c < NC; ++c) { const bf16x8 k0 = *(const LAS bf16x8*)(kb + c * 32), k1 = *(const LAS bf16x8*)(kb + 32 * KP + c * 32);
                s0 = __builtin_amdgcn_mfma_f32_32x32x16_bf16(k0, qf[c], s0, 0, 0, 0); s1 = __builtin_amdgcn_mfma_f32_32x32x16_bf16(k1, qf[c], s1, 0, 0, 0); }
            if (domask) {
#pragma unroll
                for (int r = 0; r < 16; ++r) { const int kk = kp0 + 16 * (r >> 3) + 8 * hi + (r & 7); const int rel0 = qpos - kk, rel1 = rel0 - 32;
                    const bool ok0 = MODE == 0 ? rel0 >= 0 : (rel0 >= 0 && rel0 < 128), ok1 = MODE == 0 ? rel1 >= 0 : (rel1 >= 0 && rel1 < 128);
                    s0[r] = ok0 ? s0[r] : -1e30f; s1[r] = ok1 ? s1[r] : -1e30f; }
            }
            float mx = max2f(s0[0], s1[0]);
#pragma unroll
            for (int r = 1; r < 16; ++r) mx = max3f(mx, s0[r], s1[r]);
            mx = xhalf_max(mx);
            const float mnew = max2f(m_run, mx), alpha = __builtin_amdgcn_exp2f(m_run - mnew); m_run = mnew;
            f32x2 ps2 = {0.f, 0.f}; const f32x2 mn2 = {mnew, mnew};
#pragma unroll
            for (int r = 0; r < 16; r += 2) { f32x2 a2 = (f32x2){s0[r], s0[r + 1]} - mn2, b2 = (f32x2){s1[r], s1[r + 1]} - mn2;
                a2.x = __builtin_amdgcn_exp2f(a2.x); a2.y = __builtin_amdgcn_exp2f(a2.y); b2.x = __builtin_amdgcn_exp2f(b2.x); b2.y = __builtin_amdgcn_exp2f(b2.y);
                ps2 += a2; ps2 += b2; s0[r] = a2.x; s0[r + 1] = a2.y; s1[r] = b2.x; s1[r + 1] = b2.y; }
            l_run = l_run * alpha + (ps2.x + ps2.y);
            if (__builtin_amdgcn_ballot_w64(alpha != 1.0f) != 0ull) {
                const f32x2 al2 = {alpha, alpha};
#pragma unroll
                for (int r = 0; r < 16; r += 2) { f32x2 x = (f32x2){o0[r], o0[r + 1]} * al2, y = (f32x2){o1[r], o1[r + 1]} * al2; o0[r] = x.x; o0[r + 1] = x.y; o1[r] = y.x; o1[r + 1] = y.y; }
            }
            bf16x8 pk[4];
#pragma unroll
            for (int j = 0; j < 2; ++j) { u32x4 a, c2;
                a.x = cvtpk(s0[8 * j], s0[8 * j + 1]); a.y = cvtpk(s0[8 * j + 2], s0[8 * j + 3]); a.z = cvtpk(s0[8 * j + 4], s0[8 * j + 5]); a.w = cvtpk(s0[8 * j + 6], s0[8 * j + 7]);
                c2.x = cvtpk(s1[8 * j], s1[8 * j + 1]); c2.y = cvtpk(s1[8 * j + 2], s1[8 * j + 3]); c2.z = cvtpk(s1[8 * j + 4], s1[8 * j + 5]); c2.w = cvtpk(s1[8 * j + 6], s1[8 * j + 7]);
                pk[j] = __builtin_bit_cast(bf16x8, a); pk[2 + j] = __builtin_bit_cast(bf16x8, c2); }
#pragma unroll
            for (int j = 0; j < 4; ++j) {
                const s16x4 a0 = vtr(vb + (16 * j) * VP), a1 = vtr(vb + (16 * j + 4) * VP), b0 = vtr(vb + (16 * j) * VP + 64), b1 = vtr(vb + (16 * j + 4) * VP + 64);
                const bf16x8 va = {a0[0], a0[1], a0[2], a0[3], a1[0], a1[1], a1[2], a1[3]}, vb8 = {b0[0], b0[1], b0[2], b0[3], b1[0], b1[1], b1[2], b1[3]};
                o0 = __builtin_amdgcn_mfma_f32_32x32x16_bf16(va, pk[j], o0, 0, 0, 0); o1 = __builtin_amdgcn_mfma_f32_32x32x16_bf16(vb8, pk[j], o1, 0, 0, 0);
            }
        }
        if (more) { *(LAS u32x4*)(lds + sn + kw_off) = kreg; *(LAS u32x4*)(lds + sn + vw_off) = vreg;
            if (MODE == 0 && tid < 256) *(LAS u32x4*)(lds + sn + rw_off) = rreg; }
        __syncthreads();
    }
    const float inv = __builtin_amdgcn_rcpf(xhalf_sum(l_run));
    bf16* op = O + (seq0 + qpos) * 1024 + hq * 64 + 4 * hi;
#pragma unroll
    for (int g = 0; g < 4; ++g) { u32x2 w0, w1;
        w0.x = cvtpk(o0[4 * g] * inv, o0[4 * g + 1] * inv); w0.y = cvtpk(o0[4 * g + 2] * inv, o0[4 * g + 3] * inv);
        w1.x = cvtpk(o1[4 * g] * inv, o1[4 * g + 1] * inv); w1.y = cvtpk(o1[4 * g + 2] * inv, o1[4 * g + 3] * inv);
        *(u32x2*)(op + 8 * g) = w0; *(u32x2*)(op + 32 + 8 * g) = w1; }
}
}


__device__ __forceinline__ void swa_unit(LAS unsigned char* lds, const bf16* __restrict__ Qs, const bf16* __restrict__ Ks, const bf16* __restrict__ Vs, bf16* O, const float* __restrict__ sinks, int b, int g, int n) {
    using namespace att;
    constexpr int STG = KBUF + VBUF;
    const int tid = threadIdx.x, lane = tid & 63, w = __builtin_amdgcn_readfirstlane(tid >> 6), l31 = lane & 31, hi = lane >> 5;
    const int tb = n == 0 ? 2 : 0, kpos_base = (n - 1) * 128; const long seq0 = (long)b * SEQ;
    { const int skey = tid >> 3, sch = tid & 7; u32x4 kr[4], vr[4];
#pragma unroll
      for (int t = 0; t < 4; ++t) if (t >= tb) { const long off = (seq0 + kpos_base + t * 64 + skey) * 128 + g * 64 + sch * 8; kr[t] = *(const u32x4*)(Ks + off); vr[t] = *(const u32x4*)(Vs + off); }
#pragma unroll
      for (int t = 0; t < 4; ++t) if (t >= tb) { *(LAS u32x4*)(lds + t * STG + skey * KP + sch * 16) = kr[t]; *(LAS u32x4*)(lds + t * STG + KBUF + skey * VP + sch * 16) = vr[t]; } }
    __syncthreads();
    const int pi = (l31 & 0x13) | ((l31 & 4) << 1) | ((l31 & 8) >> 1);
    const int kr_k = pi * KP + hi * 16;
    const int vr_v = KBUF + (8 * hi + ((lane & 15) >> 2)) * VP + (16 * ((lane >> 4) & 1) + 4 * (lane & 3)) * 2;
    const int a = w & 3, qpos = n * 128 + a * 32 + l31;
    const int t0 = a < 2 ? tb : (tb > 1 ? tb : 1), t1 = a < 2 ? 2 : 3;
#pragma unroll 1
    for (int hp = 0; hp < 4; ++hp) {
        const int hq = 8 * g + 2 * hp + (w >> 2);
        bf16x8 qf[4];
        { const bf16* qp = Qs + (seq0 + qpos) * 1024 + hq * 64 + hi * 8;
#pragma unroll
          for (int c = 0; c < 4; ++c) qf[c] = *(const bf16x8*)(qp + c * 16); }
        float m_run = sinks[hq] * LOG2E, l_run = hi == 0 ? 1.f : 0.f;
        f32x16 o0 = {}, o1 = {};
#pragma unroll 1
        for (int t = t0; t <= t1; ++t) {
            const LAS unsigned char* kb = lds + t * STG + kr_k; const LAS unsigned char* vb = lds + t * STG + vr_v;
            f32x16 s0 = {}, s1 = {};
#pragma unroll
            for (int c = 0; c < 4; ++c) { const bf16x8 k0 = *(const LAS bf16x8*)(kb + c * 32), k1 = *(const LAS bf16x8*)(kb + 32 * KP + c * 32);
                s0 = __builtin_amdgcn_mfma_f32_32x32x16_bf16(k0, qf[c], s0, 0, 0, 0); s1 = __builtin_amdgcn_mfma_f32_32x32x16_bf16(k1, qf[c], s1, 0, 0, 0); }
            const int kp0 = kpos_base + t * 64;
#pragma unroll
            for (int r = 0; r < 16; ++r) { const int rel0 = qpos - (kp0 + 16 * (r >> 3) + 8 * hi + (r & 7)), rel1 = rel0 - 32;
                s0[r] = (rel0 >= 0 && rel0 < 128) ? s0[r] : -1e30f; s1[r] = (rel1 >= 0 && rel1 < 128) ? s1[r] : -1e30f; }
            float mx = max2f(s0[0], s1[0]);
#pragma unroll
            for (int r = 1; r < 16; ++r) mx = max3f(mx, s0[r], s1[r]);
            mx = xhalf_max(mx);
            const float mnew = max2f(m_run, mx), alpha = __builtin_amdgcn_exp2f(m_run - mnew); m_run = mnew;
            float ps = 0.f;
#pragma unroll
            for (int r = 0; r < 16; ++r) { s0[r] = __builtin_amdgcn_exp2f(s0[r] - mnew); s1[r] = __builtin_amdgcn_exp2f(s1[r] - mnew); ps += s0[r] + s1[r]; }
            l_run = l_run * alpha + ps;
#pragma unroll
            for (int r = 0; r < 16; ++r) { o0[r] *= alpha; o1[r] *= alpha; }
            bf16x8 pk[4];
#pragma unroll
            for (int j = 0; j < 2; ++j) { u32x4 a_, c_;
                a_.x = cvtpk(s0[8 * j], s0[8 * j + 1]); a_.y = cvtpk(s0[8 * j + 2], s0[8 * j + 3]); a_.z = cvtpk(s0[8 * j + 4], s0[8 * j + 5]); a_.w = cvtpk(s0[8 * j + 6], s0[8 * j + 7]);
                c_.x = cvtpk(s1[8 * j], s1[8 * j + 1]); c_.y = cvtpk(s1[8 * j + 2], s1[8 * j + 3]); c_.z = cvtpk(s1[8 * j + 4], s1[8 * j + 5]); c_.w = cvtpk(s1[8 * j + 6], s1[8 * j + 7]);
                pk[j] = __builtin_bit_cast(bf16x8, a_); pk[2 + j] = __builtin_bit_cast(bf16x8, c_); }
#pragma unroll
            for (int j = 0; j < 4; ++j) {
                const s16x4 a0 = vtr(vb + (16 * j) * VP), a1 = vtr(vb + (16 * j + 4) * VP), b0 = vtr(vb + (16 * j) * VP + 64), b1 = vtr(vb + (16 * j + 4) * VP + 64);
                const bf16x8 va = {a0[0], a0[1], a0[2], a0[3], a1[0], a1[1], a1[2], a1[3]}, vb8 = {b0[0], b0[1], b0[2], b0[3], b1[0], b1[1], b1[2], b1[3]};
                o0 = __builtin_amdgcn_mfma_f32_32x32x16_bf16(va, pk[j], o0, 0, 0, 0); o1 = __builtin_amdgcn_mfma_f32_32x32x16_bf16(vb8, pk[j], o1, 0, 0, 0); }
        }
        const float inv = __builtin_amdgcn_rcpf(xhalf_sum(l_run));
        bf16* op = O + (seq0 + qpos) * 1024 + hq * 64 + 4 * hi;
#pragma unroll
        for (int q4 = 0; q4 < 4; ++q4) { u32x2 w0, w1;
            w0.x = cvtpk(o0[4 * q4] * inv, o0[4 * q4 + 1] * inv); w0.y = cvtpk(o0[4 * q4 + 2] * inv, o0[4 * q4 + 3] * inv);
            w1.x = cvtpk(o1[4 * q4] * inv, o1[4 * q4 + 1] * inv); w1.y = cvtpk(o1[4 * q4 + 2] * inv, o1[4 * q4 + 3] * inv);
            *(u32x2*)(op + 8 * q4) = w0; *(u32x2*)(op + 32 + 8 * q4) = w1; }
    }
    __syncthreads();
}

__device__ __forceinline__ int swap45(int w) { return (w & 15) | (((w >> 4) & 1) << 5) | (((w >> 5) & 1) << 4); }
__device__ __forceinline__ int src_col(int which, int r) {
    switch (which) {
    case 0:
        if (r < 256) return r;
        if (r < 512) { const int p = r - 256; return p < 160 ? 256 + p : -1; }
        if (r < 1536) { const int p = r - 512; return 416 + (p & ~63) + swap45(p & 63); }
        if (r < 1792) { const int p = r - 1536; return p < 128 ? 1440 + (p & ~63) + swap45(p & 63) : 1568 + (p - 128); }
        return 1696 + (r - 1792);
    case 1:
        if (r < 1024) return (r >> 6) * 96 + (r & 63);
        { const int p = r - 1024; return (p >> 5) * 96 + 64 + (p & 31); }
    case 2:
        if (r < 1024) return (r >> 6) * 128 + (r & 63);
        { const int p = r - 1024; return (p >> 6) * 128 + 64 + (p & 63); }
    default: return r;
    }
}
__device__ __forceinline__ void transpose_item(const float* __restrict__ W, int Ks, int N, bf16* WT, int R, int Kd, int which, const float* __restrict__ gs, LAS float* scr, int item, int lane) {
    const int nblk = R / 32, kb = item / nblk, nb = item % nblk, k0 = 64 * kb, n0 = 32 * nb;
    const int sc = src_col(which, n0 + (lane & 31));
    float vals[32];
#pragma unroll
    for (int i = 0; i < 32; ++i) { const int k = k0 + 2 * i + (lane >> 5); float v = 0.f;
        if (sc >= 0 && k < Ks) { v = W[(size_t)k * N + sc]; if (gs) v *= gs[k]; }
        vals[i] = v; }
#pragma unroll
    for (int i = 0; i < 32; ++i) scr[(2 * i + (lane >> 5)) * 33 + (lane & 31)] = vals[i];
    asm volatile("s_waitcnt lgkmcnt(0)" ::: "memory");
    const int c = lane & 7;
#pragma unroll
    for (int j = 0; j < 4; ++j) { const int n = (lane >> 3) + 8 * j; const LAS float* s = scr + (8 * c) * 33 + n;
        u32x4 o; o.x = cvtpk(s[0 * 33], s[1 * 33]); o.y = cvtpk(s[2 * 33], s[3 * 33]); o.z = cvtpk(s[4 * 33], s[5 * 33]); o.w = cvtpk(s[6 * 33], s[7 * 33]);
        *(u32x4*)(WT + (size_t)(n0 + n) * Kd + k0 + 8 * c) = o; }
    asm volatile("s_waitcnt lgkmcnt(0)" ::: "memory");
}


__device__ __forceinline__ float sum16(const float* p) { const f32x4* q = (const f32x4*)p; const f32x4 a = q[0], b = q[1], c = q[2], d = q[3];
    return (((a[0] + a[1]) + (a[2] + a[3])) + ((b[0] + b[1]) + (b[2] + b[3]))) + (((c[0] + c[1]) + (c[2] + c[3])) + ((d[0] + d[1]) + (d[2] + d[3]))); }
template <bool FIRST>
__device__ __forceinline__ void rowpass(const float* xin, float* xo, const bf16* T, const float* part_t, const float* gpost, const float* gpre, bf16* XN, const float* part_e, float* rstd_e, int gw, int NGW, int lane) {
    for (int row0 = gw; row0 < M; row0 += 2 * NGW) {
        f32x4 xv[2][4]; u32x4 tw[2][2]; float rt[2];
#pragma unroll
        for (int r2 = 0; r2 < 2; ++r2) { const size_t row = (size_t)(row0 + r2 * NGW);
#pragma unroll
            for (int j = 0; j < 2; ++j) { const int col = 512 * j + 8 * lane; tw[r2][j] = *(const u32x4*)(T + row * DM + col);
                xv[r2][2 * j] = *(const f32x4*)(xin + row * DM + col); xv[r2][2 * j + 1] = *(const f32x4*)(xin + row * DM + col + 4); }
            rt[r2] = __builtin_amdgcn_rsqf(sum16(part_t + row * 16) * (1.0f / DM) + EPS); }
#pragma unroll
        for (int r2 = 0; r2 < 2; ++r2) { const size_t row = (size_t)(row0 + r2 * NGW); float ss = 0.f;
#pragma unroll
            for (int j = 0; j < 2; ++j) { const int col = 512 * j + 8 * lane;
                const f32x4 ta = unpack4((u32x2){tw[r2][j].x, tw[r2][j].y}), tb = unpack4((u32x2){tw[r2][j].z, tw[r2][j].w});
                const f32x4 ga = *(const f32x4*)(gpost + col), gb = *(const f32x4*)(gpost + col + 4);
                xv[r2][2 * j] += ta * rt[r2] * ga; xv[r2][2 * j + 1] += tb * rt[r2] * gb; ss += dot4(xv[r2][2 * j]) + dot4(xv[r2][2 * j + 1]);
                *(f32x4*)(xo + row * DM + col) = xv[r2][2 * j]; *(f32x4*)(xo + row * DM + col + 4) = xv[r2][2 * j + 1]; }
            if (FIRST) { const float r1 = __builtin_amdgcn_rsqf(wave_sum(ss) * (1.0f / DM) + EPS);
#pragma unroll
                for (int j = 0; j < 2; ++j) { const int col = 512 * j + 8 * lane; const f32x4 ga = *(const f32x4*)(gpre + col), gb = *(const f32x4*)(gpre + col + 4);
                    const u32x2 a = pack4(xv[r2][2 * j] * r1 * ga), b2 = pack4(xv[r2][2 * j + 1] * r1 * gb); *(u32x4*)(XN + row * DM + col) = (u32x4){a.x, a.y, b2.x, b2.y}; }
            } else {
#pragma unroll
                for (int j = 0; j < 2; ++j) { const int col = 512 * j + 8 * lane; const u32x2 a = pack4(xv[r2][2 * j]), b2 = pack4(xv[r2][2 * j + 1]); *(u32x4*)(XN + row * DM + col) = (u32x4){a.x, a.y, b2.x, b2.y}; }
                if (lane == 0) rstd_e[row] = __builtin_amdgcn_rsqf(sum16(part_e + row * 16) * (1.0f / DM) + EPS); }
        }
    }
}

#define XB_TMO      128
#define XB_XCNT(j)  (256  + 64 * (j))
#define XB_XSUB(j)  (1280 + 64 * (j))
#define XB_XGEN(j)  (2304 + 64 * (j))
#define XB_TOP      3328
#define XB_TOPGEN   3392
#define XCD_BAR_WORDS 3456
#define XB_SPIN_CAP (1u << 18)

__device__ __forceinline__ unsigned xb_ld(unsigned* p)              { return __hip_atomic_load(p, __ATOMIC_RELAXED, __HIP_MEMORY_SCOPE_AGENT); }
__device__ __forceinline__ unsigned xb_add(unsigned* p, unsigned v) { return __hip_atomic_fetch_add(p, v, __ATOMIC_RELAXED, __HIP_MEMORY_SCOPE_AGENT); }
__device__ __forceinline__ unsigned xb_xcc_id() { return (unsigned)__builtin_amdgcn_s_getreg((3 << 11) | 20) & 0xFu; }
#define XB_SPIN(cond, bar) do { unsigned _sp = 0; while (cond) { __builtin_amdgcn_s_sleep(1); \
    if ((++_sp & 255u) == 0u) { if (xb_ld(&(bar)[XB_TMO])) break; if (_sp > XB_SPIN_CAP) { atomicAdd(&(bar)[XB_TMO], 1u); break; } } } } while (0)

struct XcdBarrier {
    unsigned* bar; unsigned x;
    volatile LAS unsigned* st;
};

__device__ __forceinline__ XcdBarrier xcd_barrier_post(unsigned* bar, volatile LAS unsigned* st) {
    XcdBarrier b; b.bar = bar; b.x = xb_xcc_id(); b.st = st;
    if (threadIdx.x == 0) (void)xb_add(&bar[XB_XCNT(b.x)], 1u);
    return b;
}
__device__ __forceinline__ void xcd_barrier_complete(unsigned* bar, unsigned x, unsigned& nloc, unsigned& nx) {
    const unsigned G = gridDim.x * gridDim.y * gridDim.z;
    unsigned sum, cnt, mine, sp = 0u;
    for (;;) {
        sum = 0u; cnt = 0u; mine = 0u;
#pragma unroll
        for (unsigned j = 0; j < 16; ++j) { const unsigned c = xb_ld(&bar[XB_XCNT(j)]); sum += c; cnt += (c > 0u) ? 1u : 0u; mine = (j == x) ? c : mine; }
        if (sum == G) break;
        __builtin_amdgcn_s_sleep(1);
        if ((++sp & 255u) == 0u) { if (xb_ld(&bar[XB_TMO])) break; if (sp > XB_SPIN_CAP) { atomicAdd(&bar[XB_TMO], 1u); break; } }
    }
    nloc = mine > 0u ? mine : 1u; nx = cnt > 0u ? cnt : 1u;
}

__device__ __forceinline__ void xcd_barrier(const XcdBarrier& b) {
    asm volatile("s_waitcnt vmcnt(0)" ::: "memory");
    __syncthreads();
    if (threadIdx.x == 0) {
        unsigned* bar = b.bar;
        __builtin_amdgcn_s_waitcnt(0);
        unsigned nloc = b.st[0], nx = b.st[1];
        if (nloc == 0u) { xcd_barrier_complete(bar, b.x, nloc, nx); b.st[0] = nloc; b.st[1] = nx; }
        const unsigned old = xb_add(&bar[XB_XSUB(b.x)], 1u);
        const unsigned gen = old / nloc;
        if (old + 1u == (gen + 1u) * nloc) {
            __builtin_amdgcn_fence(__ATOMIC_RELEASE, "agent");
            asm volatile("s_waitcnt vmcnt(0)" ::: "memory");
            const unsigned og = xb_add(&bar[XB_TOP], 1u);
            const unsigned tg = og / nx;
            if (og + 1u == (tg + 1u) * nx) xb_add(&bar[XB_TOPGEN], 1u);
            else XB_SPIN(xb_ld(&bar[XB_TOPGEN]) == tg, bar);
            __builtin_amdgcn_fence(__ATOMIC_ACQUIRE, "agent");
            xb_add(&bar[XB_XGEN(b.x)], 1u);
            asm volatile("s_waitcnt vmcnt(0)" ::: "memory");
        } else {
            XB_SPIN(xb_ld(&bar[XB_XGEN(b.x)]) == gen, bar);
            __builtin_amdgcn_fence(__ATOMIC_ACQUIRE, "agent");
            asm volatile("s_waitcnt vmcnt(0)" ::: "memory");
        }
    }
    __syncthreads();
}

__global__ void __launch_bounds__(NWAVES * 64, 2) mega_fwd(Params P) {
    extern __shared__ __attribute__((aligned(16))) unsigned char lds_raw[];
    LAS unsigned char* lds = (LAS unsigned char*)lds_raw;
    const int tid = threadIdx.x, lane = tid & 63, wave = __builtin_amdgcn_readfirstlane(tid >> 6);
    const int G = gridDim.x, bx = blockIdx.x, vcu = (G % 8 == 0) ? (bx % 8) * (G / 8) + bx / 8 : bx;
    const int gw = vcu * NWAVES + wave, NGW = G * NWAVES;
    const int lo = P.ph_lo, hi = P.ph_hi;
#ifndef PH_MASK
#define PH_MASK 0x7ff
#endif
#define IN(k) (((PH_MASK >> (k)) & 1) && lo <= (k) && (k) < hi)
#ifdef PROBE_A
    unsigned long long t_a = 0, t_b = 0;
#define STAMP(id) do { if ((id) == PROBE_A) t_a = __builtin_amdgcn_s_memrealtime(); if ((id) == PROBE_B) t_b = __builtin_amdgcn_s_memrealtime(); } while (0)
#else
#define STAMP(id) do { } while (0)
#endif
    volatile LAS unsigned* bst = (volatile LAS unsigned*)(lds + 128 * 1024);
    if (tid < 2) bst[tid] = 0u;
    __syncthreads();
    XcdBarrier xbar = xcd_barrier_post((unsigned*)(P.ws + WS_CTL) + 1024, bst);
#define SEAM(k) do { if (IN(k) && IN((k) + 1)) { if (P.ph_hi > 64) cg::this_grid().sync(); else xcd_barrier(xbar); } STAMP((k) + 1); } while (0)
    STAMP(0);
#define tab ((const f32x2*)(P.ws + WS_TAB))
#define XN ((bf16*)(P.ws + WS_XN))
#define part_q ((float*)(P.ws + WS_PQ))
#define part_kv ((float*)(P.ws + WS_PKV))
#define part_t ((float*)(P.ws + WS_PT))
#define part_e ((float*)(P.ws + WS_PE))
#define rstd_e ((float*)(P.ws + WS_RSTDE))
#define gates ((bf16*)P.out)

    if (IN(0)) {
        LAS float* scr = (LAS float*)(lds + wave * 16384);
        int it = gw;
#define TR(IN_, KS, N_, R_, KD, WHICH, GSP, OFF) { const int nit = ((KD) / 64) * ((R_) / 32); for (; it < nit; it += NGW) transpose_item(P.in[IN_], KS, N_, (bf16*)(P.ws + (OFF)), R_, KD, WHICH, GSP, scr, it, lane); it -= nit; }
        TR(3, 1024, 3744, N_IN_PAD, 1024, 0, nullptr, WS_WIN)
        TR(5, 256, 1536, 1536, 256, 1, P.in[4], WS_WQKV)
        TR(7, 128, 2048, 2048, 256, 2, P.in[6], WS_WQKV + (size_t)1536 * 256 * 2)
        TR(17, 256, 1024, 1024, 256, 3, nullptr, WS_WPP)
        TR(9, 1024, 1024, 1024, 1024, 3, nullptr, WS_WUP)
        TR(10, 1024, 1024, 1024, 1024, 3, nullptr, WS_WUP + (size_t)1024 * 1024 * 2)
        TR(11, 1024, 1024, 1024, 1024, 3, nullptr, WS_WOUT)
        TR(14, 1024, 4096, 4096, 1024, 3, nullptr, WS_W1)
        TR(15, 4096, 1024, 1024, 4096, 3, nullptr, WS_W2)
        TR(19, 1024, 1024, 1024, 1024, 3, nullptr, WS_WPG)
#undef TR
        { const float* x = P.in[0]; const float* g = P.in[2];
          for (int row0 = gw; row0 < M; row0 += 2 * NGW) {
              f32x4 v[2][4], pv[2]; float ss[2] = {0.f, 0.f};
#pragma unroll
              for (int r2 = 0; r2 < 2; ++r2) { const int row = row0 + r2 * NGW; const f32x4* xr = (const f32x4*)(x + (size_t)row * DM);
#pragma unroll
                  for (int j = 0; j < 4; ++j) v[r2][j] = xr[lane + 64 * j];
                  pv[r2] = ((const f32x4*)(P.in[1] + (size_t)row * 256))[lane]; }
#pragma unroll
              for (int r2 = 0; r2 < 2; ++r2) { const int row = row0 + r2 * NGW;
#pragma unroll
                  for (int j = 0; j < 4; ++j) ss[r2] += dot4(v[r2][j]);
                  const float rs = __builtin_amdgcn_rsqf(wave_sum(ss[r2]) * (1.0f / DM) + EPS);
#pragma unroll
                  for (int j = 0; j < 4; ++j) { const f32x4 gg = ((const f32x4*)g)[lane + 64 * j]; *(u32x2*)(XN + (size_t)row * DM + 4 * (lane + 64 * j)) = pack4(v[r2][j] * rs * gg); }
                  *(u32x2*)((bf16*)(P.ws + WS_PB) + (size_t)row * 256 + 4 * lane) = pack4(pv[r2]); }
          } }
        for (int i = (vcu * NWAVES + wave) * 64 + lane; i < SEQ * 32; i += NGW * 64) {
            const int pos = i >> 5, j = i & 31; const float inv = expf(-9.210340371976184f * (float)j * (2.0f / 64.0f)); const float ang = (float)pos * inv;
            ((f32x2*)(P.ws + WS_TAB))[i] = (f32x2){cosf(ang), sinf(ang)}; }
    }
    SEAM(0);
    if (IN(1)) {
        pg8::Gemm g{XN, (const bf16*)(P.ws + WS_WIN), M, N_IN_PAD, 1024}; Sched S = make_sched(G, bx, 15);
        EpiP1 E{(bf16*)(P.ws + WS_QA), (bf16*)(P.ws + WS_KVR), (bf16*)(P.ws + WS_KROPE), (bf16*)(P.ws + WS_QS), (bf16*)(P.ws + WS_KS), (bf16*)(P.ws + WS_VS), gates, part_q, part_kv, tab};
        pg8::gemm_phase<EpiP1, Sched, true, true>(lds, g, S, E);
    }
    SEAM(1);
    if (IN(2)) {
        pg8::Gemm g{(const bf16*)(P.ws + WS_QA), (const bf16*)(P.ws + WS_WQKV), 2 * M, 3584, 256};
        Sched S = make_sched(G, bx, 6); S.nseg = 2; S.nN[1] = 8; S.pmo[1] = 128; S.pno[1] = 6; S.start[1] = 768; S.start[2] = 768 + 1024;
        EpiP2 E{(bf16*)(P.ws + WS_QN), (bf16*)(P.ws + WS_QR), (bf16*)(P.ws + WS_KN), (bf16*)(P.ws + WS_VM), part_q, part_kv, tab};
        pg8::gemm_phase<EpiP2, Sched, true, true>(lds, g, S, E);
    }
    SEAM(2);
    if (IN(3)) {
        for (int U = vcu; U < 2048; U += G) {
            const int c8 = U & 255, i = U >> 8, bh = c8 >> 1, s = c8 & 1, k = i >> 1, qb = (i & 1) ? 15 - 2 * k - s : 2 * k + s;
            att::unit<0>(lds, (const bf16*)(P.ws + WS_QN), (const bf16*)(P.ws + WS_QR), (const bf16*)(P.ws + WS_KN), (const bf16*)(P.ws + WS_KROPE), (const bf16*)(P.ws + WS_VM), (bf16*)(P.ws + WS_QN), nullptr, bh >> 4, bh & 15, qb, 0);
        }
        STAMP(12);
        for (int U = vcu; U < 512; U += G) swa_unit(lds, (const bf16*)(P.ws + WS_QS), (const bf16*)(P.ws + WS_KS), (const bf16*)(P.ws + WS_VS), (bf16*)(P.ws + WS_QS), P.in[8], U >> 6, (U >> 5) & 1, U & 31);
    }
    SEAM(3);
    if (IN(4)) {
        pg8::Gemm g{(const bf16*)(P.ws + WS_QN), (const bf16*)(P.ws + WS_WUP), 2 * M, 2048, 1024}; Sched S = make_sched(G, bx, 4); S.pairs = 1;
        EpiP4 E{gates, XN, (bf16*)(P.ws + WS_QA)};
        pg8::gemm_phase<EpiP4, Sched, true, true>(lds, g, S, E);
    }
    SEAM(4);
    if (IN(5)) {
        pg8::Gemm g{XN, (const bf16*)(P.ws + WS_WOUT), M, 1024, 1024}; Sched S = make_sched(G, bx, 4);
        EpiT E{(bf16*)(P.ws + WS_T), part_t};
        pg8::gemm_phase<EpiT, Sched, true, true>(lds, g, S, E);
    }
    SEAM(5);
    if (IN(6)) rowpass<true>(P.in[0], P.out, (const bf16*)(P.ws + WS_T), part_t, P.in[12], P.in[13], XN, nullptr, nullptr, gw, NGW, lane);
    SEAM(6);
    if (IN(7)) {
        pg8::Gemm g{XN, (const bf16*)(P.ws + WS_W1), M, FF, 1024}; Sched S = make_sched(G, bx, 16);
        EpiRelu2 E{(bf16*)(P.ws + WS_U)};
        pg8::gemm_phase<EpiRelu2, Sched, true, true>(lds, g, S, E);
    }
    SEAM(7);
    if (IN(8)) {
        { pg8::Gemm g{(const bf16*)(P.ws + WS_U), (const bf16*)(P.ws + WS_W2), M, 1024, FF}; Sched S = make_sched(G, bx, 4);
          EpiT E{(bf16*)(P.ws + WS_T), part_t};
          pg8::gemm_phase<EpiT, Sched, true, true>(lds, g, S, E); }
        { pg8::Gemm g{(const bf16*)(P.ws + WS_PB), (const bf16*)(P.ws + WS_WPP), M, 1024, 256}; Sched S = make_sched(G, bx, 4);
          EpiT E{(bf16*)(P.ws + WS_ERAW), part_e};
          pg8::gemm_phase<EpiT, Sched, true, true>(lds, g, S, E); }
    }
    SEAM(8);
    if (IN(9)) rowpass<false>(P.out, P.out, (const bf16*)(P.ws + WS_T), part_t, P.in[16], nullptr, XN, part_e, rstd_e, gw, NGW, lane);
    SEAM(9);
    if (IN(10)) {
        pg8::Gemm g{XN, (const bf16*)(P.ws + WS_WPG), M, 1024, 1024}; Sched S = make_sched(G, bx, 4);
        EpiOut E{P.out, (const bf16*)(P.ws + WS_ERAW), rstd_e, P.in[18]};
        pg8::gemm_phase<EpiOut, Sched, true, true>(lds, g, S, E);
    }
    STAMP(11);
#ifdef PROBE_A
    cg::this_grid().sync();
    STAMP(13); cg::this_grid().sync(); cg::this_grid().sync(); cg::this_grid().sync(); cg::this_grid().sync(); STAMP(14);
    if (bx == 0 && tid == 0) P.out[0] += (float)(((t_b - t_a) / PROBE_Q) * (PROBE_Q / 100ull));
#endif
#undef IN
#undef SEAM
#undef tab
#undef XN
#undef part_q
#undef part_kv
#undef part_t
#undef part_e
#undef rstd_e
#undef gates
}

extern "C" void kernel_launch(void* const* d_in, const int* in_sizes, int n_in, void* d_out, int out_size, void* d_ws, size_t ws_size, hipStream_t stream) {
    static int grid = 0;
    if (grid == 0) {
        int dev = 0, cus = 0, per_cu = 0;
        hipGetDevice(&dev); hipDeviceGetAttribute(&cus, hipDeviceAttributeMultiprocessorCount, dev);
        if (hipFuncSetAttribute((const void*)mega_fwd, hipFuncAttributeMaxDynamicSharedMemorySize, LDS_BYTES) != hipSuccess) { fprintf(stderr, "hipFuncSetAttribute failed\n"); }
        if (hipOccupancyMaxActiveBlocksPerMultiprocessor(&per_cu, (const void*)mega_fwd, NWAVES * 64, LDS_BYTES) != hipSuccess || per_cu < 1) { fprintf(stderr, "occupancy query: %d\n", per_cu); per_cu = 1; }
        (void)hipGetLastError();
        grid = cus * per_cu;
        if (n_in != 20 || ws_size < WS_END) fprintf(stderr, "kernel_launch: unexpected n_in %d / ws %zu\n", n_in, ws_size);
    }
    Params p{};
    for (int i = 0; i < 20; ++i) p.in[i] = (const float*)d_in[i];
    p.out = (float*)d_out; p.ws = (unsigned char*)d_ws;
#if MK_N_LAUNCHES == 1
    (void)hipMemsetAsync((unsigned char*)d_ws + WS_CTL, 0, CTL_BYTES, stream);
    p.ph_lo = 0; p.ph_hi = 11;
    void* args[] = {&p};
    hipError_t e = hipLaunchCooperativeKernel((const void*)mega_fwd, dim3(grid), dim3(NWAVES * 64), args, LDS_BYTES, stream);
    if (e != hipSuccess) fprintf(stderr, "cooperative launch failed: %s (grid %d)\n", hipGetErrorString(e), grid);
#else
    for (int k = 0; k < 11; ++k) { p.ph_lo = k; p.ph_hi = k + 1; hipLaunchKernelGGL(mega_fwd, dim3(grid), dim3(NWAVES * 64), LDS_BYTES, stream, p); }
#endif
}
```

```cpp
#include <hip/hip_runtime.h>
#include <hip/hip_cooperative_groups.h>
#include <cstdio>
#include <cstdint>
namespace cg = cooperative_groups;
#ifndef MK_N_LAUNCHES
#define MK_N_LAUNCHES 1
#endif
namespace pg8 {
#define PG8_LAS __attribute__((address_space(3)))
typedef unsigned short bf16_t;
typedef short bf16x8 __attribute__((ext_vector_type(8)));
typedef float f32x4 __attribute__((ext_vector_type(4)));
typedef unsigned u32x4 __attribute__((ext_vector_type(4)));
constexpr int BM = 256, BK = 64, HALF = 128, HTB = HALF * BK * 2  , STAGE_BYTES = 8 * HTB, NXCD = 8, WGM = 8;

__host__ __device__ __forceinline__ int lds_byte(int r, int c) { const int st = (r >> 4) * 2 + (c >> 5), rr = r & 15, cc = c & 31, ob = rr * 64 + cc * 2; return st * 1024 + (ob ^ (((ob >> 9) & 1) << 5)); }
__host__ __device__ __forceinline__ void stage_rc(int b, int& R, int& C) { const int st = b / 1024, sb = b % 1024, swz = sb ^ (((sb >> 9) & 1) << 5); R = (st >> 1) * 16 + swz / 64; C = (st & 1) * 32 + (swz % 64) / 2; }
__host__ __device__ __forceinline__ int perm32(int rho) { const int n = rho >> 4, i = rho & 15; return 8 * (i >> 2) + 4 * n + (i & 3); }

struct Unit { int pm, pn, kind; };
struct Gemm { const bf16_t* A; const bf16_t* Bt; int M, N, K; };

template <class Epi, class Sched, bool ALIGN_EPI = false, bool SP2 = false>
__device__ __forceinline__ void gemm_phase(PG8_LAS unsigned char* lds, const Gemm g, const Sched& S, const Epi& E) {
    const int tid = threadIdx.x, wid = __builtin_amdgcn_readfirstlane(tid >> 6), lane = tid & 63, wr = wid >> 2, wc = wid & 3, fr = lane & 15, fq = lane >> 4;
    int K_ = g.K; asm volatile("" : "+s"(K_));
    const int K = K_, nt = K / BK;
    unsigned voffA[2], voffB[2];
#pragma unroll
    for (int i = 0; i < 2; ++i) { int R, C; stage_rc(tid * 16 + i * 8192, R, C); const int Rb = Epi::PERM ? ((R & ~31) + perm32(R & 31)) : R;
        voffA[i] = (unsigned)(R * K + C) * 2u; voffB[i] = (unsigned)(Rb * K + C) * 2u; }
    const size_t kstep = (size_t)(BK * 2);
    const size_t hstep = (size_t)HALF * K * 2;
    const size_t tstep = 2 * hstep;
    const unsigned ldsw = (unsigned)wid * 1024u;
    const int aoff = lds_byte(wr * 64 + fr, fq * 8), boff = lds_byte(wc * 32 + fr, fq * 8);
#define PG8_SA(b, h) (((b) * 2 + (h)) * HTB)
#define PG8_SB(b, h) ((4 + (b) * 2 + (h)) * HTB)
#define PG8_STAGE(bufoff, gbase, voff) do { _Pragma("unroll") for (int _i = 0; _i < 2; ++_i) \
        __builtin_amdgcn_global_load_lds((const unsigned*)((const char*)(gbase) + (voff)[_i]), (PG8_LAS unsigned*)(lds + (bufoff) + ldsw + _i * 8192), 16, 0, 0); } while (0)
#define PG8_LDA(dst, b, h) do { _Pragma("unroll") for (int m = 0; m < 4; ++m) _Pragma("unroll") for (int k = 0; k < 2; ++k) dst[m][k] = *(const PG8_LAS bf16x8*)(lds + PG8_SA(b, h) + aoff + m * 2048 + k * 1024); } while (0)
#define PG8_LDB(dst, b, h) do { _Pragma("unroll") for (int n = 0; n < 2; ++n) _Pragma("unroll") for (int k = 0; k < 2; ++k) dst[n][k] = *(const PG8_LAS bf16x8*)(lds + PG8_SB(b, h) + boff + n * 2048 + k * 1024); } while (0)
#define PG8_MMA(ai, bj, At, Bt) do { __builtin_amdgcn_s_setprio(1); _Pragma("unroll") for (int m = 0; m < 4; ++m) _Pragma("unroll") for (int n = 0; n < 2; ++n) _Pragma("unroll") for (int k = 0; k < 2; ++k) \
        acc[ai][bj][m][n] = __builtin_amdgcn_mfma_f32_16x16x32_bf16(Bt[n][k], At[m][k], acc[ai][bj][m][n], 0, 0, 0); __builtin_amdgcn_s_setprio(0); } while (0)
#define PG8_WAIT_V(n) asm volatile("s_waitcnt vmcnt(" #n ")" ::: "memory")
#define PG8_WAIT_L(n) asm volatile("s_waitcnt lgkmcnt(" #n ")" ::: "memory")
#define PG8_BAR __builtin_amdgcn_s_barrier()
#define PG8_SCHED __builtin_amdgcn_sched_barrier(0)
    Unit cur, nxt; int ui = 0;
    if (!S.next(0, cur)) return;
    f32x4 acc[2][2][4][2];
#pragma unroll
    for (int a = 0; a < 2; ++a)
#pragma unroll
        for (int b = 0; b < 2; ++b)
#pragma unroll
            for (int m = 0; m < 4; ++m)
#pragma unroll
                for (int n = 0; n < 2; ++n) acc[a][b][m][n] = (f32x4){0.f, 0.f, 0.f, 0.f};
    bf16x8 At[4][2], B0[2][2], B1[2][2];
    const char* cA = (const char*)g.A + (size_t)cur.pm * tstep; const char* cB = (const char*)g.Bt + (size_t)cur.pn * tstep;
    S.a_ready(cur);
    if constexpr (SP2) {
        PG8_STAGE(PG8_SB(0, 0), cB, voffB); PG8_STAGE(PG8_SB(0, 1), cB + hstep, voffB); PG8_STAGE(PG8_SA(0, 0), cA, voffA); PG8_STAGE(PG8_SA(0, 1), cA + hstep, voffA);
        if (wr == 1) PG8_BAR;
        PG8_WAIT_V(2); PG8_BAR;
        PG8_STAGE(PG8_SB(1, 0), cB + kstep, voffB); PG8_STAGE(PG8_SA(1, 0), cA + kstep, voffA); PG8_STAGE(PG8_SB(1, 1), cB + hstep + kstep, voffB);
        PG8_WAIT_V(6); PG8_BAR;
    } else {
        PG8_STAGE(PG8_SB(0, 0), cB, voffB); PG8_STAGE(PG8_SA(0, 0), cA, voffA); PG8_STAGE(PG8_SB(0, 1), cB + hstep, voffB); PG8_STAGE(PG8_SA(0, 1), cA + hstep, voffA);
        if (wr == 1) PG8_BAR;
        PG8_WAIT_V(4); PG8_BAR;
        PG8_STAGE(PG8_SB(1, 0), cB + kstep, voffB); PG8_STAGE(PG8_SA(1, 0), cA + kstep, voffA); PG8_STAGE(PG8_SB(1, 1), cB + hstep + kstep, voffB);
        PG8_WAIT_V(6); PG8_BAR;
    }
    for (;;) {
        const bool has_next = S.next(ui + 1, nxt);
        const char* nA = has_next ? (const char*)g.A + (size_t)nxt.pm * tstep : cA; const char* nB = has_next ? (const char*)g.Bt + (size_t)nxt.pn * tstep : cB;
        for (int t = 0; t < nt; t += 2) {
            const bool last = (t == nt - 2);
            const char* a1 = cA + (size_t)(t + 1) * kstep;
            const char* a2 = last ? nA : cA + (size_t)(t + 2) * kstep; const char* b2 = last ? nB : cB + (size_t)(t + 2) * kstep;
            const char* a3 = a2 + kstep; const char* b3 = b2 + kstep;
            if (last && has_next) S.a_ready(nxt);
            if constexpr (SP2) {
            PG8_LDB(B0, 0, 0); PG8_LDB(B1, 0, 1); PG8_SCHED; PG8_LDA(At, 0, 0); PG8_STAGE(PG8_SA(1, 1), a1 + hstep, voffA);
            PG8_WAIT_V(8); PG8_WAIT_L(0); PG8_BAR; PG8_MMA(0, 0, At, B0); PG8_MMA(0, 1, At, B1); PG8_BAR; PG8_SCHED;
            PG8_LDA(At, 0, 1); PG8_STAGE(PG8_SB(0, 0), b2, voffB); PG8_STAGE(PG8_SB(0, 1), b2 + hstep, voffB); PG8_STAGE(PG8_SA(0, 0), a2, voffA);
            PG8_WAIT_V(8); PG8_WAIT_L(0); PG8_BAR; PG8_MMA(1, 0, At, B0); PG8_MMA(1, 1, At, B1); PG8_BAR; PG8_SCHED;
            PG8_LDB(B0, 1, 0); PG8_LDB(B1, 1, 1); PG8_SCHED; PG8_LDA(At, 1, 0); PG8_STAGE(PG8_SA(0, 1), a2 + hstep, voffA);
            PG8_WAIT_V(8); PG8_WAIT_L(0); PG8_BAR; PG8_MMA(0, 0, At, B0); PG8_MMA(0, 1, At, B1); PG8_BAR; PG8_SCHED;
            PG8_LDA(At, 1, 1); PG8_STAGE(PG8_SB(1, 0), b3, voffB); PG8_STAGE(PG8_SB(1, 1), b3 + hstep, voffB); PG8_STAGE(PG8_SA(1, 0), a3, voffA);
            PG8_WAIT_V(8); PG8_WAIT_L(0); PG8_BAR; PG8_MMA(1, 0, At, B0); PG8_MMA(1, 1, At, B1); PG8_BAR; PG8_SCHED;
            } else {
            PG8_LDB(B0, 0, 0); PG8_SCHED; PG8_LDA(At, 0, 0); PG8_STAGE(PG8_SA(1, 1), a1 + hstep, voffA);
            PG8_WAIT_L(8); PG8_BAR; PG8_WAIT_L(0); PG8_MMA(0, 0, At, B0); PG8_BAR; PG8_SCHED;
            PG8_LDB(B1, 0, 1); PG8_STAGE(PG8_SB(0, 0), b2, voffB);
            PG8_BAR; PG8_WAIT_L(0); PG8_MMA(0, 1, At, B1); PG8_BAR;
            PG8_LDA(At, 0, 1); PG8_STAGE(PG8_SA(0, 0), a2, voffA);
            PG8_BAR; PG8_WAIT_L(0); PG8_MMA(1, 0, At, B0); PG8_BAR; PG8_SCHED;
            PG8_STAGE(PG8_SB(0, 1), b2 + hstep, voffB);
            PG8_WAIT_V(6); PG8_BAR; PG8_MMA(1, 1, At, B1); PG8_BAR;
            PG8_LDB(B0, 1, 0); PG8_SCHED; PG8_LDA(At, 1, 0); PG8_STAGE(PG8_SA(0, 1), a2 + hstep, voffA);
            PG8_WAIT_L(8); PG8_BAR; PG8_WAIT_L(0); PG8_MMA(0, 0, At, B0); PG8_BAR; PG8_SCHED;
            PG8_LDB(B1, 1, 1); PG8_STAGE(PG8_SB(1, 0), b3, voffB);
            PG8_BAR; PG8_WAIT_L(0); PG8_MMA(0, 1, At, B1); PG8_BAR;
            PG8_LDA(At, 1, 1); PG8_STAGE(PG8_SA(1, 0), a3, voffA);
            PG8_BAR; PG8_WAIT_L(0); PG8_MMA(1, 0, At, B0); PG8_BAR; PG8_SCHED;
            PG8_STAGE(PG8_SB(1, 1), b3 + hstep, voffB);
            PG8_WAIT_V(6); PG8_BAR; PG8_MMA(1, 1, At, B1); PG8_BAR;
            }
        }
        if constexpr (ALIGN_EPI) { if (wr == 0) PG8_BAR; }
        if constexpr (!Epi::AFTER_DRAIN) { if (cur.kind & 0x100) E.mid(acc, cur, wr, wc, fr, fq); else E(acc, cur, wr, wc, fr, fq); S.done(cur); }
        if (!has_next) break;
        {
#pragma unroll
        for (int a = 0; a < 2; ++a)
#pragma unroll
            for (int b = 0; b < 2; ++b)
#pragma unroll
                for (int m = 0; m < 4; ++m)
#pragma unroll
                    for (int n = 0; n < 2; ++n) acc[a][b][m][n] = (f32x4){0.f, 0.f, 0.f, 0.f};
        }
        cur = nxt; cA = nA; cB = nB; ++ui;
        if constexpr (ALIGN_EPI) { if (wr == 1) PG8_BAR; }
    }
    PG8_WAIT_V(0);
    if constexpr (!ALIGN_EPI) { if (wr == 0) PG8_BAR; }
    PG8_BAR;
    if constexpr (Epi::AFTER_DRAIN) { E.fused(acc, cur, wr, wc, fr, fq, lds, wid, lane); S.done(cur); }
#undef PG8_SA
#undef PG8_SB
#undef PG8_STAGE
#undef PG8_LDA
#undef PG8_LDB
#undef PG8_MMA
#undef PG8_WAIT_V
#undef PG8_WAIT_L
#undef PG8_BAR
#undef PG8_SCHED
}
}

#define LAS __attribute__((address_space(3)))
typedef unsigned short bf16;
typedef float f32x4 __attribute__((ext_vector_type(4)));
typedef float f32x2 __attribute__((ext_vector_type(2)));
typedef float f32x16 __attribute__((ext_vector_type(16)));
typedef short bf16x8 __attribute__((ext_vector_type(8)));
typedef short s16x4 __attribute__((ext_vector_type(4)));
typedef unsigned u32x4 __attribute__((ext_vector_type(4)));
typedef unsigned u32x2 __attribute__((ext_vector_type(2)));
typedef __bf16 bf16x2_t __attribute__((ext_vector_type(2)));

constexpr int DM = 1024, SEQ = 4096, NB = 8, M = NB * SEQ, FF = 4096;
constexpr int NWAVES = 8;
constexpr float EPS = 1e-6f, LOG2E = 1.4426950408889634f;
constexpr float C2_MLA = 0.10206207261596575f * LOG2E;
constexpr float C2_SWA = 0.125f * LOG2E;
constexpr int N_IN_PAD = 3840;

constexpr size_t MiB = 1u << 20;
constexpr size_t WS_CTL = 0, CTL_BYTES = 65536;
constexpr size_t WS_TAB = 1 * MiB, WS_PQ = 2 * MiB, WS_PKV = 2 * MiB + 512 * 1024, WS_PT = 3 * MiB, WS_PE = 5 * MiB, WS_RSTDE = 7 * MiB;
constexpr size_t WS_WIN = 8 * MiB, WS_WQKV = 16 * MiB, WS_WPP = 18 * MiB, WS_WUP = 19 * MiB, WS_WOUT = 23 * MiB, WS_W1 = 25 * MiB, WS_W2 = 33 * MiB, WS_WPG = 41 * MiB;
constexpr size_t WS_XN = 48 * MiB, WS_QA = 112 * MiB, WS_KVR = 128 * MiB, WS_KS = 144 * MiB, WS_VS = 152 * MiB, WS_KROPE = 160 * MiB, WS_ERAW = 112 * MiB;
constexpr size_t WS_T = 176 * MiB, WS_QR = 176 * MiB, WS_PB = 240 * MiB;
constexpr size_t WS_QN = 256 * MiB, WS_QS = 320 * MiB, WS_KN = 384 * MiB, WS_VM = 448 * MiB, WS_U = 256 * MiB, WS_END = 512 * MiB;

constexpr int LDS_BYTES = 132 * 1024;

struct Params { const float* in[20]; float* out; unsigned char* ws; int ph_lo, ph_hi; };

__device__ __forceinline__ unsigned cvtpk(float lo, float hi) { f32x2 v = {lo, hi}; bf16x2_t b = __builtin_convertvector(v, bf16x2_t); return __builtin_bit_cast(unsigned, b); }
__device__ __forceinline__ u32x2 pack4(f32x4 v) { u32x2 r; r.x = cvtpk(v[0], v[1]); r.y = cvtpk(v[2], v[3]); return r; }
__device__ __forceinline__ float bf2f(unsigned short h) { return __builtin_bit_cast(float, (unsigned)h << 16); }
__device__ __forceinline__ f32x4 unpack4(u32x2 w) { f32x4 r; r[0] = __builtin_bit_cast(float, w.x << 16); r[1] = __builtin_bit_cast(float, w.x & 0xffff0000u); r[2] = __builtin_bit_cast(float, w.y << 16); r[3] = __builtin_bit_cast(float, w.y & 0xffff0000u); return r; }
__device__ __forceinline__ float sigmoidf_(float x) { return __builtin_amdgcn_rcpf(1.0f + __builtin_amdgcn_exp2f(-x * LOG2E)); }
__device__ __forceinline__ f32x4 sigmoid4(f32x4 v) { f32x4 r; r[0] = sigmoidf_(v[0]); r[1] = sigmoidf_(v[1]); r[2] = sigmoidf_(v[2]); r[3] = sigmoidf_(v[3]); return r; }
__device__ __forceinline__ float wave_sum(float v) {
#pragma unroll
    for (int o = 1; o < 64; o <<= 1) v += __shfl_xor(v, o);
    return v;
}
__device__ __forceinline__ float dot4(f32x4 v) { return (v[0] * v[0] + v[1] * v[1]) + (v[2] * v[2] + v[3] * v[3]); }

struct Sched {
    int G, c, nseg, pairs;
    int nN[2], pmo[2], pno[2], start[3];
    __device__ __forceinline__ bool next(int i, pg8::Unit& u) const {
        const int ii = pairs ? (i >> 1) : i;
        const long L = (long)ii * G + c; if (L >= start[nseg]) return false;
        const int s = (nseg > 1 && L >= start[1]) ? 1 : 0; const int l = (int)L - start[s];
        const int nwg = start[s + 1] - start[s], q = nwg >> 3, id = (l & 7) * q + (l >> 3);
        const int nig = 8 * nN[s], gid = id / nig, r = id % nig;
        const int pm = gid * 8 + (r & 7), pn = r >> 3;
        u.pm = pmo[s] + pm; u.pn = pno[s] + pn; u.kind = u.pn;
        if (pairs) { if (i & 1) { u.pm += 128; u.pn += 4; u.kind = 0; } else u.kind = 0x100; }
        return true;
    }
    __device__ __forceinline__ void a_ready(const pg8::Unit&) const {}
    __device__ __forceinline__ void done(const pg8::Unit&) const {}
};
__device__ __forceinline__ Sched make_sched(int G, int c, int nN0) { Sched s; s.G = G; s.c = c; s.nseg = 1; s.pairs = 0; s.nN[0] = nN0; s.nN[1] = 1; s.pmo[0] = s.pmo[1] = 0; s.pno[0] = s.pno[1] = 0; s.start[0] = 0; s.start[1] = 128 * nN0; s.start[2] = s.start[1]; return s; }

typedef pg8::f32x4 A4;
#define EPI_ROWS(ai, m) for (int ai = 0; ai < 2; ++ai) _Pragma("unroll") for (int m = 0; m < 4; ++m)

struct EpiP1 {
    static constexpr bool PERM = false, AFTER_DRAIN = false;
    bf16 *qa, *kvr, *krope, *qs, *ks, *vs, *gates; float *part_q, *part_kv; const f32x2* tab;
    __device__ __forceinline__ void mid(const A4 (&acc)[2][2][4][2], const pg8::Unit& u, int wr, int wc, int fr, int fq) const {}
    __device__ __forceinline__ void operator()(const A4 (&acc)[2][2][4][2], const pg8::Unit& u, int wr, int wc, int fr, int fq) const {
        const int pn = u.kind, row0 = u.pm * 256 + wr * 64 + fr, cl0 = wc * 32 + fq * 4;
        if (pn <= 1) {
            bf16* dst = pn == 0 ? qa : kvr; float* part = pn == 0 ? part_q : part_kv;
#pragma unroll
            EPI_ROWS(ai, m) { const int row = row0 + ai * 128 + m * 16; float ss = 0.f;
#pragma unroll
                for (int bj = 0; bj < 2; ++bj)
#pragma unroll
                    for (int n = 0; n < 2; ++n) { const A4 v = acc[ai][bj][m][n]; if (pn == 0 || bj == 0) ss += dot4(v);
                        *(u32x2*)(dst + (size_t)row * 256 + bj * 128 + cl0 + n * 16) = pack4(v); }
                ss += __shfl_xor(ss, 16); ss += __shfl_xor(ss, 32);
                if (fq == 0) part[(size_t)row * 4 + wc] = ss;
                if (pn == 1 && wc == 0) {
                    const int pos = row & (SEQ - 1); const A4 x1 = acc[ai][1][m][0], x2 = acc[ai][1][m][1]; A4 o1, o2;
#pragma unroll
                    for (int e = 0; e < 4; ++e) { const f32x2 cs = tab[pos * 32 + 2 * (4 * fq + e)]; o1[e] = x1[e] * cs.x - x2[e] * cs.y; o2[e] = x2[e] * cs.x + x1[e] * cs.y; }
                    *(u32x2*)(krope + (size_t)row * 32 + 4 * fq) = pack4(o1); *(u32x2*)(krope + (size_t)row * 32 + 16 + 4 * fq) = pack4(o2);
                }
            }
        } else if (pn <= 6) {
            const int d1 = 16 * (wc & 1) + 4 * fq;
            f32x4 tb[2][2];
            { const int pos = row0 & (SEQ - 1); tb[0][0] = *(const f32x4*)(tab + pos * 32 + d1); tb[0][1] = *(const f32x4*)(tab + pos * 32 + d1 + 2); }
#pragma unroll
            for (int it = 0; it < 8; ++it) { const int ai = it >> 2, m = it & 3; const int row = row0 + ai * 128 + m * 16;
                if (it + 1 < 8) { const int pos = (row0 + ((it + 1) >> 2) * 128 + ((it + 1) & 3) * 16) & (SEQ - 1); tb[(it + 1) & 1][0] = *(const f32x4*)(tab + pos * 32 + d1); tb[(it + 1) & 1][1] = *(const f32x4*)(tab + pos * 32 + d1 + 2); }
                asm volatile("" ::: "memory");
                const f32x4 t0 = tb[it & 1][0], t1 = tb[it & 1][1];
                const float cc[4] = {t0[0], t0[2], t1[0], t1[2]}, sn[4] = {t0[1], t0[3], t1[1], t1[3]};
#pragma unroll
                for (int bj = 0; bj < 2; ++bj) {
                    if (pn == 6 && bj == 1) {
#pragma unroll
                        for (int n = 0; n < 2; ++n) *(u32x2*)(vs + (size_t)row * 128 + cl0 + n * 16) = pack4(acc[ai][1][m][n]);
                    } else {
                        const A4 x1 = acc[ai][bj][m][0], x2 = acc[ai][bj][m][1]; A4 o1, o2; const float sc = pn == 6 ? 1.0f : C2_SWA;
#pragma unroll
                        for (int e = 0; e < 4; ++e) { o1[e] = (x1[e] * cc[e] - x2[e] * sn[e]) * sc; o2[e] = (x2[e] * cc[e] + x1[e] * sn[e]) * sc; }
                        bf16* d = pn == 6 ? ks + (size_t)row * 128 + (wc >> 1) * 64 : qs + (size_t)row * 1024 + ((pn - 2) * 4 + bj * 2 + (wc >> 1)) * 64;
                        *(u32x2*)(d + d1) = pack4(o1); *(u32x2*)(d + 32 + d1) = pack4(o2);
                    }
                }
            }
        } else {
#pragma unroll
            EPI_ROWS(ai, m) { const int row = row0 + ai * 128 + m * 16;
#pragma unroll
                for (int bj = 0; bj < 2; ++bj)
#pragma unroll
                    for (int n = 0; n < 2; ++n) *(u32x2*)(gates + (size_t)row * 2048 + (pn - 7) * 256 + bj * 128 + cl0 + n * 16) = pack4(sigmoid4(acc[ai][bj][m][n]));
            }
        }
    }
};

struct EpiP2 {
    static constexpr bool PERM = false, AFTER_DRAIN = false;
    bf16 *qn, *qr, *kn, *vm; const float *part_q, *part_kv; const f32x2* tab;
    __device__ __forceinline__ void mid(const A4 (&acc)[2][2][4][2], const pg8::Unit& u, int wr, int wc, int fr, int fq) const {}
    __device__ __forceinline__ void operator()(const A4 (&acc)[2][2][4][2], const pg8::Unit& u, int wr, int wc, int fr, int fq) const {
        const int pn = u.kind, row0 = (u.pm & 127) * 256 + wr * 64 + fr, cl0 = wc * 32 + fq * 4;
        const bool isq = pn < 6, isrope = pn == 4 || pn == 5; const float* part = isq ? part_q : part_kv; const float invn = isq ? (1.0f / 256.0f) : (1.0f / 128.0f);
        f32x4 pp[2]; f32x4 tb[2][2];
        pp[0] = *(const f32x4*)(part + (size_t)row0 * 4);
        if (isrope) { const int pos = row0 & (SEQ - 1); tb[0][0] = *(const f32x4*)(tab + pos * 32 + 8 * fq); tb[0][1] = *(const f32x4*)(tab + pos * 32 + 8 * fq + 4); }
        f32x4 tc[2][2];
        if (isrope) { const int pos = row0 & (SEQ - 1); tc[0][0] = *(const f32x4*)(tab + pos * 32 + 8 * fq + 2); tc[0][1] = *(const f32x4*)(tab + pos * 32 + 8 * fq + 6); }
#pragma unroll
        for (int it = 0; it < 8; ++it) { const int ai = it >> 2, m = it & 3; const int row = row0 + ai * 128 + m * 16;
            if (it + 1 < 8) { const int rn = row0 + ((it + 1) >> 2) * 128 + ((it + 1) & 3) * 16; pp[(it + 1) & 1] = *(const f32x4*)(part + (size_t)rn * 4);
                if (isrope) { const int pos = rn & (SEQ - 1); tb[(it + 1) & 1][0] = *(const f32x4*)(tab + pos * 32 + 8 * fq); tb[(it + 1) & 1][1] = *(const f32x4*)(tab + pos * 32 + 8 * fq + 4);
                    tc[(it + 1) & 1][0] = *(const f32x4*)(tab + pos * 32 + 8 * fq + 2); tc[(it + 1) & 1][1] = *(const f32x4*)(tab + pos * 32 + 8 * fq + 6); } }
            asm volatile("" ::: "memory");
            const f32x4 p4 = pp[it & 1];
            float rs = __builtin_amdgcn_rsqf(((p4[0] + p4[1]) + (p4[2] + p4[3])) * invn + EPS);
            if (isq) rs *= C2_MLA;
            if (isrope) {
                const float cc[4] = {tb[it & 1][0][0], tc[it & 1][0][0], tb[it & 1][1][0], tc[it & 1][1][0]}, sn[4] = {tb[it & 1][0][1], tc[it & 1][0][1], tb[it & 1][1][1], tc[it & 1][1][1]};
#pragma unroll
                for (int bj = 0; bj < 2; ++bj) { const A4 x1 = acc[ai][bj][m][0], x2 = acc[ai][bj][m][1]; A4 o1, o2;
#pragma unroll
                    for (int e = 0; e < 4; ++e) { o1[e] = (x1[e] * cc[e] - x2[e] * sn[e]) * rs; o2[e] = (x2[e] * cc[e] + x1[e] * sn[e]) * rs; }
                    bf16* d = qr + (size_t)row * 512 + ((pn - 4) * 8 + bj * 4 + wc) * 32;
                    *(u32x2*)(d + 4 * fq) = pack4(o1); *(u32x2*)(d + 16 + 4 * fq) = pack4(o2); }
            } else {
                bf16* d = pn < 4 ? qn + (size_t)row * 1024 + pn * 256 : (pn < 10 ? kn + (size_t)row * 1024 + (pn - 6) * 256 : vm + (size_t)row * 1024 + (pn - 10) * 256);
#pragma unroll
                for (int bj = 0; bj < 2; ++bj)
#pragma unroll
                    for (int n = 0; n < 2; ++n) *(u32x2*)(d + bj * 128 + cl0 + n * 16) = pack4(acc[ai][bj][m][n] * rs);
            }
        }
    }
};

struct EpiP4 {
    static constexpr bool PERM = false, AFTER_DRAIN = false;
    const bf16* gates; bf16* y; bf16* ya;
    __device__ __forceinline__ void mid(const A4 (&acc)[2][2][4][2], const pg8::Unit& u, int wr, int wc, int fr, int fq) const {
        const int row0 = u.pm * 256 + wr * 64 + fr, col0 = u.pn * 256 + wc * 32 + fq * 4;
        u32x2 gq[2][2][2];
#define P4_LD(buf, it_) do { const bf16* g_ = gates + (size_t)(row0 + ((it_) >> 2) * 128 + ((it_) & 3) * 16) * 2048 + col0; \
        _Pragma("unroll") for (int bj = 0; bj < 2; ++bj) _Pragma("unroll") for (int n = 0; n < 2; ++n) gq[buf][bj][n] = *(const u32x2*)(g_ + bj * 128 + n * 16); } while (0)
        P4_LD(0, 0);
#pragma unroll
        for (int it = 0; it < 8; ++it) { const int ai = it >> 2, m = it & 3; const size_t row = (size_t)(row0 + ai * 128 + m * 16);
            if (it + 1 < 8) P4_LD((it + 1) & 1, it + 1);
            asm volatile("" ::: "memory");
#pragma unroll
            for (int bj = 0; bj < 2; ++bj)
#pragma unroll
                for (int n = 0; n < 2; ++n) *(u32x2*)(ya + row * 1024 + col0 + bj * 128 + n * 16) = pack4(acc[ai][bj][m][n] * unpack4(gq[it & 1][bj][n]));
        }
#undef P4_LD
    }
    __device__ __forceinline__ void operator()(const A4 (&acc)[2][2][4][2], const pg8::Unit& u, int wr, int wc, int fr, int fq) const {
        const int row0 = (u.pm - 128) * 256 + wr * 64 + fr, col0 = (u.pn - 4) * 256 + wc * 32 + fq * 4;
        u32x2 gq[2][2][2], yq[2][2][2];
#define P4_LD(buf, it_) do { const size_t r_ = (size_t)(row0 + ((it_) >> 2) * 128 + ((it_) & 3) * 16); const bf16* g_ = gates + r_ * 2048 + 1024 + col0; const bf16* y_ = ya + r_ * 1024 + col0; \
        _Pragma("unroll") for (int bj = 0; bj < 2; ++bj) _Pragma("unroll") for (int n = 0; n < 2; ++n) { gq[buf][bj][n] = *(const u32x2*)(g_ + bj * 128 + n * 16); yq[buf][bj][n] = *(const u32x2*)(y_ + bj * 128 + n * 16); } } while (0)
        P4_LD(0, 0);
#pragma unroll
        for (int it = 0; it < 8; ++it) { const int ai = it >> 2, m = it & 3; const size_t row = (size_t)(row0 + ai * 128 + m * 16);
            if (it + 1 < 8) P4_LD((it + 1) & 1, it + 1);
            asm volatile("" ::: "memory");
#pragma unroll
            for (int bj = 0; bj < 2; ++bj)
#pragma unroll
                for (int n = 0; n < 2; ++n) *(u32x2*)(y + row * 1024 + col0 + bj * 128 + n * 16) = pack4(unpack4(yq[it & 1][bj][n]) + acc[ai][bj][m][n] * unpack4(gq[it & 1][bj][n]));
        }
#undef P4_LD
    }
};

struct EpiT {
    static constexpr bool PERM = false, AFTER_DRAIN = false;
    bf16* o; float* part;
    __device__ __forceinline__ void mid(const A4 (&acc)[2][2][4][2], const pg8::Unit& u, int wr, int wc, int fr, int fq) const {}
    __device__ __forceinline__ void operator()(const A4 (&acc)[2][2][4][2], const pg8::Unit& u, int wr, int wc, int fr, int fq) const {
        const int row0 = u.pm * 256 + wr * 64 + fr, col0 = u.pn * 256 + wc * 32 + fq * 4;
#pragma unroll
        EPI_ROWS(ai, m) { const size_t row = (size_t)(row0 + ai * 128 + m * 16); float ss = 0.f;
#pragma unroll
            for (int bj = 0; bj < 2; ++bj)
#pragma unroll
                for (int n = 0; n < 2; ++n) { const A4 v = acc[ai][bj][m][n]; ss += dot4(v); *(u32x2*)(o + row * 1024 + col0 + bj * 128 + n * 16) = pack4(v); }
            ss += __shfl_xor(ss, 16); ss += __shfl_xor(ss, 32);
            if (fq == 0) part[row * 16 + u.pn * 4 + wc] = ss;
        }
    }
};

struct EpiRelu2 {
    static constexpr bool PERM = false, AFTER_DRAIN = false;
    bf16* o;
    __device__ __forceinline__ void mid(const A4 (&acc)[2][2][4][2], const pg8::Unit& u, int wr, int wc, int fr, int fq) const {}
    __device__ __forceinline__ void operator()(const A4 (&acc)[2][2][4][2], const pg8::Unit& u, int wr, int wc, int fr, int fq) const {
        const int row0 = u.pm * 256 + wr * 64 + fr, col0 = u.pn * 256 + wc * 32 + fq * 4;
#pragma unroll
        EPI_ROWS(ai, m) { const size_t row = (size_t)(row0 + ai * 128 + m * 16);
#pragma unroll
            for (int bj = 0; bj < 2; ++bj)
#pragma unroll
                for (int n = 0; n < 2; ++n) { A4 v = acc[ai][bj][m][n];
#pragma unroll
                    for (int e = 0; e < 4; ++e) { const float r = __builtin_fmaxf(v[e], 0.f); v[e] = r * r; }
                    *(u32x2*)(o + row * FF + col0 + bj * 128 + n * 16) = pack4(v); }
        }
    }
};

struct EpiOut {
    static constexpr bool PERM = false, AFTER_DRAIN = false;
    float* out; const bf16* eraw; const float* rstd_e; const float* gple;
    __device__ __forceinline__ void mid(const A4 (&acc)[2][2][4][2], const pg8::Unit& u, int wr, int wc, int fr, int fq) const {}
    __device__ __forceinline__ void operator()(const A4 (&acc)[2][2][4][2], const pg8::Unit& u, int wr, int wc, int fr, int fq) const {
        const int row0 = u.pm * 256 + wr * 64 + fr, col0 = u.pn * 256 + wc * 32 + fq * 4;
        f32x4 gv[2][2];
#pragma unroll
        for (int bj = 0; bj < 2; ++bj)
#pragma unroll
            for (int n = 0; n < 2; ++n) gv[bj][n] = *(const f32x4*)(gple + col0 + bj * 128 + n * 16);
        f32x4 xq[2][2][2]; u32x2 eq[2][2][2]; float rq[2];
#define PO_LD(buf, it_) do { const size_t r_ = (size_t)(row0 + ((it_) >> 2) * 128 + ((it_) & 3) * 16); rq[buf] = rstd_e[r_]; \
        _Pragma("unroll") for (int bj = 0; bj < 2; ++bj) _Pragma("unroll") for (int n = 0; n < 2; ++n) { const size_t off_ = r_ * 1024 + col0 + bj * 128 + n * 16; xq[buf][bj][n] = *(const f32x4*)(out + off_); eq[buf][bj][n] = *(const u32x2*)(eraw + off_); } } while (0)
        PO_LD(0, 0);
#pragma unroll
        for (int it = 0; it < 8; ++it) { const int ai = it >> 2, m = it & 3; const size_t row = (size_t)(row0 + ai * 128 + m * 16);
            if (it + 1 < 8) PO_LD((it + 1) & 1, it + 1);
            asm volatile("" ::: "memory");
#pragma unroll
            for (int bj = 0; bj < 2; ++bj)
#pragma unroll
                for (int n = 0; n < 2; ++n) { const size_t off = row * 1024 + col0 + bj * 128 + n * 16;
                    *(f32x4*)(out + off) = xq[it & 1][bj][n] + sigmoid4(acc[ai][bj][m][n]) * (unpack4(eq[it & 1][bj][n]) * rq[it & 1] * gv[bj][n]); }
        }
#undef PO_LD
    }
};

namespace att {
constexpr int KP = 208, VP = 192, KBUF = 64 * KP, VBUF = 64 * VP, STAGE = KBUF + VBUF;
__device__ __forceinline__ float max3f(float a, float b, float c) { float r; asm("v_max3_f32 %0, %1, %2, %3" : "=v"(r) : "v"(a), "v"(b), "v"(c)); return r; }
__device__ __forceinline__ float max2f(float a, float b) { float r; asm("v_max_f32_e32 %0, %1, %2" : "=v"(r) : "v"(a), "v"(b)); return r; }
__device__ __forceinline__ float xhalf_max(float v) { auto rr = __builtin_amdgcn_permlane32_swap(__float_as_uint(v), __float_as_uint(v), false, false); return max2f(__uint_as_float(rr[0]), __uint_as_float(rr[1])); }
__device__ __forceinline__ float xhalf_sum(float v) { auto rr = __builtin_amdgcn_permlane32_swap(__float_as_uint(v), __float_as_uint(v), false, false); return __uint_as_float(rr[0]) + __uint_as_float(rr[1]); }
__device__ __forceinline__ s16x4 vtr(const LAS unsigned char* p) { return __builtin_bit_cast(s16x4, __builtin_amdgcn_ds_read_tr16_b64_v4i16((LAS s16x4*)p)); }

template <int MODE>
__device__ __forceinline__ void unit(LAS unsigned char* lds, const bf16* __restrict__ Qa, const bf16* __restrict__ Qb, const bf16* __restrict__ Ka, const bf16* __restrict__ Kb, const bf16* __restrict__ Va, bf16* O,
                                     const float* __restrict__ sinks, int b, int h, int blk, int hp) {
    constexpr int NC = MODE == 0 ? 6 : 4;
    const int tid = threadIdx.x, lane = tid & 63, w = __builtin_amdgcn_readfirstlane(tid >> 6), l31 = lane & 31, hi = lane >> 5;
    int hq, qpos0w, t_beg, t_end, kpos_base; size_t krow_base; int kvpitch, kvcol;
    if (MODE == 0) { hq = h; qpos0w = blk * 256 + w * 32; t_beg = 0; t_end = 4 * blk + 4; kpos_base = 0; kvpitch = 1024; kvcol = h * 64; }
    else { hq = 8 * h + 2 * hp + (w >> 2); qpos0w = blk * 128 + (w & 3) * 32; t_beg = blk == 0 ? 2 : 0; t_end = 4; kpos_base = (blk - 1) * 128; kvpitch = 128; kvcol = h * 64; }
    const size_t seq0 = (size_t)b * SEQ;
    const int qpos = qpos0w + l31;
    bf16x8 qf[NC];
    { const bf16* qp = Qa + (seq0 + qpos) * 1024 + hq * 64 + hi * 8;
#pragma unroll
      for (int c = 0; c < 4; ++c) qf[c] = *(const bf16x8*)(qp + c * 16);
      if (MODE == 0) { const bf16* qp2 = Qb + (seq0 + qpos) * 512 + hq * 32 + hi * 8;
#pragma unroll
          for (int c = 4; c < NC; ++c) qf[c] = *(const bf16x8*)(qp2 + (c - 4) * 16); } }
    const int skey = tid >> 3, sch = tid & 7;
    const bf16* kg = Ka + ((long)seq0 + kpos_base + skey) * kvpitch + kvcol + sch * 8;
    const bf16* vg = Va + ((long)seq0 + kpos_base + skey) * kvpitch + kvcol + sch * 8;
    const bf16* rg = MODE == 0 ? Kb + (seq0 + (tid >> 2)) * 32 + (tid & 3) * 8 : nullptr;
    const int kw_off = skey * KP + sch * 16, vw_off = KBUF + skey * VP + sch * 16, rw_off = (tid >> 2) * KP + 128 + (tid & 3) * 16;
    const int pi = (l31 & 0x13) | ((l31 & 4) << 1) | ((l31 & 8) >> 1);
    const int kr_off = pi * KP + hi * 16;
    const int vr_off = KBUF + (8 * hi + ((lane & 15) >> 2)) * VP + (16 * ((lane >> 4) & 1) + 4 * (lane & 3)) * 2;
    float m_run, l_run;
    if (MODE == 0) { m_run = -1e30f; l_run = 0.f; } else { m_run = sinks[hq] * LOG2E; l_run = hi == 0 ? 1.f : 0.f; }
    f32x16 o0 = {}, o1 = {};
    u32x4 kreg, vreg, rreg = {};
    kreg = *(const u32x4*)(kg + (long)t_beg * 64 * kvpitch); vreg = *(const u32x4*)(vg + (long)t_beg * 64 * kvpitch);
    if (MODE == 0 && tid < 256) rreg = *(const u32x4*)(rg + (size_t)t_beg * 64 * 32);
    *(LAS u32x4*)(lds + kw_off) = kreg; *(LAS u32x4*)(lds + vw_off) = vreg;
    if (MODE == 0 && tid < 256) *(LAS u32x4*)(lds + rw_off) = rreg;
    __syncthreads();
    for (int t = t_beg; t < t_end; ++t) {
        const int st = ((t - t_beg) & 1) * STAGE, sn = STAGE - st;
        const bool more = t + 1 < t_end;
        if (more) { kreg = *(const u32x4*)(kg + (long)(t + 1) * 64 * kvpitch); vreg = *(const u32x4*)(vg + (long)(t + 1) * 64 * kvpitch);
            if (MODE == 0 && tid < 256) rreg = *(const u32x4*)(rg + (size_t)(t + 1) * 64 * 32); }
        const int kp0 = kpos_base + t * 64;
        bool doit, domask;
        if (MODE == 0) { doit = kp0 <= qpos0w + 31; domask = kp0 + 63 > qpos0w; }
        else { const int a = w & 3; doit = a < 2 ? (t <= 2) : (t >= 1); domask = true; }
        if (doit) {
            const LAS unsigned char* kb = lds + st + kr_off; const LAS unsigned char* vb = lds + st + vr_off;
            f32x16 s0 = {}, s1 = {};
#pragma unroll
            for (int c = 0; c < NC; ++c) { const bf16x8 k0 = *(const LAS bf16x8*)(kb + c * 32), k1 = *(const LAS bf16x8*)(kb + 32 * KP + c * 32);
                s0 = __builtin_amdgcn_mfma_f32_32x32x16_bf16(k0, qf[c], s0, 0, 0, 0); s1 = __builtin_amdgcn_mfma_f32_32x32x16_bf16(k1, qf[c], s1, 0, 0, 0); }
            if (domask) {
#pragma unroll
                for (int r = 0; r < 16; ++r) { const int kk = kp0 + 16 * (r >> 3) + 8 * hi + (r & 7); const int rel0 = qpos - kk, rel1 = rel0 - 32;
                    const bool ok0 = MODE == 0 ? rel0 >= 0 : (rel0 >= 0 && rel0 < 128), ok1 = MODE == 0 ? rel1 >= 0 : (rel1 >= 0 && rel1 < 128);
                    s0[r] = ok0 ? s0[r] : -1e30f; s1[r] = ok1 ? s1[r] : -1e30f; }
            }
            float mx = max2f(s0[0], s1[0]);
#pragma unroll
            for (int r = 1; r < 16; ++r) mx = max3f(mx, s0[r], s1[r]);
            mx = xhalf_max(mx);
            const float mnew = max2f(m_run, mx), alpha = __builtin_amdgcn_exp2f(m_run - mnew); m_run = mnew;
            f32x2 ps2 = {0.f, 0.f}; const f32x2 mn2 = {mnew, mnew};
#pragma unroll
            for (int r = 0; r < 16; r += 2) { f32x2 a2 = (f32x2){s0[r], s0[r + 1]} - mn2, b2 = (f32x2){s1[r], s1[r + 1]} - mn2;
                a2.x = __builtin_amdgcn_exp2f(a2.x); a2.y = __builtin_amdgcn_exp2f(a2.y); b2.x = __builtin_amdgcn_exp2f(b2.x); b2.y = __builtin_amdgcn_exp2f(b2.y);
                ps2 += a2; ps2 += b2; s0[r] = a2.x; s0[r + 1] = a2.y; s1[r] = b2.x; s1[r + 1] = b2.y; }
            l_run = l_run * alpha + (ps2.x + ps2.y);
            if (__builtin_amdgcn_ballot_w64(alpha != 1.0f) != 0ull) {
                const f32x2 al2 = {alpha, alpha};
#pragma unroll
                for (int r = 0; r < 16; r += 2) { f32x2 x = (f32x2){o0[r], o0[r + 1]} * al2, y = (f32x2){o1[r], o1[r + 1]} * al2; o0[r] = x.x; o0[r + 1] = x.y; o1[r] = y.x; o1[r + 1] = y.y; }
            }
            bf16x8 pk[4];
#pragma unroll
            for (int j = 0; j < 2; ++j) { u32x4 a, c2;
                a.x = cvtpk(s0[8 * j], s0[8 * j + 1]); a.y = cvtpk(s0[8 * j + 2], s0[8 * j + 3]); a.z = cvtpk(s0[8 * j + 4], s0[8 * j + 5]); a.w = cvtpk(s0[8 * j + 6], s0[8 * j + 7]);
                c2.x = cvtpk(s1[8 * j], s1[8 * j + 1]); c2.y = cvtpk(s1[8 * j + 2], s1[8 * j + 3]); c2.z = cvtpk(s1[8 * j + 4], s1[8 * j + 5]); c2.w = cvtpk(s1[8 * j + 6], s1[8 * j + 7]);
                pk[j] = __builtin_bit_cast(bf16x8, a); pk[2 + j] = __builtin_bit_cast(bf16x8, c2); }
#pragma unroll
            for (int j = 0; j < 4; ++j) {
                const s16x4 a0 = vtr(vb + (16 * j) * VP), a1 = vtr(vb + (16 * j + 4) * VP), b0 = vtr(vb + (16 * j) * VP + 64), b1 = vtr(vb + (16 * j + 4) * VP + 64);
                const bf16x8 va = {a0[0], a0[1], a0[2], a0[3], a1[0], a1[1], a1[2], a1[3]}, vb8 = {b0[0], b0[1], b0[2], b0[3], b1[0], b1[1], b1[2], b1[3]};
                o0 = __builtin_amdgcn_mfma_f32_32x32x16_bf16(va, pk[j], o0, 0, 0, 0); o1 = __builtin_amdgcn_mfma_f32_32x32x16_bf16(vb8, pk[j], o1, 0, 0, 0);
            }
        }
        if (more) { *(LAS u32x4*)(lds + sn + kw_off) = kreg; *(LAS u32x4*)(lds + sn + vw_off) = vreg;
            if (MODE == 0 && tid < 256) *(LAS u32x4*)(lds + sn + rw_off) = rreg; }
        __syncthreads();
    }
    const float inv = __builtin_amdgcn_rcpf(xhalf_sum(l_run));
    bf16* op = O + (seq0 + qpos) * 1024 + hq * 64 + 4 * hi;
#pragma unroll
    for (int g = 0; g < 4; ++g) { u32x2 w0, w1;
        w0.x = cvtpk(o0[4 * g] * inv, o0[4 * g + 1] * inv); w0.y = cvtpk(o0[4 * g + 2] * inv, o0[4 * g + 3] * inv);
        w1.x = cvtpk(o1[4 * g] * inv, o1[4 * g + 1] * inv); w1.y = cvtpk(o1[4 * g + 2] * inv, o1[4 * g + 3] * inv);
        *(u32x2*)(op + 8 * g) = w0; *(u32x2*)(op + 32 + 8 * g) = w1; }
}
}


__device__ __forceinline__ void swa_unit(LAS unsigned char* lds, const bf16* __restrict__ Qs, const bf16* __restrict__ Ks, const bf16* __restrict__ Vs, bf16* O, const float* __restrict__ sinks, int b, int g, int n) {
    using namespace att;
    constexpr int STG = KBUF + VBUF;
    const int tid = threadIdx.x, lane = tid & 63, w = __builtin_amdgcn_readfirstlane(tid >> 6), l31 = lane & 31, hi = lane >> 5;
    const int tb = n == 0 ? 2 : 0, kpos_base = (n - 1) * 128; const long seq0 = (long)b * SEQ;
    { const int skey = tid >> 3, sch = tid & 7; u32x4 kr[4], vr[4];
#pragma unroll
      for (int t = 0; t < 4; ++t) if (t >= tb) { const long off = (seq0 + kpos_base + t * 64 + skey) * 128 + g * 64 + sch * 8; kr[t] = *(const u32x4*)(Ks + off); vr[t] = *(const u32x4*)(Vs + off); }
#pragma unroll
      for (int t = 0; t < 4; ++t) if (t >= tb) { *(LAS u32x4*)(lds + t * STG + skey * KP + sch * 16) = kr[t]; *(LAS u32x4*)(lds + t * STG + KBUF + skey * VP + sch * 16) = vr[t]; } }
    __syncthreads();
    const int pi = (l31 & 0x13) | ((l31 & 4) << 1) | ((l31 & 8) >> 1);
    const int kr_k = pi * KP + hi * 16;
    const int vr_v = KBUF + (8 * hi + ((lane & 15) >> 2)) * VP + (16 * ((lane >> 4) & 1) + 4 * (lane & 3)) * 2;
    const int a = w & 3, qpos = n * 128 + a * 32 + l31;
    const int t0 = a < 2 ? tb : (tb > 1 ? tb : 1), t1 = a < 2 ? 2 : 3;
#pragma unroll 1
    for (int hp = 0; hp < 4; ++hp) {
        const int hq = 8 * g + 2 * hp + (w >> 2);
        bf16x8 qf[4];
        { const bf16* qp = Qs + (seq0 + qpos) * 1024 + hq * 64 + hi * 8;
#pragma unroll
          for (int c = 0; c < 4; ++c) qf[c] = *(const bf16x8*)(qp + c * 16); }
        float m_run = sinks[hq] * LOG2E, l_run = hi == 0 ? 1.f : 0.f;
        f32x16 o0 = {}, o1 = {};
#pragma unroll 1
        for (int t = t0; t <= t1; ++t) {
            const LAS unsigned char* kb = lds + t * STG + kr_k; const LAS unsigned char* vb = lds + t * STG + vr_v;
            f32x16 s0 = {}, s1 = {};
#pragma unroll
            for (int c = 0; c < 4; ++c) { const bf16x8 k0 = *(const LAS bf16x8*)(kb + c * 32), k1 = *(const LAS bf16x8*)(kb + 32 * KP + c * 32);
                s0 = __builtin_amdgcn_mfma_f32_32x32x16_bf16(k0, qf[c], s0, 0, 0, 0); s1 = __builtin_amdgcn_mfma_f32_32x32x16_bf16(k1, qf[c], s1, 0, 0, 0); }
            const int kp0 = kpos_base + t * 64;
#pragma unroll
            for (int r = 0; r < 16; ++r) { const int rel0 = qpos - (kp0 + 16 * (r >> 3) + 8 * hi + (r & 7)), rel1 = rel0 - 32;
                s0[r] = (rel0 >= 0 && rel0 < 128) ? s0[r] : -1e30f; s1[r] = (rel1 >= 0 && rel1 < 128) ? s1[r] : -1e30f; }
            float mx = max2f(s0[0], s1[0]);
#pragma unroll
            for (int r = 1; r < 16; ++r) mx = max3f(mx, s0[r], s1[r]);
            mx = xhalf_max(mx);
            const float mnew = max2f(m_run, mx), alpha = __builtin_amdgcn_exp2f(m_run - mnew); m_run = mnew;
            float ps = 0.f;
#pragma unroll
            for (int r = 0; r < 16; ++r) { s0[r] = __builtin_amdgcn_exp2f(s0[r] - mnew); s1[r] = __builtin_amdgcn_exp2f(s1[r] - mnew); ps += s0[r] + s1[r]; }
            l_run = l_run * alpha + ps;
#pragma unroll
            for (int r = 0; r < 16; ++r) { o0[r] *= alpha; o1[r] *= alpha; }
            bf16x8 pk[4];
#pragma unroll
            for (int j = 0; j < 2; ++j) { u32x4 a_, c_;
                a_.x = cvtpk(s0[8 * j], s0[8 * j + 1]); a_.y = cvtpk(s0[8 * j + 2], s0[8 * j + 3]); a_.z = cvtpk(s0[8 * j + 4], s0[8 * j + 5]); a_.w = cvtpk(s0[8 * j + 6], s0[8 * j + 7]);
                c_.x = cvtpk(s1[8 * j], s1[8 * j + 1]); c_.y = cvtpk(s1[8 * j + 2], s1[8 * j + 3]); c_.z = cvtpk(s1[8 * j + 4], s1[8 * j + 5]); c_.w = cvtpk(s1[8 * j + 6], s1[8 * j + 7]);
                pk[j] = __builtin_bit_cast(bf16x8, a_); pk[2 + j] = __builtin_bit_cast(bf16x8, c_); }
#pragma unroll
            for (int j = 0; j < 4; ++j) {
                const s16x4 a0 = vtr(vb + (16 * j) * VP), a1 = vtr(vb + (16 * j + 4) * VP), b0 = vtr(vb + (16 * j) * VP + 64), b1 = vtr(vb + (16 * j + 4) * VP + 64);
                const bf16x8 va = {a0[0], a0[1], a0[2], a0[3], a1[0], a1[1], a1[2], a1[3]}, vb8 = {b0[0], b0[1], b0[2], b0[3], b1[0], b1[1], b1[2], b1[3]};
                o0 = __builtin_amdgcn_mfma_f32_32x32x16_bf16(va, pk[j], o0, 0, 0, 0); o1 = __builtin_amdgcn_mfma_f32_32x32x16_bf16(vb8, pk[j], o1, 0, 0, 0); }
        }
        const float inv = __builtin_amdgcn_rcpf(xhalf_sum(l_run));
        bf16* op = O + (seq0 + qpos) * 1024 + hq * 64 + 4 * hi;
#pragma unroll
        for (int q4 = 0; q4 < 4; ++q4) { u32x2 w0, w1;
            w0.x = cvtpk(o0[4 * q4] * inv, o0[4 * q4 + 1] * inv); w0.y = cvtpk(o0[4 * q4 + 2] * inv, o0[4 * q4 + 3] * inv);
            w1.x = cvtpk(o1[4 * q4] * inv, o1[4 * q4 + 1] * inv); w1.y = cvtpk(o1[4 * q4 + 2] * inv, o1[4 * q4 + 3] * inv);
            *(u32x2*)(op + 8 * q4) = w0; *(u32x2*)(op + 32 + 8 * q4) = w1; }
    }
    __syncthreads();
}

__device__ __forceinline__ int swap45(int w) { return (w & 15) | (((w >> 4) & 1) << 5) | (((w >> 5) & 1) << 4); }
__device__ __forceinline__ int src_col(int which, int r) {
    switch (which) {
    case 0:
        if (r < 256) return r;
        if (r < 512) { const int p = r - 256; return p < 160 ? 256 + p : -1; }
        if (r < 1536) { const int p = r - 512; return 416 + (p & ~63) + swap45(p & 63); }
        if (r < 1792) { const int p = r - 1536; return p < 128 ? 1440 + (p & ~63) + swap45(p & 63) : 1568 + (p - 128); }
        return 1696 + (r - 1792);
    case 1:
        if (r < 1024) return (r >> 6) * 96 + (r & 63);
        { const int p = r - 1024; return (p >> 5) * 96 + 64 + (p & 31); }
    case 2:
        if (r < 1024) return (r >> 6) * 128 + (r & 63);
        { const int p = r - 1024; return (p >> 6) * 128 + 64 + (p & 63); }
    default: return r;
    }
}
__device__ __forceinline__ void transpose_item(const float* __restrict__ W, int Ks, int N, bf16* WT, int R, int Kd, int which, const float* __restrict__ gs, LAS float* scr, int item, int lane) {
    const int nblk = R / 32, kb = item / nblk, nb = item % nblk, k0 = 64 * kb, n0 = 32 * nb;
    const int sc = src_col(which, n0 + (lane & 31));
    float vals[32];
#pragma unroll
    for (int i = 0; i < 32; ++i) { const int k = k0 + 2 * i + (lane >> 5); float v = 0.f;
        if (sc >= 0 && k < Ks) { v = W[(size_t)k * N + sc]; if (gs) v *= gs[k]; }
        vals[i] = v; }
#pragma unroll
    for (int i = 0; i < 32; ++i) scr[(2 * i + (lane >> 5)) * 33 + (lane & 31)] = vals[i];
    asm volatile("s_waitcnt lgkmcnt(0)" ::: "memory");
    const int c = lane & 7;
#pragma unroll
    for (int j = 0; j < 4; ++j) { const int n = (lane >> 3) + 8 * j; const LAS float* s = scr + (8 * c) * 33 + n;
        u32x4 o; o.x = cvtpk(s[0 * 33], s[1 * 33]); o.y = cvtpk(s[2 * 33], s[3 * 33]); o.z = cvtpk(s[4 * 33], s[5 * 33]); o.w = cvtpk(s[6 * 33], s[7 * 33]);
        *(u32x4*)(WT + (size_t)(n0 + n) * Kd + k0 + 8 * c) = o; }
    asm volatile("s_waitcnt lgkmcnt(0)" ::: "memory");
}


__device__ __forceinline__ float sum16(const float* p) { const f32x4* q = (const f32x4*)p; const f32x4 a = q[0], b = q[1], c = q[2], d = q[3];
    return (((a[0] + a[1]) + (a[2] + a[3])) + ((b[0] + b[1]) + (b[2] + b[3]))) + (((c[0] + c[1]) + (c[2] + c[3])) + ((d[0] + d[1]) + (d[2] + d[3]))); }
template <bool FIRST>
__device__ __forceinline__ void rowpass(const float* xin, float* xo, const bf16* T, const float* part_t, const float* gpost, const float* gpre, bf16* XN, const float* part_e, float* rstd_e, int gw, int NGW, int lane) {
    for (int row0 = gw; row0 < M; row0 += 2 * NGW) {
        f32x4 xv[2][4]; u32x4 tw[2][2]; float rt[2];
#pragma unroll
        for (int r2 = 0; r2 < 2; ++r2) { const size_t row = (size_t)(row0 + r2 * NGW);
#pragma unroll
            for (int j = 0; j < 2; ++j) { const int col = 512 * j + 8 * lane; tw[r2][j] = *(const u32x4*)(T + row * DM + col);
                xv[r2][2 * j] = *(const f32x4*)(xin + row * DM + col); xv[r2][2 * j + 1] = *(const f32x4*)(xin + row * DM + col + 4); }
            rt[r2] = __builtin_amdgcn_rsqf(sum16(part_t + row * 16) * (1.0f / DM) + EPS); }
#pragma unroll
        for (int r2 = 0; r2 < 2; ++r2) { const size_t row = (size_t)(row0 + r2 * NGW); float ss = 0.f;
#pragma unroll
            for (int j = 0; j < 2; ++j) { const int col = 512 * j + 8 * lane;
                const f32x4 ta = unpack4((u32x2){tw[r2][j].x, tw[r2][j].y}), tb = unpack4((u32x2){tw[r2][j].z, tw[r2][j].w});
                const f32x4 ga = *(const f32x4*)(gpost + col), gb = *(const f32x4*)(gpost + col + 4);
                xv[r2][2 * j] += ta * rt[r2] * ga; xv[r2][2 * j + 1] += tb * rt[r2] * gb; ss += dot4(xv[r2][2 * j]) + dot4(xv[r2][2 * j + 1]);
                *(f32x4*)(xo + row * DM + col) = xv[r2][2 * j]; *(f32x4*)(xo + row * DM + col + 4) = xv[r2][2 * j + 1]; }
            if (FIRST) { const float r1 = __builtin_amdgcn_rsqf(wave_sum(ss) * (1.0f / DM) + EPS);
#pragma unroll
                for (int j = 0; j < 2; ++j) { const int col = 512 * j + 8 * lane; const f32x4 ga = *(const f32x4*)(gpre + col), gb = *(const f32x4*)(gpre + col + 4);
                    const u32x2 a = pack4(xv[r2][2 * j] * r1 * ga), b2 = pack4(xv[r2][2 * j + 1] * r1 * gb); *(u32x4*)(XN + row * DM + col) = (u32x4){a.x, a.y, b2.x, b2.y}; }
            } else {
#pragma unroll
                for (int j = 0; j < 2; ++j) { const int col = 512 * j + 8 * lane; const u32x2 a = pack4(xv[r2][2 * j]), b2 = pack4(xv[r2][2 * j + 1]); *(u32x4*)(XN + row * DM + col) = (u32x4){a.x, a.y, b2.x, b2.y}; }
                if (lane == 0) rstd_e[row] = __builtin_amdgcn_rsqf(sum16(part_e + row * 16) * (1.0f / DM) + EPS); }
        }
    }
}

#define XB_TMO      128
#define XB_XCNT(j)  (256  + 64 * (j))
#define XB_XSUB(j)  (1280 + 64 * (j))
#define XB_XGEN(j)  (2304 + 64 * (j))
#define XB_TOP      3328
#define XB_TOPGEN   3392
#define XCD_BAR_WORDS 3456
#define XB_SPIN_CAP (1u << 18)

__device__ __forceinline__ unsigned xb_ld(unsigned* p)              { return __hip_atomic_load(p, __ATOMIC_RELAXED, __HIP_MEMORY_SCOPE_AGENT); }
__device__ __forceinline__ unsigned xb_add(unsigned* p, unsigned v) { return __hip_atomic_fetch_add(p, v, __ATOMIC_RELAXED, __HIP_MEMORY_SCOPE_AGENT); }
__device__ __forceinline__ unsigned xb_xcc_id() { return (unsigned)__builtin_amdgcn_s_getreg((3 << 11) | 20) & 0xFu; }
#define XB_SPIN(cond, bar) do { unsigned _sp = 0; while (cond) { __builtin_amdgcn_s_sleep(1); \
    if ((++_sp & 255u) == 0u) { if (xb_ld(&(bar)[XB_TMO])) break; if (_sp > XB_SPIN_CAP) { atomicAdd(&(bar)[XB_TMO], 1u); break; } } } } while (0)

struct XcdBarrier {
    unsigned* bar; unsigned x;
    volatile LAS unsigned* st;
};

__device__ __forceinline__ XcdBarrier xcd_barrier_post(unsigned* bar, volatile LAS unsigned* st) {
    XcdBarrier b; b.bar = bar; b.x = xb_xcc_id(); b.st = st;
    if (threadIdx.x == 0) (void)xb_add(&bar[XB_XCNT(b.x)], 1u);
    return b;
}
__device__ __forceinline__ void xcd_barrier_complete(unsigned* bar, unsigned x, unsigned& nloc, unsigned& nx) {
    const unsigned G = gridDim.x * gridDim.y * gridDim.z;
    unsigned sum, cnt, mine, sp = 0u;
    for (;;) {
        sum = 0u; cnt = 0u; mine = 0u;
#pragma unroll
        for (unsigned j = 0; j < 16; ++j) { const unsigned c = xb_ld(&bar[XB_XCNT(j)]); sum += c; cnt += (c > 0u) ? 1u : 0u; mine = (j == x) ? c : mine; }
        if (sum == G) break;
        __builtin_amdgcn_s_sleep(1);
        if ((++sp & 255u) == 0u) { if (xb_ld(&bar[XB_TMO])) break; if (sp > XB_SPIN_CAP) { atomicAdd(&bar[XB_TMO], 1u); break; } }
    }
    nloc = mine > 0u ? mine : 1u; nx = cnt > 0u ? cnt : 1u;
}

__device__ __forceinline__ void xcd_barrier(const XcdBarrier& b) {
    asm volatile("s_waitcnt vmcnt(0)" ::: "memory");
    __syncthreads();
    if (threadIdx.x == 0) {
        unsigned* bar = b.bar;
        __builtin_amdgcn_s_waitcnt(0);
        unsigned nloc = b.st[0], nx = b.st[1];
        if (nloc == 0u) { xcd_barrier_complete(bar, b.x, nloc, nx); b.st[0] = nloc; b.st[1] = nx; }
        const unsigned old = xb_add(&bar[XB_XSUB(b.x)], 1u);
        const unsigned gen = old / nloc;
        if (old + 1u == (gen + 1u) * nloc) {
            __builtin_amdgcn_fence(__ATOMIC_RELEASE, "agent");
            asm volatile("s_waitcnt vmcnt(0)" ::: "memory");
            const unsigned og = xb_add(&bar[XB_TOP], 1u);
            const unsigned tg = og / nx;
            if (og + 1u == (tg + 1u) * nx) xb_add(&bar[XB_TOPGEN], 1u);
            else XB_SPIN(xb_ld(&bar[XB_TOPGEN]) == tg, bar);
            __builtin_amdgcn_fence(__ATOMIC_ACQUIRE, "agent");
            xb_add(&bar[XB_XGEN(b.x)], 1u);
            asm volatile("s_waitcnt vmcnt(0)" ::: "memory");
        } else {
            XB_SPIN(xb_ld(&bar[XB_XGEN(b.x)]) == gen, bar);
            __builtin_amdgcn_fence(__ATOMIC_ACQUIRE, "agent");
            asm volatile("s_waitcnt vmcnt(0)" ::: "memory");
        }
    }
    __syncthreads();
}

__global__ void __launch_bounds__(NWAVES * 64, 2) mega_fwd(Params P) {
    extern __shared__ __attribute__((aligned(16))) unsigned char lds_raw[];
    LAS unsigned char* lds = (LAS unsigned char*)lds_raw;
    const int tid = threadIdx.x, lane = tid & 63, wave = __builtin_amdgcn_readfirstlane(tid >> 6);
    const int G = gridDim.x, bx = blockIdx.x, vcu = (G % 8 == 0) ? (bx % 8) * (G / 8) + bx / 8 : bx;
    const int gw = vcu * NWAVES + wave, NGW = G * NWAVES;
    const int lo = P.ph_lo, hi = P.ph_hi;
#ifndef PH_MASK
#define PH_MASK 0x7ff
#endif
#define IN(k) (((PH_MASK >> (k)) & 1) && lo <= (k) && (k) < hi)
#ifdef PROBE_A
    unsigned long long t_a = 0, t_b = 0;
#define STAMP(id) do { if ((id) == PROBE_A) t_a = __builtin_amdgcn_s_memrealtime(); if ((id) == PROBE_B) t_b = __builtin_amdgcn_s_memrealtime(); } while (0)
#else
#define STAMP(id) do { } while (0)
#endif
    volatile LAS unsigned* bst = (volatile LAS unsigned*)(lds + 128 * 1024);
    if (tid < 2) bst[tid] = 0u;
    __syncthreads();
    XcdBarrier xbar = xcd_barrier_post((unsigned*)(P.ws + WS_CTL) + 1024, bst);
#define SEAM(k) do { if (IN(k) && IN((k) + 1)) { if (P.ph_hi > 64) cg::this_grid().sync(); else xcd_barrier(xbar); } STAMP((k) + 1); } while (0)
    STAMP(0);
#define tab ((const f32x2*)(P.ws + WS_TAB))
#define XN ((bf16*)(P.ws + WS_XN))
#define part_q ((float*)(P.ws + WS_PQ))
#define part_kv ((float*)(P.ws + WS_PKV))
#define part_t ((float*)(P.ws + WS_PT))
#define part_e ((float*)(P.ws + WS_PE))
#define rstd_e ((float*)(P.ws + WS_RSTDE))
#define gates ((bf16*)P.out)

    if (IN(0)) {
        LAS float* scr = (LAS float*)(lds + wave * 16384);
#define TR(IN_, KS, N_, R_, KD, WHICH, GSP, OFF) { const int nit = ((KD) / 64) * ((R_) / 32); for (; it < nit; it += nstep) transpose_item(P.in[IN_], KS, N_, (bf16*)(P.ws + (OFF)), R_, KD, WHICH, GSP, scr, it, lane); it -= nit; }
#define TR_LATE() do { \
        TR(5, 256, 1536, 1536, 256, 1, P.in[4], WS_WQKV) \
        TR(7, 128, 2048, 2048, 256, 2, P.in[6], WS_WQKV + (size_t)1536 * 256 * 2) \
        TR(9, 1024, 1024, 1024, 1024, 3, nullptr, WS_WUP) \
        TR(10, 1024, 1024, 1024, 1024, 3, nullptr, WS_WUP + (size_t)1024 * 1024 * 2) \
        TR(11, 1024, 1024, 1024, 1024, 3, nullptr, WS_WOUT) \
        TR(14, 1024, 4096, 4096, 1024, 3, nullptr, WS_W1) \
        TR(15, 4096, 1024, 1024, 4096, 3, nullptr, WS_W2) \
        TR(19, 1024, 1024, 1024, 1024, 3, nullptr, WS_WPG) \
        TR(17, 256, 1024, 1024, 256, 3, nullptr, WS_WPP) } while (0)
        { int it = gw; const int nstep = NGW;
          TR(3, 1024, 3744, N_IN_PAD, 1024, 0, nullptr, WS_WIN)
          if (G != 256) TR_LATE(); }
        { const float* x = P.in[0]; const float* g = P.in[2];
          for (int row0 = gw; row0 < M; row0 += 2 * NGW) {
              f32x4 v[2][4], pv[2]; float ss[2] = {0.f, 0.f};
#pragma unroll
              for (int r2 = 0; r2 < 2; ++r2) { const int row = row0 + r2 * NGW; const f32x4* xr = (const f32x4*)(x + (size_t)row * DM);
#pragma unroll
                  for (int j = 0; j < 4; ++j) v[r2][j] = xr[lane + 64 * j];
                  pv[r2] = ((const f32x4*)(P.in[1] + (size_t)row * 256))[lane]; }
#pragma unroll
              for (int r2 = 0; r2 < 2; ++r2) { const int row = row0 + r2 * NGW;
#pragma unroll
                  for (int j = 0; j < 4; ++j) ss[r2] += dot4(v[r2][j]);
                  const float rs = __builtin_amdgcn_rsqf(wave_sum(ss[r2]) * (1.0f / DM) + EPS);
#pragma unroll
                  for (int j = 0; j < 4; ++j) { const f32x4 gg = ((const f32x4*)g)[lane + 64 * j]; *(u32x2*)(XN + (size_t)row * DM + 4 * (lane + 64 * j)) = pack4(v[r2][j] * rs * gg); }
                  *(u32x2*)((bf16*)(P.ws + WS_PB) + (size_t)row * 256 + 4 * lane) = pack4(pv[r2]); }
          } }
        for (int i = (vcu * NWAVES + wave) * 64 + lane; i < SEQ * 32; i += NGW * 64) {
            const int pos = i >> 5, j = i & 31; const float inv = expf(-9.210340371976184f * (float)j * (2.0f / 64.0f)); const float ang = (float)pos * inv;
            ((f32x2*)(P.ws + WS_TAB))[i] = (f32x2){cosf(ang), sinf(ang)}; }
    }
    SEAM(0);
    if (IN(1)) {
        pg8::Gemm g{XN, (const bf16*)(P.ws + WS_WIN), M, N_IN_PAD, 1024}; Sched S = make_sched(G, bx, 15);
        EpiP1 E{(bf16*)(P.ws + WS_QA), (bf16*)(P.ws + WS_KVR), (bf16*)(P.ws + WS_KROPE), (bf16*)(P.ws + WS_QS), (bf16*)(P.ws + WS_KS), (bf16*)(P.ws + WS_VS), gates, part_q, part_kv, tab};
        pg8::gemm_phase<EpiP1, Sched, true, true>(lds, g, S, E);
        if (G == 256 && bx >= 128) {
            LAS float* scr = (LAS float*)(lds + wave * 16384);
            int it = (bx - 128) * NWAVES + wave; const int nstep = 128 * NWAVES;
            TR_LATE();
        }
    }
#undef TR
#undef TR_LATE
    SEAM(1);
    if (IN(2)) {
        pg8::Gemm g{(const bf16*)(P.ws + WS_QA), (const bf16*)(P.ws + WS_WQKV), 2 * M, 3584, 256};
        Sched S = make_sched(G, bx, 6); S.nseg = 2; S.nN[1] = 8; S.pmo[1] = 128; S.pno[1] = 6; S.start[1] = 768; S.start[2] = 768 + 1024;
        EpiP2 E{(bf16*)(P.ws + WS_QN), (bf16*)(P.ws + WS_QR), (bf16*)(P.ws + WS_KN), (bf16*)(P.ws + WS_VM), part_q, part_kv, tab};
        pg8::gemm_phase<EpiP2, Sched, true, true>(lds, g, S, E);
    }
    SEAM(2);
    if (IN(3)) {
        for (int U = vcu; U < 2048; U += G) {
            const int c8 = U & 255, i = U >> 8, bh = c8 >> 1, s = c8 & 1, k = i >> 1, qb = (i & 1) ? 15 - 2 * k - s : 2 * k + s;
            att::unit<0>(lds, (const bf16*)(P.ws + WS_QN), (const bf16*)(P.ws + WS_QR), (const bf16*)(P.ws + WS_KN), (const bf16*)(P.ws + WS_KROPE), (const bf16*)(P.ws + WS_VM), (bf16*)(P.ws + WS_QN), nullptr, bh >> 4, bh & 15, qb, 0);
        }
        STAMP(12);
        for (int U = vcu; U < 512; U += G) swa_unit(lds, (const bf16*)(P.ws + WS_QS), (const bf16*)(P.ws + WS_KS), (const bf16*)(P.ws + WS_VS), (bf16*)(P.ws + WS_QS), P.in[8], U >> 6, (U >> 5) & 1, U & 31);
    }
    SEAM(3);
    if (IN(4)) {
        pg8::Gemm g{(const bf16*)(P.ws + WS_QN), (const bf16*)(P.ws + WS_WUP), 2 * M, 2048, 1024}; Sched S = make_sched(G, bx, 4); S.pairs = 1;
        EpiP4 E{gates, XN, (bf16*)(P.ws + WS_QA)};
        pg8::gemm_phase<EpiP4, Sched, true, true>(lds, g, S, E);
    }
    SEAM(4);
    if (IN(5)) {
        pg8::Gemm g{XN, (const bf16*)(P.ws + WS_WOUT), M, 1024, 1024}; Sched S = make_sched(G, bx, 4);
        EpiT E{(bf16*)(P.ws + WS_T), part_t};
        pg8::gemm_phase<EpiT, Sched, true, true>(lds, g, S, E);
    }
    SEAM(5);
    if (IN(6)) rowpass<true>(P.in[0], P.out, (const bf16*)(P.ws + WS_T), part_t, P.in[12], P.in[13], XN, nullptr, nullptr, gw, NGW, lane);
    SEAM(6);
    if (IN(7)) {
        pg8::Gemm g{XN, (const bf16*)(P.ws + WS_W1), M, FF, 1024}; Sched S = make_sched(G, bx, 16);
        EpiRelu2 E{(bf16*)(P.ws + WS_U)};
        pg8::gemm_phase<EpiRelu2, Sched, true, true>(lds, g, S, E);
    }
    SEAM(7);
    if (IN(8)) {
        { pg8::Gemm g{(const bf16*)(P.ws + WS_U), (const bf16*)(P.ws + WS_W2), M, 1024, FF}; Sched S = make_sched(G, bx, 4);
          EpiT E{(bf16*)(P.ws + WS_T), part_t};
          pg8::gemm_phase<EpiT, Sched, true, true>(lds, g, S, E); }
        { pg8::Gemm g{(const bf16*)(P.ws + WS_PB), (const bf16*)(P.ws + WS_WPP), M, 1024, 256}; Sched S = make_sched(G, bx, 4);
          EpiT E{(bf16*)(P.ws + WS_ERAW), part_e};
          pg8::gemm_phase<EpiT, Sched, true, true>(lds, g, S, E); }
    }
    SEAM(8);
    if (IN(9)) rowpass<false>(P.out, P.out, (const bf16*)(P.ws + WS_T), part_t, P.in[16], nullptr, XN, part_e, rstd_e, gw, NGW, lane);
    SEAM(9);
    if (IN(10)) {
        pg8::Gemm g{XN, (const bf16*)(P.ws + WS_WPG), M, 1024, 1024}; Sched S = make_sched(G, bx, 4);
        EpiOut E{P.out, (const bf16*)(P.ws + WS_ERAW), rstd_e, P.in[18]};
        pg8::gemm_phase<EpiOut, Sched, true, true>(lds, g, S, E);
    }
    STAMP(11);
#ifdef PROBE_A
    cg::this_grid().sync();
    STAMP(13); cg::this_grid().sync(); cg::this_grid().sync(); cg::this_grid().sync(); cg::this_grid().sync(); STAMP(14);
    if (bx == 0 && tid == 0) P.out[0] += (float)(((t_b - t_a) / PROBE_Q) * (PROBE_Q / 100ull));
#endif
#undef IN
#undef SEAM
#undef tab
#undef XN
#undef part_q
#undef part_kv
#undef part_t
#undef part_e
#undef rstd_e
#undef gates
}

extern "C" void kernel_launch(void* const* d_in, const int* in_sizes, int n_in, void* d_out, int out_size, void* d_ws, size_t ws_size, hipStream_t stream) {
    static int grid = 0;
    if (grid == 0) {
        int dev = 0, cus = 0, per_cu = 0;
        hipGetDevice(&dev); hipDeviceGetAttribute(&cus, hipDeviceAttributeMultiprocessorCount, dev);
        if (hipFuncSetAttribute((const void*)mega_fwd, hipFuncAttributeMaxDynamicSharedMemorySize, LDS_BYTES) != hipSuccess) { fprintf(stderr, "hipFuncSetAttribute failed\n"); }
        if (hipOccupancyMaxActiveBlocksPerMultiprocessor(&per_cu, (const void*)mega_fwd, NWAVES * 64, LDS_BYTES) != hipSuccess || per_cu < 1) { fprintf(stderr, "occupancy query: %d\n", per_cu); per_cu = 1; }
        (void)hipGetLastError();
        grid = cus * per_cu;
        if (n_in != 20 || ws_size < WS_END) fprintf(stderr, "kernel_launch: unexpected n_in %d / ws %zu\n", n_in, ws_size);
    }
    Params p{};
    for (int i = 0; i < 20; ++i) p.in[i] = (const float*)d_in[i];
    p.out = (float*)d_out; p.ws = (unsigned char*)d_ws;
#if MK_N_LAUNCHES == 1
    (void)hipMemsetAsync((unsigned char*)d_ws + WS_CTL, 0, CTL_BYTES, stream);
    p.ph_lo = 0; p.ph_hi = 11;
    void* args[] = {&p};
    hipError_t e = hipLaunchCooperativeKernel((const void*)mega_fwd, dim3(grid), dim3(NWAVES * 64), args, LDS_BYTES, stream);
    if (e != hipSuccess) fprintf(stderr, "cooperative launch failed: %s (grid %d)\n", hipGetErrorString(e), grid);
#else
    for (int k = 0; k < 11; ++k) { p.ph_lo = k; p.ph_hi = k + 1; hipLaunchKernelGGL(mega_fwd, dim3(grid), dim3(NWAVES * 64), LDS_BYTES, stream, p); }
#endif
}
```

```cpp
#include <hip/hip_runtime.h>
#include <hip/hip_cooperative_groups.h>
#include <cstdio>
#include <cstdint>
namespace cg = cooperative_groups;
#ifndef MK_N_LAUNCHES
#define MK_N_LAUNCHES 1
#endif
namespace pg8 {
#define PG8_LAS __attribute__((address_space(3)))
typedef unsigned short bf16_t;
typedef short bf16x8 __attribute__((ext_vector_type(8)));
typedef float f32x4 __attribute__((ext_vector_type(4)));
typedef unsigned u32x4 __attribute__((ext_vector_type(4)));
constexpr int BM = 256, BK = 64, HALF = 128, HTB = HALF * BK * 2  , STAGE_BYTES = 8 * HTB, NXCD = 8, WGM = 8;

__host__ __device__ __forceinline__ int lds_byte(int r, int c) { const int st = (r >> 4) * 2 + (c >> 5), rr = r & 15, cc = c & 31, ob = rr * 64 + cc * 2; return st * 1024 + (ob ^ (((ob >> 9) & 1) << 5)); }
__host__ __device__ __forceinline__ void stage_rc(int b, int& R, int& C) { const int st = b / 1024, sb = b % 1024, swz = sb ^ (((sb >> 9) & 1) << 5); R = (st >> 1) * 16 + swz / 64; C = (st & 1) * 32 + (swz % 64) / 2; }
__host__ __device__ __forceinline__ int perm32(int rho) { const int n = rho >> 4, i = rho & 15; return 8 * (i >> 2) + 4 * n + (i & 3); }

struct Unit { int pm, pn, kind; };
struct Gemm { const bf16_t* A; const bf16_t* Bt; int M, N, K; };

template <class Epi, class Sched, bool ALIGN_EPI = false, bool SP2 = false>
__device__ __forceinline__ void gemm_phase(PG8_LAS unsigned char* lds, const Gemm g, const Sched& S, const Epi& E) {
    const int tid = threadIdx.x, wid = __builtin_amdgcn_readfirstlane(tid >> 6), lane = tid & 63, wr = wid >> 2, wc = wid & 3, fr = lane & 15, fq = lane >> 4;
    int K_ = g.K; asm volatile("" : "+s"(K_));
    const int K = K_, nt = K / BK;
    unsigned voffA[2], voffB[2];
#pragma unroll
    for (int i = 0; i < 2; ++i) { int R, C; stage_rc(tid * 16 + i * 8192, R, C); const int Rb = Epi::PERM ? ((R & ~31) + perm32(R & 31)) : R;
        voffA[i] = (unsigned)(R * K + C) * 2u; voffB[i] = (unsigned)(Rb * K + C) * 2u; }
    const size_t kstep = (size_t)(BK * 2);
    const size_t hstep = (size_t)HALF * K * 2;
    const size_t tstep = 2 * hstep;
    const unsigned ldsw = (unsigned)wid * 1024u;
    const int aoff = lds_byte(wr * 64 + fr, fq * 8), boff = lds_byte(wc * 32 + fr, fq * 8);
#define PG8_SA(b, h) (((b) * 2 + (h)) * HTB)
#define PG8_SB(b, h) ((4 + (b) * 2 + (h)) * HTB)
#define PG8_STAGE(bufoff, gbase, voff) do { _Pragma("unroll") for (int _i = 0; _i < 2; ++_i) \
        __builtin_amdgcn_global_load_lds((const unsigned*)((const char*)(gbase) + (voff)[_i]), (PG8_LAS unsigned*)(lds + (bufoff) + ldsw + _i * 8192), 16, 0, 0); } while (0)
#define PG8_LDA(dst, b, h) do { _Pragma("unroll") for (int m = 0; m < 4; ++m) _Pragma("unroll") for (int k = 0; k < 2; ++k) dst[m][k] = *(const PG8_LAS bf16x8*)(lds + PG8_SA(b, h) + aoff + m * 2048 + k * 1024); } while (0)
#define PG8_LDB(dst, b, h) do { _Pragma("unroll") for (int n = 0; n < 2; ++n) _Pragma("unroll") for (int k = 0; k < 2; ++k) dst[n][k] = *(const PG8_LAS bf16x8*)(lds + PG8_SB(b, h) + boff + n * 2048 + k * 1024); } while (0)
#define PG8_MMA(ai, bj, At, Bt) do { __builtin_amdgcn_s_setprio(1); _Pragma("unroll") for (int m = 0; m < 4; ++m) _Pragma("unroll") for (int n = 0; n < 2; ++n) _Pragma("unroll") for (int k = 0; k < 2; ++k) \
        acc[ai][bj][m][n] = __builtin_amdgcn_mfma_f32_16x16x32_bf16(Bt[n][k], At[m][k], acc[ai][bj][m][n], 0, 0, 0); __builtin_amdgcn_s_setprio(0); } while (0)
#define PG8_WAIT_V(n) asm volatile("s_waitcnt vmcnt(" #n ")" ::: "memory")
#define PG8_WAIT_L(n) asm volatile("s_waitcnt lgkmcnt(" #n ")" ::: "memory")
#define PG8_BAR __builtin_amdgcn_s_barrier()
#define PG8_SCHED __builtin_amdgcn_sched_barrier(0)
    Unit cur, nxt; int ui = 0;
    if (!S.next(0, cur)) return;
    f32x4 acc[2][2][4][2];
#pragma unroll
    for (int a = 0; a < 2; ++a)
#pragma unroll
        for (int b = 0; b < 2; ++b)
#pragma unroll
            for (int m = 0; m < 4; ++m)
#pragma unroll
                for (int n = 0; n < 2; ++n) acc[a][b][m][n] = (f32x4){0.f, 0.f, 0.f, 0.f};
    bf16x8 At[4][2], B0[2][2], B1[2][2];
    const char* cA = (const char*)g.A + (size_t)cur.pm * tstep; const char* cB = (const char*)g.Bt + (size_t)cur.pn * tstep;
    S.a_ready(cur);
    if constexpr (SP2) {
        PG8_STAGE(PG8_SB(0, 0), cB, voffB); PG8_STAGE(PG8_SB(0, 1), cB + hstep, voffB); PG8_STAGE(PG8_SA(0, 0), cA, voffA); PG8_STAGE(PG8_SA(0, 1), cA + hstep, voffA);
        if (wr == 1) PG8_BAR;
        PG8_WAIT_V(2); PG8_BAR;
        PG8_STAGE(PG8_SB(1, 0), cB + kstep, voffB); PG8_STAGE(PG8_SA(1, 0), cA + kstep, voffA); PG8_STAGE(PG8_SB(1, 1), cB + hstep + kstep, voffB);
        PG8_WAIT_V(6); PG8_BAR;
    } else {
        PG8_STAGE(PG8_SB(0, 0), cB, voffB); PG8_STAGE(PG8_SA(0, 0), cA, voffA); PG8_STAGE(PG8_SB(0, 1), cB + hstep, voffB); PG8_STAGE(PG8_SA(0, 1), cA + hstep, voffA);
        if (wr == 1) PG8_BAR;
        PG8_WAIT_V(4); PG8_BAR;
        PG8_STAGE(PG8_SB(1, 0), cB + kstep, voffB); PG8_STAGE(PG8_SA(1, 0), cA + kstep, voffA); PG8_STAGE(PG8_SB(1, 1), cB + hstep + kstep, voffB);
        PG8_WAIT_V(6); PG8_BAR;
    }
    for (;;) {
        const bool has_next = S.next(ui + 1, nxt);
        const char* nA = has_next ? (const char*)g.A + (size_t)nxt.pm * tstep : cA; const char* nB = has_next ? (const char*)g.Bt + (size_t)nxt.pn * tstep : cB;
        for (int t = 0; t < nt; t += 2) {
            const bool last = (t == nt - 2);
            const char* a1 = cA + (size_t)(t + 1) * kstep;
            const char* a2 = last ? nA : cA + (size_t)(t + 2) * kstep; const char* b2 = last ? nB : cB + (size_t)(t + 2) * kstep;
            const char* a3 = a2 + kstep; const char* b3 = b2 + kstep;
            if (last && has_next) S.a_ready(nxt);
            if constexpr (SP2) {
            PG8_LDB(B0, 0, 0); PG8_LDB(B1, 0, 1); PG8_SCHED; PG8_LDA(At, 0, 0); PG8_STAGE(PG8_SA(1, 1), a1 + hstep, voffA);
            PG8_WAIT_V(8); PG8_WAIT_L(0); PG8_BAR; PG8_MMA(0, 0, At, B0); PG8_MMA(0, 1, At, B1); PG8_BAR; PG8_SCHED;
            PG8_LDA(At, 0, 1); PG8_STAGE(PG8_SB(0, 0), b2, voffB); PG8_STAGE(PG8_SB(0, 1), b2 + hstep, voffB); PG8_STAGE(PG8_SA(0, 0), a2, voffA);
            PG8_WAIT_V(8); PG8_WAIT_L(0); PG8_BAR; PG8_MMA(1, 0, At, B0); PG8_MMA(1, 1, At, B1); PG8_BAR; PG8_SCHED;
            PG8_LDB(B0, 1, 0); PG8_LDB(B1, 1, 1); PG8_SCHED; PG8_LDA(At, 1, 0); PG8_STAGE(PG8_SA(0, 1), a2 + hstep, voffA);
            PG8_WAIT_V(8); PG8_WAIT_L(0); PG8_BAR; PG8_MMA(0, 0, At, B0); PG8_MMA(0, 1, At, B1); PG8_BAR; PG8_SCHED;
            PG8_LDA(At, 1, 1); PG8_STAGE(PG8_SB(1, 0), b3, voffB); PG8_STAGE(PG8_SB(1, 1), b3 + hstep, voffB); PG8_STAGE(PG8_SA(1, 0), a3, voffA);
            PG8_WAIT_V(8); PG8_WAIT_L(0); PG8_BAR; PG8_MMA(1, 0, At, B0); PG8_MMA(1, 1, At, B1); PG8_BAR; PG8_SCHED;
            } else {
            PG8_LDB(B0, 0, 0); PG8_SCHED; PG8_LDA(At, 0, 0); PG8_STAGE(PG8_SA(1, 1), a1 + hstep, voffA);
            PG8_WAIT_L(8); PG8_BAR; PG8_WAIT_L(0); PG8_MMA(0, 0, At, B0); PG8_BAR; PG8_SCHED;
            PG8_LDB(B1, 0, 1); PG8_STAGE(PG8_SB(0, 0), b2, voffB);
            PG8_BAR; PG8_WAIT_L(0); PG8_MMA(0, 1, At, B1); PG8_BAR;
            PG8_LDA(At, 0, 1); PG8_STAGE(PG8_SA(0, 0), a2, voffA);
            PG8_BAR; PG8_WAIT_L(0); PG8_MMA(1, 0, At, B0); PG8_BAR; PG8_SCHED;
            PG8_STAGE(PG8_SB(0, 1), b2 + hstep, voffB);
            PG8_WAIT_V(6); PG8_BAR; PG8_MMA(1, 1, At, B1); PG8_BAR;
            PG8_LDB(B0, 1, 0); PG8_SCHED; PG8_LDA(At, 1, 0); PG8_STAGE(PG8_SA(0, 1), a2 + hstep, voffA);
            PG8_WAIT_L(8); PG8_BAR; PG8_WAIT_L(0); PG8_MMA(0, 0, At, B0); PG8_BAR; PG8_SCHED;
            PG8_LDB(B1, 1, 1); PG8_STAGE(PG8_SB(1, 0), b3, voffB);
            PG8_BAR; PG8_WAIT_L(0); PG8_MMA(0, 1, At, B1); PG8_BAR;
            PG8_LDA(At, 1, 1); PG8_STAGE(PG8_SA(1, 0), a3, voffA);
            PG8_BAR; PG8_WAIT_L(0); PG8_MMA(1, 0, At, B0); PG8_BAR; PG8_SCHED;
            PG8_STAGE(PG8_SB(1, 1), b3 + hstep, voffB);
            PG8_WAIT_V(6); PG8_BAR; PG8_MMA(1, 1, At, B1); PG8_BAR;
            }
        }
        if constexpr (ALIGN_EPI) { if (wr == 0) PG8_BAR; }
        if constexpr (!Epi::AFTER_DRAIN) { if (cur.kind & 0x100) E.mid(acc, cur, wr, wc, fr, fq); else E(acc, cur, wr, wc, fr, fq); S.done(cur); }
        if (!has_next) break;
        {
#pragma unroll
        for (int a = 0; a < 2; ++a)
#pragma unroll
            for (int b = 0; b < 2; ++b)
#pragma unroll
                for (int m = 0; m < 4; ++m)
#pragma unroll
                    for (int n = 0; n < 2; ++n) acc[a][b][m][n] = (f32x4){0.f, 0.f, 0.f, 0.f};
        }
        cur = nxt; cA = nA; cB = nB; ++ui;
        if constexpr (ALIGN_EPI) { if (wr == 1) PG8_BAR; }
    }
    PG8_WAIT_V(0);
    if constexpr (!ALIGN_EPI) { if (wr == 0) PG8_BAR; }
    PG8_BAR;
    if constexpr (Epi::AFTER_DRAIN) { E.fused(acc, cur, wr, wc, fr, fq, lds, wid, lane); S.done(cur); }
#undef PG8_SA
#undef PG8_SB
#undef PG8_STAGE
#undef PG8_LDA
#undef PG8_LDB
#undef PG8_MMA
#undef PG8_WAIT_V
#undef PG8_WAIT_L
#undef PG8_BAR
#undef PG8_SCHED
}
}

#define LAS __attribute__((address_space(3)))
typedef unsigned short bf16;
typedef float f32x4 __attribute__((ext_vector_type(4)));
typedef float f32x2 __attribute__((ext_vector_type(2)));
typedef float f32x16 __attribute__((ext_vector_type(16)));
typedef short bf16x8 __attribute__((ext_vector_type(8)));
typedef short s16x4 __attribute__((ext_vector_type(4)));
typedef unsigned u32x4 __attribute__((ext_vector_type(4)));
typedef unsigned u32x2 __attribute__((ext_vector_type(2)));
typedef __bf16 bf16x2_t __attribute__((ext_vector_type(2)));

constexpr int DM = 1024, SEQ = 4096, NB = 8, M = NB * SEQ, FF = 4096;
constexpr int NWAVES = 8;
constexpr float EPS = 1e-6f, LOG2E = 1.4426950408889634f;
constexpr float C2_MLA = 0.10206207261596575f * LOG2E;
constexpr float C2_SWA = 0.125f * LOG2E;
constexpr int N_IN_PAD = 3840;

constexpr size_t MiB = 1u << 20;
constexpr size_t WS_CTL = 0, CTL_BYTES = 65536;
constexpr size_t WS_TAB = 1 * MiB, WS_PQ = 2 * MiB, WS_PKV = 2 * MiB + 512 * 1024, WS_PT = 3 * MiB, WS_PE = 5 * MiB, WS_RSTDE = 7 * MiB;
constexpr size_t WS_WIN = 8 * MiB, WS_WQKV = 16 * MiB, WS_WPP = 18 * MiB, WS_WUP = 19 * MiB, WS_WOUT = 23 * MiB, WS_W1 = 25 * MiB, WS_W2 = 33 * MiB, WS_WPG = 41 * MiB;
constexpr size_t WS_XN = 48 * MiB, WS_QA = 112 * MiB, WS_KVR = 128 * MiB, WS_KS = 144 * MiB, WS_VS = 152 * MiB, WS_KROPE = 160 * MiB, WS_ERAW = 112 * MiB;
constexpr size_t WS_T = 176 * MiB, WS_QR = 176 * MiB, WS_PB = 240 * MiB;
constexpr size_t WS_QN = 256 * MiB, WS_QS = 320 * MiB, WS_KN = 384 * MiB, WS_VM = 448 * MiB, WS_U = 256 * MiB, WS_END = 512 * MiB;

constexpr int LDS_BYTES = 132 * 1024;

struct Params { const float* in[20]; float* out; unsigned char* ws; int ph_lo, ph_hi; };

__device__ __forceinline__ unsigned cvtpk(float lo, float hi) { f32x2 v = {lo, hi}; bf16x2_t b = __builtin_convertvector(v, bf16x2_t); return __builtin_bit_cast(unsigned, b); }
__device__ __forceinline__ u32x2 pack4(f32x4 v) { u32x2 r; r.x = cvtpk(v[0], v[1]); r.y = cvtpk(v[2], v[3]); return r; }
__device__ __forceinline__ float bf2f(unsigned short h) { return __builtin_bit_cast(float, (unsigned)h << 16); }
__device__ __forceinline__ f32x4 unpack4(u32x2 w) { f32x4 r; r[0] = __builtin_bit_cast(float, w.x << 16); r[1] = __builtin_bit_cast(float, w.x & 0xffff0000u); r[2] = __builtin_bit_cast(float, w.y << 16); r[3] = __builtin_bit_cast(float, w.y & 0xffff0000u); return r; }
__device__ __forceinline__ float sigmoidf_(float x) { return __builtin_amdgcn_rcpf(1.0f + __builtin_amdgcn_exp2f(-x * LOG2E)); }
__device__ __forceinline__ f32x4 sigmoid4(f32x4 v) { f32x4 r; r[0] = sigmoidf_(v[0]); r[1] = sigmoidf_(v[1]); r[2] = sigmoidf_(v[2]); r[3] = sigmoidf_(v[3]); return r; }
__device__ __forceinline__ float wave_sum(float v) {
#pragma unroll
    for (int o = 1; o < 64; o <<= 1) v += __shfl_xor(v, o);
    return v;
}
__device__ __forceinline__ float dot4(f32x4 v) { return (v[0] * v[0] + v[1] * v[1]) + (v[2] * v[2] + v[3] * v[3]); }

struct Sched {
    int G, c, nseg, pairs;
    int nN[2], pmo[2], pno[2], start[3];
    __device__ __forceinline__ bool next(int i, pg8::Unit& u) const {
        const int ii = pairs ? (i >> 1) : i;
        const long L = (long)ii * G + c; if (L >= start[nseg]) return false;
        const int s = (nseg > 1 && L >= start[1]) ? 1 : 0; const int l = (int)L - start[s];
        const int nwg = start[s + 1] - start[s], q = nwg >> 3, id = (l & 7) * q + (l >> 3);
        const int nig = 8 * nN[s], gid = id / nig, r = id % nig;
        const int pm = gid * 8 + (r & 7), pn = r >> 3;
        u.pm = pmo[s] + pm; u.pn = pno[s] + pn; u.kind = u.pn;
        if (pairs) { if (i & 1) { u.pm += 128; u.pn += 4; u.kind = 0; } else u.kind = 0x100; }
        return true;
    }
    __device__ __forceinline__ void a_ready(const pg8::Unit&) const {}
    __device__ __forceinline__ void done(const pg8::Unit&) const {}
};
__device__ __forceinline__ Sched make_sched(int G, int c, int nN0) { Sched s; s.G = G; s.c = c; s.nseg = 1; s.pairs = 0; s.nN[0] = nN0; s.nN[1] = 1; s.pmo[0] = s.pmo[1] = 0; s.pno[0] = s.pno[1] = 0; s.start[0] = 0; s.start[1] = 128 * nN0; s.start[2] = s.start[1]; return s; }

typedef pg8::f32x4 A4;
#define EPI_ROWS(ai, m) for (int ai = 0; ai < 2; ++ai) _Pragma("unroll") for (int m = 0; m < 4; ++m)

struct EpiP1 {
    static constexpr bool PERM = false, AFTER_DRAIN = false;
    bf16 *qa, *kvr, *krope, *qs, *ks, *vs, *gates; float *part_q, *part_kv; const f32x2* tab;
    __device__ __forceinline__ void mid(const A4 (&acc)[2][2][4][2], const pg8::Unit& u, int wr, int wc, int fr, int fq) const {}
    __device__ __forceinline__ void operator()(const A4 (&acc)[2][2][4][2], const pg8::Unit& u, int wr, int wc, int fr, int fq) const {
        const int pn = u.kind, row0 = u.pm * 256 + wr * 64 + fr, cl0 = wc * 32 + fq * 4;
        if (pn <= 1) {
            bf16* dst = pn == 0 ? qa : kvr; float* part = pn == 0 ? part_q : part_kv;
#pragma unroll
            EPI_ROWS(ai, m) { const int row = row0 + ai * 128 + m * 16; float ss = 0.f;
#pragma unroll
                for (int bj = 0; bj < 2; ++bj)
#pragma unroll
                    for (int n = 0; n < 2; ++n) { const A4 v = acc[ai][bj][m][n]; if (pn == 0 || bj == 0) ss += dot4(v);
                        *(u32x2*)(dst + (size_t)row * 256 + bj * 128 + cl0 + n * 16) = pack4(v); }
                ss += __shfl_xor(ss, 16); ss += __shfl_xor(ss, 32);
                if (fq == 0) part[(size_t)row * 4 + wc] = ss;
                if (pn == 1 && wc == 0) {
                    const int pos = row & (SEQ - 1); const A4 x1 = acc[ai][1][m][0], x2 = acc[ai][1][m][1]; A4 o1, o2;
#pragma unroll
                    for (int e = 0; e < 4; ++e) { const f32x2 cs = tab[pos * 32 + 2 * (4 * fq + e)]; o1[e] = x1[e] * cs.x - x2[e] * cs.y; o2[e] = x2[e] * cs.x + x1[e] * cs.y; }
                    *(u32x2*)(krope + (size_t)row * 32 + 4 * fq) = pack4(o1); *(u32x2*)(krope + (size_t)row * 32 + 16 + 4 * fq) = pack4(o2);
                }
            }
        } else if (pn <= 6) {
            const int d1 = 16 * (wc & 1) + 4 * fq;
            f32x4 tb[2][2];
            { const int pos = row0 & (SEQ - 1); tb[0][0] = *(const f32x4*)(tab + pos * 32 + d1); tb[0][1] = *(const f32x4*)(tab + pos * 32 + d1 + 2); }
#pragma unroll
            for (int it = 0; it < 8; ++it) { const int ai = it >> 2, m = it & 3; const int row = row0 + ai * 128 + m * 16;
                if (it + 1 < 8) { const int pos = (row0 + ((it + 1) >> 2) * 128 + ((it + 1) & 3) * 16) & (SEQ - 1); tb[(it + 1) & 1][0] = *(const f32x4*)(tab + pos * 32 + d1); tb[(it + 1) & 1][1] = *(const f32x4*)(tab + pos * 32 + d1 + 2); }
                asm volatile("" ::: "memory");
                const f32x4 t0 = tb[it & 1][0], t1 = tb[it & 1][1];
                const float cc[4] = {t0[0], t0[2], t1[0], t1[2]}, sn[4] = {t0[1], t0[3], t1[1], t1[3]};
#pragma unroll
                for (int bj = 0; bj < 2; ++bj) {
                    if (pn == 6 && bj == 1) {
#pragma unroll
                        for (int n = 0; n < 2; ++n) *(u32x2*)(vs + (size_t)row * 128 + cl0 + n * 16) = pack4(acc[ai][1][m][n]);
                    } else {
                        const A4 x1 = acc[ai][bj][m][0], x2 = acc[ai][bj][m][1]; A4 o1, o2; const float sc = pn == 6 ? 1.0f : C2_SWA;
#pragma unroll
                        for (int e = 0; e < 4; ++e) { o1[e] = (x1[e] * cc[e] - x2[e] * sn[e]) * sc; o2[e] = (x2[e] * cc[e] + x1[e] * sn[e]) * sc; }
                        bf16* d = pn == 6 ? ks + (size_t)row * 128 + (wc >> 1) * 64 : qs + (size_t)row * 1024 + ((pn - 2) * 4 + bj * 2 + (wc >> 1)) * 64;
                        *(u32x2*)(d + d1) = pack4(o1); *(u32x2*)(d + 32 + d1) = pack4(o2);
                    }
                }
            }
        } else {
#pragma unroll
            EPI_ROWS(ai, m) { const int row = row0 + ai * 128 + m * 16;
#pragma unroll
                for (int bj = 0; bj < 2; ++bj)
#pragma unroll
                    for (int n = 0; n < 2; ++n) *(u32x2*)(gates + (size_t)row * 2048 + (pn - 7) * 256 + bj * 128 + cl0 + n * 16) = pack4(sigmoid4(acc[ai][bj][m][n]));
            }
        }
    }
};

struct EpiP2 {
    static constexpr bool PERM = false, AFTER_DRAIN = false;
    bf16 *qn, *qr, *kn, *vm; const float *part_q, *part_kv; const f32x2* tab;
    __device__ __forceinline__ void mid(const A4 (&acc)[2][2][4][2], const pg8::Unit& u, int wr, int wc, int fr, int fq) const {}
    __device__ __forceinline__ void operator()(const A4 (&acc)[2][2][4][2], const pg8::Unit& u, int wr, int wc, int fr, int fq) const {
        const int pn = u.kind, row0 = (u.pm & 127) * 256 + wr * 64 + fr, cl0 = wc * 32 + fq * 4;
        const bool isq = pn < 6, isrope = pn == 4 || pn == 5; const float* part = isq ? part_q : part_kv; const float invn = isq ? (1.0f / 256.0f) : (1.0f / 128.0f);
        f32x4 pp[2]; f32x4 tb[2][2];
        pp[0] = *(const f32x4*)(part + (size_t)row0 * 4);
        if (isrope) { const int pos = row0 & (SEQ - 1); tb[0][0] = *(const f32x4*)(tab + pos * 32 + 8 * fq); tb[0][1] = *(const f32x4*)(tab + pos * 32 + 8 * fq + 4); }
        f32x4 tc[2][2];
        if (isrope) { const int pos = row0 & (SEQ - 1); tc[0][0] = *(const f32x4*)(tab + pos * 32 + 8 * fq + 2); tc[0][1] = *(const f32x4*)(tab + pos * 32 + 8 * fq + 6); }
#pragma unroll
        for (int it = 0; it < 8; ++it) { const int ai = it >> 2, m = it & 3; const int row = row0 + ai * 128 + m * 16;
            if (it + 1 < 8) { const int rn = row0 + ((it + 1) >> 2) * 128 + ((it + 1) & 3) * 16; pp[(it + 1) & 1] = *(const f32x4*)(part + (size_t)rn * 4);
                if (isrope) { const int pos = rn & (SEQ - 1); tb[(it + 1) & 1][0] = *(const f32x4*)(tab + pos * 32 + 8 * fq); tb[(it + 1) & 1][1] = *(const f32x4*)(tab + pos * 32 + 8 * fq + 4);
                    tc[(it + 1) & 1][0] = *(const f32x4*)(tab + pos * 32 + 8 * fq + 2); tc[(it + 1) & 1][1] = *(const f32x4*)(tab + pos * 32 + 8 * fq + 6); } }
            asm volatile("" ::: "memory");
            const f32x4 p4 = pp[it & 1];
            float rs = __builtin_amdgcn_rsqf(((p4[0] + p4[1]) + (p4[2] + p4[3])) * invn + EPS);
            if (isq) rs *= C2_MLA;
            if (isrope) {
                const float cc[4] = {tb[it & 1][0][0], tc[it & 1][0][0], tb[it & 1][1][0], tc[it & 1][1][0]}, sn[4] = {tb[it & 1][0][1], tc[it & 1][0][1], tb[it & 1][1][1], tc[it & 1][1][1]};
#pragma unroll
                for (int bj = 0; bj < 2; ++bj) { const A4 x1 = acc[ai][bj][m][0], x2 = acc[ai][bj][m][1]; A4 o1, o2;
#pragma unroll
                    for (int e = 0; e < 4; ++e) { o1[e] = (x1[e] * cc[e] - x2[e] * sn[e]) * rs; o2[e] = (x2[e] * cc[e] + x1[e] * sn[e]) * rs; }
                    bf16* d = qr + (size_t)row * 512 + ((pn - 4) * 8 + bj * 4 + wc) * 32;
                    *(u32x2*)(d + 4 * fq) = pack4(o1); *(u32x2*)(d + 16 + 4 * fq) = pack4(o2); }
            } else {
                bf16* d = pn < 4 ? qn + (size_t)row * 1024 + pn * 256 : (pn < 10 ? kn + (size_t)row * 1024 + (pn - 6) * 256 : vm + (size_t)row * 1024 + (pn - 10) * 256);
#pragma unroll
                for (int bj = 0; bj < 2; ++bj)
#pragma unroll
                    for (int n = 0; n < 2; ++n) *(u32x2*)(d + bj * 128 + cl0 + n * 16) = pack4(acc[ai][bj][m][n] * rs);
            }
        }
    }
};

struct EpiP4 {
    static constexpr bool PERM = false, AFTER_DRAIN = false;
    const bf16* gates; bf16* y; bf16* ya;
    __device__ __forceinline__ void mid(const A4 (&acc)[2][2][4][2], const pg8::Unit& u, int wr, int wc, int fr, int fq) const {
        const int row0 = u.pm * 256 + wr * 64 + fr, col0 = u.pn * 256 + wc * 32 + fq * 4;
        u32x2 gq[2][2][2];
#define P4_LD(buf, it_) do { const bf16* g_ = gates + (size_t)(row0 + ((it_) >> 2) * 128 + ((it_) & 3) * 16) * 2048 + col0; \
        _Pragma("unroll") for (int bj = 0; bj < 2; ++bj) _Pragma("unroll") for (int n = 0; n < 2; ++n) gq[buf][bj][n] = *(const u32x2*)(g_ + bj * 128 + n * 16); } while (0)
        P4_LD(0, 0);
#pragma unroll
        for (int it = 0; it < 8; ++it) { const int ai = it >> 2, m = it & 3; const size_t row = (size_t)(row0 + ai * 128 + m * 16);
            if (it + 1 < 8) P4_LD((it + 1) & 1, it + 1);
            asm volatile("" ::: "memory");
#pragma unroll
            for (int bj = 0; bj < 2; ++bj)
#pragma unroll
                for (int n = 0; n < 2; ++n) *(u32x2*)(ya + row * 1024 + col0 + bj * 128 + n * 16) = pack4(acc[ai][bj][m][n] * unpack4(gq[it & 1][bj][n]));
        }
#undef P4_LD
    }
    __device__ __forceinline__ void operator()(const A4 (&acc)[2][2][4][2], const pg8::Unit& u, int wr, int wc, int fr, int fq) const {
        const int row0 = (u.pm - 128) * 256 + wr * 64 + fr, col0 = (u.pn - 4) * 256 + wc * 32 + fq * 4;
        u32x2 gq[2][2][2], yq[2][2][2];
#define P4_LD(buf, it_) do { const size_t r_ = (size_t)(row0 + ((it_) >> 2) * 128 + ((it_) & 3) * 16); const bf16* g_ = gates + r_ * 2048 + 1024 + col0; const bf16* y_ = ya + r_ * 1024 + col0; \
        _Pragma("unroll") for (int bj = 0; bj < 2; ++bj) _Pragma("unroll") for (int n = 0; n < 2; ++n) { gq[buf][bj][n] = *(const u32x2*)(g_ + bj * 128 + n * 16); yq[buf][bj][n] = *(const u32x2*)(y_ + bj * 128 + n * 16); } } while (0)
        P4_LD(0, 0);
#pragma unroll
        for (int it = 0; it < 8; ++it) { const int ai = it >> 2, m = it & 3; const size_t row = (size_t)(row0 + ai * 128 + m * 16);
            if (it + 1 < 8) P4_LD((it + 1) & 1, it + 1);
            asm volatile("" ::: "memory");
#pragma unroll
            for (int bj = 0; bj < 2; ++bj)
#pragma unroll
                for (int n = 0; n < 2; ++n) *(u32x2*)(y + row * 1024 + col0 + bj * 128 + n * 16) = pack4(unpack4(yq[it & 1][bj][n]) + acc[ai][bj][m][n] * unpack4(gq[it & 1][bj][n]));
        }
#undef P4_LD
    }
};

struct EpiT {
    static constexpr bool PERM = false, AFTER_DRAIN = false;
    bf16* o; float* part;
    __device__ __forceinline__ void mid(const A4 (&acc)[2][2][4][2], const pg8::Unit& u, int wr, int wc, int fr, int fq) const {}
    __device__ __forceinline__ void operator()(const A4 (&acc)[2][2][4][2], const pg8::Unit& u, int wr, int wc, int fr, int fq) const {
        const int row0 = u.pm * 256 + wr * 64 + fr, col0 = u.pn * 256 + wc * 32 + fq * 4;
#pragma unroll
        EPI_ROWS(ai, m) { const size_t row = (size_t)(row0 + ai * 128 + m * 16); float ss = 0.f;
#pragma unroll
            for (int bj = 0; bj < 2; ++bj)
#pragma unroll
                for (int n = 0; n < 2; ++n) { const A4 v = acc[ai][bj][m][n]; ss += dot4(v); *(u32x2*)(o + row * 1024 + col0 + bj * 128 + n * 16) = pack4(v); }
            ss += __shfl_xor(ss, 16); ss += __shfl_xor(ss, 32);
            if (fq == 0) part[row * 16 + u.pn * 4 + wc] = ss;
        }
    }
};

struct EpiRelu2 {
    static constexpr bool PERM = false, AFTER_DRAIN = false;
    bf16* o;
    __device__ __forceinline__ void mid(const A4 (&acc)[2][2][4][2], const pg8::Unit& u, int wr, int wc, int fr, int fq) const {}
    __device__ __forceinline__ void operator()(const A4 (&acc)[2][2][4][2], const pg8::Unit& u, int wr, int wc, int fr, int fq) const {
        const int row0 = u.pm * 256 + wr * 64 + fr, col0 = u.pn * 256 + wc * 32 + fq * 4;
#pragma unroll
        EPI_ROWS(ai, m) { const size_t row = (size_t)(row0 + ai * 128 + m * 16);
#pragma unroll
            for (int bj = 0; bj < 2; ++bj)
#pragma unroll
                for (int n = 0; n < 2; ++n) { A4 v = acc[ai][bj][m][n];
#pragma unroll
                    for (int e = 0; e < 4; ++e) { const float r = __builtin_fmaxf(v[e], 0.f); v[e] = r * r; }
                    *(u32x2*)(o + row * FF + col0 + bj * 128 + n * 16) = pack4(v); }
        }
    }
};

struct EpiOut {
    static constexpr bool PERM = false, AFTER_DRAIN = false;
    float* out; const bf16* eraw; const float* rstd_e; const float* gple;
    __device__ __forceinline__ void mid(const A4 (&acc)[2][2][4][2], const pg8::Unit& u, int wr, int wc, int fr, int fq) const {}
    __device__ __forceinline__ void operator()(const A4 (&acc)[2][2][4][2], const pg8::Unit& u, int wr, int wc, int fr, int fq) const {
        const int row0 = u.pm * 256 + wr * 64 + fr, col0 = u.pn * 256 + wc * 32 + fq * 4;
        f32x4 gv[2][2];
#pragma unroll
        for (int bj = 0; bj < 2; ++bj)
#pragma unroll
            for (int n = 0; n < 2; ++n) gv[bj][n] = *(const f32x4*)(gple + col0 + bj * 128 + n * 16);
        f32x4 xq[2][2][2]; u32x2 eq[2][2][2]; float rq[2];
#define PO_LD(buf, it_) do { const size_t r_ = (size_t)(row0 + ((it_) >> 2) * 128 + ((it_) & 3) * 16); rq[buf] = rstd_e[r_]; \
        _Pragma("unroll") for (int bj = 0; bj < 2; ++bj) _Pragma("unroll") for (int n = 0; n < 2; ++n) { const size_t off_ = r_ * 1024 + col0 + bj * 128 + n * 16; xq[buf][bj][n] = *(const f32x4*)(out + off_); eq[buf][bj][n] = *(const u32x2*)(eraw + off_); } } while (0)
        PO_LD(0, 0);
#pragma unroll
        for (int it = 0; it < 8; ++it) { const int ai = it >> 2, m = it & 3; const size_t row = (size_t)(row0 + ai * 128 + m * 16);
            if (it + 1 < 8) PO_LD((it + 1) & 1, it + 1);
            asm volatile("" ::: "memory");
#pragma unroll
            for (int bj = 0; bj < 2; ++bj)
#pragma unroll
                for (int n = 0; n < 2; ++n) { const size_t off = row * 1024 + col0 + bj * 128 + n * 16;
                    *(f32x4*)(out + off) = xq[it & 1][bj][n] + sigmoid4(acc[ai][bj][m][n]) * (unpack4(eq[it & 1][bj][n]) * rq[it & 1] * gv[bj][n]); }
        }
#undef PO_LD
    }
};

namespace att {
constexpr int KP = 208, VP = 192, KBUF = 64 * KP, VBUF = 64 * VP, STAGE = KBUF + VBUF;
__device__ __forceinline__ float max3f(float a, float b, float c) { float r; asm("v_max3_f32 %0, %1, %2, %3" : "=v"(r) : "v"(a), "v"(b), "v"(c)); return r; }
__device__ __forceinline__ float max2f(float a, float b) { float r; asm("v_max_f32_e32 %0, %1, %2" : "=v"(r) : "v"(a), "v"(b)); return r; }
__device__ __forceinline__ float xhalf_max(float v) { auto rr = __builtin_amdgcn_permlane32_swap(__float_as_uint(v), __float_as_uint(v), false, false); return max2f(__uint_as_float(rr[0]), __uint_as_float(rr[1])); }
__device__ __forceinline__ float xhalf_sum(float v) { auto rr = __builtin_amdgcn_permlane32_swap(__float_as_uint(v), __float_as_uint(v), false, false); return __uint_as_float(rr[0]) + __uint_as_float(rr[1]); }
__device__ __forceinline__ s16x4 vtr(const LAS unsigned char* p) { return __builtin_bit_cast(s16x4, __builtin_amdgcn_ds_read_tr16_b64_v4i16((LAS s16x4*)p)); }

template <int MODE>
__device__ __forceinline__ void unit(LAS unsigned char* lds, const bf16* __restrict__ Qa, const bf16* __restrict__ Qb, const bf16* __restrict__ Ka, const bf16* __restrict__ Kb, const bf16* __restrict__ Va, bf16* O,
                                     const float* __restrict__ sinks, int b, int h, int blk, int hp) {
    constexpr int NC = MODE == 0 ? 6 : 4;
    const int tid = threadIdx.x, lane = tid & 63, w = __builtin_amdgcn_readfirstlane(tid >> 6), l31 = lane & 31, hi = lane >> 5;
    int hq, qpos0w, t_beg, t_end, kpos_base; size_t krow_base; int kvpitch, kvcol;
    if (MODE == 0) { hq = h; qpos0w = blk * 256 + w * 32; t_beg = 0; t_end = 4 * blk + 4; kpos_base = 0; kvpitch = 1024; kvcol = h * 64; }
    else { hq = 8 * h + 2 * hp + (w >> 2); qpos0w = blk * 128 + (w & 3) * 32; t_beg = blk == 0 ? 2 : 0; t_end = 4; kpos_base = (blk - 1) * 128; kvpitch = 128; kvcol = h * 64; }
    const size_t seq0 = (size_t)b * SEQ;
    const int qpos = qpos0w + l31;
    bf16x8 qf[NC];
    { const bf16* qp = Qa + (seq0 + qpos) * 1024 + hq * 64 + hi * 8;
#pragma unroll
      for (int c = 0; c < 4; ++c) qf[c] = *(const bf16x8*)(qp + c * 16);
      if (MODE == 0) { const bf16* qp2 = Qb + (seq0 + qpos) * 512 + hq * 32 + hi * 8;
#pragma unroll
          for (int c = 4; c < NC; ++c) qf[c] = *(const bf16x8*)(qp2 + (c - 4) * 16); } }
    const int skey = tid >> 3, sch = tid & 7;
    const bf16* kg = Ka + ((long)seq0 + kpos_base + skey) * kvpitch + kvcol + sch * 8;
    const bf16* vg = Va + ((long)seq0 + kpos_base + skey) * kvpitch + kvcol + sch * 8;
    const bf16* rg = MODE == 0 ? Kb + (seq0 + (tid >> 2)) * 32 + (tid & 3) * 8 : nullptr;
    const int kw_off = skey * KP + sch * 16, vw_off = KBUF + skey * VP + sch * 16, rw_off = (tid >> 2) * KP + 128 + (tid & 3) * 16;
    const int pi = (l31 & 0x13) | ((l31 & 4) << 1) | ((l31 & 8) >> 1);
    const int kr_off = pi * KP + hi * 16;
    const int vr_off = KBUF + (8 * hi + ((lane & 15) >> 2)) * VP + (16 * ((lane >> 4) & 1) + 4 * (lane & 3)) * 2;
    float m_run, l_run;
    if (MODE == 0) { m_run = -1e30f; l_run = 0.f; } else { m_run = sinks[hq] * LOG2E; l_run = hi == 0 ? 1.f : 0.f; }
    f32x16 o0 = {}, o1 = {};
    u32x4 kreg, vreg, rreg = {};
    kreg = *(const u32x4*)(kg + (long)t_beg * 64 * kvpitch); vreg = *(const u32x4*)(vg + (long)t_beg * 64 * kvpitch);
    if (MODE == 0 && tid < 256) rreg = *(const u32x4*)(rg + (size_t)t_beg * 64 * 32);
    *(LAS u32x4*)(lds + kw_off) = kreg; *(LAS u32x4*)(lds + vw_off) = vreg;
    if (MODE == 0 && tid < 256) *(LAS u32x4*)(lds + rw_off) = rreg;
    __syncthreads();
    for (int t = t_beg; t < t_end; ++t) {
        const int st = ((t - t_beg) & 1) * STAGE, sn = STAGE - st;
        const bool more = t + 1 < t_end;
        if (more) { kreg = *(const u32x4*)(kg + (long)(t + 1) * 64 * kvpitch); vreg = *(const u32x4*)(vg + (long)(t + 1) * 64 * kvpitch);
            if (MODE == 0 && tid < 256) rreg = *(const u32x4*)(rg + (size_t)(t + 1) * 64 * 32); }
        const int kp0 = kpos_base + t * 64;
        bool doit, domask;
        if (MODE == 0) { doit = kp0 <= qpos0w + 31; domask = kp0 + 63 > qpos0w; }
        else { const int a = w & 3; doit = a < 2 ? (t <= 2) : (t >= 1); domask = true; }
        if (doit) {
            const LAS unsigned char* kb = lds + st + kr_off; const LAS unsigned char* vb = lds + st + vr_off;
            f32x16 s0 = {}, s1 = {};
#pragma unroll
            for (int c = 0; c < NC; ++c) { const bf16x8 k0 = *(const LAS bf16x8*)(kb + c * 32), k1 = *(const LAS bf16x8*)(kb + 32 * KP + c * 32);
                s0 = __builtin_amdgcn_mfma_f32_32x32x16_bf16(k0, qf[c], s0, 0, 0, 0); s1 = __builtin_amdgcn_mfma_f32_32x32x16_bf16(k1, qf[c], s1, 0, 0, 0); }
            if (domask) {
#pragma unroll
                for (int r = 0; r < 16; ++r) { const int kk = kp0 + 16 * (r >> 3) + 8 * hi + (r & 7); const int rel0 = qpos - kk, rel1 = rel0 - 32;
                    const bool ok0 = MODE == 0 ? rel0 >= 0 : (rel0 >= 0 && rel0 < 128), ok1 = MODE == 0 ? rel1 >= 0 : (rel1 >= 0 && rel1 < 128);
                    s0[r] = ok0 ? s0[r] : -1e30f; s1[r] = ok1 ? s1[r] : -1e30f; }
            }
            float mx = max2f(s0[0], s1[0]);
#pragma unroll
            for (int r = 1; r < 16; ++r) mx = max3f(mx, s0[r], s1[r]);
            mx = xhalf_max(mx);
            const float mnew = max2f(m_run, mx), alpha = __builtin_amdgcn_exp2f(m_run - mnew); m_run = mnew;
            f32x2 ps2 = {0.f, 0.f}; const f32x2 mn2 = {mnew, mnew};
#pragma unroll
            for (int r = 0; r < 16; r += 2) { f32x2 a2 = (f32x2){s0[r], s0[r + 1]} - mn2, b2 = (f32x2){s1[r], s1[r + 1]} - mn2;
                a2.x = __builtin_amdgcn_exp2f(a2.x); a2.y = __builtin_amdgcn_exp2f(a2.y); b2.x = __builtin_amdgcn_exp2f(b2.x); b2.y = __builtin_amdgcn_exp2f(b2.y);
                ps2 += a2; ps2 += b2; s0[r] = a2.x; s0[r + 1] = a2.y; s1[r] = b2.x; s1[r + 1] = b2.y; }
            l_run = l_run * alpha + (ps2.x + ps2.y);
            if (__builtin_amdgcn_ballot_w64(alpha != 1.0f) != 0ull) {
                const f32x2 al2 = {alpha, alpha};
#pragma unroll
                for (int r = 0; r < 16; r += 2) { f32x2 x = (f32x2){o0[r], o0[r + 1]} * al2, y = (f32x2){o1[r], o1[r + 1]} * al2; o0[r] = x.x; o0[r + 1] = x.y; o1[r] = y.x; o1[r + 1] = y.y; }
            }
            bf16x8 pk[4];
#pragma unroll
            for (int j = 0; j < 2; ++j) { u32x4 a, c2;
                a.x = cvtpk(s0[8 * j], s0[8 * j + 1]); a.y = cvtpk(s0[8 * j + 2], s0[8 * j + 3]); a.z = cvtpk(s0[8 * j + 4], s0[8 * j + 5]); a.w = cvtpk(s0[8 * j + 6], s0[8 * j + 7]);
                c2.x = cvtpk(s1[8 * j], s1[8 * j + 1]); c2.y = cvtpk(s1[8 * j + 2], s1[8 * j + 3]); c2.z = cvtpk(s1[8 * j + 4], s1[8 * j + 5]); c2.w = cvtpk(s1[8 * j + 6], s1[8 * j + 7]);
                pk[j] = __builtin_bit_cast(bf16x8, a); pk[2 + j] = __builtin_bit_cast(bf16x8, c2); }
#pragma unroll
            for (int j = 0; j < 4; ++j) {
                const s16x4 a0 = vtr(vb + (16 * j) * VP), a1 = vtr(vb + (16 * j + 4) * VP), b0 = vtr(vb + (16 * j) * VP + 64), b1 = vtr(vb + (16 * j + 4) * VP + 64);
                const bf16x8 va = {a0[0], a0[1], a0[2], a0[3], a1[0], a1[1], a1[2], a1[3]}, vb8 = {b0[0], b0[1], b0[2], b0[3], b1[0], b1[1], b1[2], b1[3]};
                o0 = __builtin_amdgcn_mfma_f32_32x32x16_bf16(va, pk[j], o0, 0, 0, 0); o1 = __builtin_amdgcn_mfma_f32_32x32x16_bf16(vb8, pk[j], o1, 0, 0, 0);
            }
        }
        if (more) { *(LAS u32x4*)(lds + sn + kw_off) = kreg; *(LAS u32x4*)(lds + sn + vw_off) = vreg;
            if (MODE == 0 && tid < 256) *(LAS u32x4*)(lds + sn + rw_off) = rreg; }
        __syncthreads();
    }
    const float inv = __builtin_amdgcn_rcpf(xhalf_sum(l_run));
    bf16* op = O + (seq0 + qpos) * 1024 + hq * 64 + 4 * hi;
#pragma unroll
    for (int g = 0; g < 4; ++g) { u32x2 w0, w1;
        w0.x = cvtpk(o0[4 * g] * inv, o0[4 * g + 1] * inv); w0.y = cvtpk(o0[4 * g + 2] * inv, o0[4 * g + 3] * inv);
        w1.x = cvtpk(o1[4 * g] * inv, o1[4 * g + 1] * inv); w1.y = cvtpk(o1[4 * g + 2] * inv, o1[4 * g + 3] * inv);
        *(u32x2*)(op + 8 * g) = w0; *(u32x2*)(op + 32 + 8 * g) = w1; }
}
}


__device__ __forceinline__ void swa_unit(LAS unsigned char* lds, const bf16* __restrict__ Qs, const bf16* __restrict__ Ks, const bf16* __restrict__ Vs, bf16* O, const float* __restrict__ sinks, int b, int g, int n) {
    using namespace att;
    constexpr int STG = KBUF + VBUF;
    const int tid = threadIdx.x, lane = tid & 63, w = __builtin_amdgcn_readfirstlane(tid >> 6), l31 = lane & 31, hi = lane >> 5;
    const int tb = n == 0 ? 2 : 0, kpos_base = (n - 1) * 128; const long seq0 = (long)b * SEQ;
    { const int skey = tid >> 3, sch = tid & 7; u32x4 kr[4], vr[4];
#pragma unroll
      for (int t = 0; t < 4; ++t) if (t >= tb) { const long off = (seq0 + kpos_base + t * 64 + skey) * 128 + g * 64 + sch * 8; kr[t] = *(const u32x4*)(Ks + off); vr[t] = *(const u32x4*)(Vs + off); }
#pragma unroll
      for (int t = 0; t < 4; ++t) if (t >= tb) { *(LAS u32x4*)(lds + t * STG + skey * KP + sch * 16) = kr[t]; *(LAS u32x4*)(lds + t * STG + KBUF + skey * VP + sch * 16) = vr[t]; } }
    __syncthreads();
    const int pi = (l31 & 0x13) | ((l31 & 4) << 1) | ((l31 & 8) >> 1);
    const int kr_k = pi * KP + hi * 16;
    const int vr_v = KBUF + (8 * hi + ((lane & 15) >> 2)) * VP + (16 * ((lane >> 4) & 1) + 4 * (lane & 3)) * 2;
    const int a = w & 3, qpos = n * 128 + a * 32 + l31;
    const int t0 = a < 2 ? tb : (tb > 1 ? tb : 1), t1 = a < 2 ? 2 : 3;
#pragma unroll 1
    for (int hp = 0; hp < 4; ++hp) {
        const int hq = 8 * g + 2 * hp + (w >> 2);
        bf16x8 qf[4];
        { const bf16* qp = Qs + (seq0 + qpos) * 1024 + hq * 64 + hi * 8;
#pragma unroll
          for (int c = 0; c < 4; ++c) qf[c] = *(const bf16x8*)(qp + c * 16); }
        float m_run = sinks[hq] * LOG2E, l_run = hi == 0 ? 1.f : 0.f;
        f32x16 o0 = {}, o1 = {};
#pragma unroll 1
        for (int t = t0; t <= t1; ++t) {
            const LAS unsigned char* kb = lds + t * STG + kr_k; const LAS unsigned char* vb = lds + t * STG + vr_v;
            f32x16 s0 = {}, s1 = {};
#pragma unroll
            for (int c = 0; c < 4; ++c) { const bf16x8 k0 = *(const LAS bf16x8*)(kb + c * 32), k1 = *(const LAS bf16x8*)(kb + 32 * KP + c * 32);
                s0 = __builtin_amdgcn_mfma_f32_32x32x16_bf16(k0, qf[c], s0, 0, 0, 0); s1 = __builtin_amdgcn_mfma_f32_32x32x16_bf16(k1, qf[c], s1, 0, 0, 0); }
            const int kp0 = kpos_base + t * 64;
#pragma unroll
            for (int r = 0; r < 16; ++r) { const int rel0 = qpos - (kp0 + 16 * (r >> 3) + 8 * hi + (r & 7)), rel1 = rel0 - 32;
                s0[r] = (rel0 >= 0 && rel0 < 128) ? s0[r] : -1e30f; s1[r] = (rel1 >= 0 && rel1 < 128) ? s1[r] : -1e30f; }
            float mx = max2f(s0[0], s1[0]);
#pragma unroll
            for (int r = 1; r < 16; ++r) mx = max3f(mx, s0[r], s1[r]);
            mx = xhalf_max(mx);
            const float mnew = max2f(m_run, mx), alpha = __builtin_amdgcn_exp2f(m_run - mnew); m_run = mnew;
            float ps = 0.f;
#pragma unroll
            for (int r = 0; r < 16; ++r) { s0[r] = __builtin_amdgcn_exp2f(s0[r] - mnew); s1[r] = __builtin_amdgcn_exp2f(s1[r] - mnew); ps += s0[r] + s1[r]; }
            l_run = l_run * alpha + ps;
#pragma unroll
            for (int r = 0; r < 16; ++r) { o0[r] *= alpha; o1[r] *= alpha; }
            bf16x8 pk[4];
#pragma unroll
            for (int j = 0; j < 2; ++j) { u32x4 a_, c_;
                a_.x = cvtpk(s0[8 * j], s0[8 * j + 1]); a_.y = cvtpk(s0[8 * j + 2], s0[8 * j + 3]); a_.z = cvtpk(s0[8 * j + 4], s0[8 * j + 5]); a_.w = cvtpk(s0[8 * j + 6], s0[8 * j + 7]);
                c_.x = cvtpk(s1[8 * j], s1[8 * j + 1]); c_.y = cvtpk(s1[8 * j + 2], s1[8 * j + 3]); c_.z = cvtpk(s1[8 * j + 4], s1[8 * j + 5]); c_.w = cvtpk(s1[8 * j + 6], s1[8 * j + 7]);
                pk[j] = __builtin_bit_cast(bf16x8, a_); pk[2 + j] = __builtin_bit_cast(bf16x8, c_); }
#pragma unroll
            for (int j = 0; j < 4; ++j) {
                const s16x4 a0 = vtr(vb + (16 * j) * VP), a1 = vtr(vb + (16 * j + 4) * VP), b0 = vtr(vb + (16 * j) * VP + 64), b1 = vtr(vb + (16 * j + 4) * VP + 64);
                const bf16x8 va = {a0[0], a0[1], a0[2], a0[3], a1[0], a1[1], a1[2], a1[3]}, vb8 = {b0[0], b0[1], b0[2], b0[3], b1[0], b1[1], b1[2], b1[3]};
                o0 = __builtin_amdgcn_mfma_f32_32x32x16_bf16(va, pk[j], o0, 0, 0, 0); o1 = __builtin_amdgcn_mfma_f32_32x32x16_bf16(vb8, pk[j], o1, 0, 0, 0); }
        }
        const float inv = __builtin_amdgcn_rcpf(xhalf_sum(l_run));
        bf16* op = O + (seq0 + qpos) * 1024 + hq * 64 + 4 * hi;
#pragma unroll
        for (int q4 = 0; q4 < 4; ++q4) { u32x2 w0, w1;
            w0.x = cvtpk(o0[4 * q4] * inv, o0[4 * q4 + 1] * inv); w0.y = cvtpk(o0[4 * q4 + 2] * inv, o0[4 * q4 + 3] * inv);
            w1.x = cvtpk(o1[4 * q4] * inv, o1[4 * q4 + 1] * inv); w1.y = cvtpk(o1[4 * q4 + 2] * inv, o1[4 * q4 + 3] * inv);
            *(u32x2*)(op + 8 * q4) = w0; *(u32x2*)(op + 32 + 8 * q4) = w1; }
    }
    __syncthreads();
}

__device__ __forceinline__ int swap45(int w) { return (w & 15) | (((w >> 4) & 1) << 5) | (((w >> 5) & 1) << 4); }
__device__ __forceinline__ int src_col(int which, int r) {
    switch (which) {
    case 0:
        if (r < 256) return r;
        if (r < 512) { const int p = r - 256; return p < 160 ? 256 + p : -1; }
        if (r < 1536) { const int p = r - 512; return 416 + (p & ~63) + swap45(p & 63); }
        if (r < 1792) { const int p = r - 1536; return p < 128 ? 1440 + (p & ~63) + swap45(p & 63) : 1568 + (p - 128); }
        return 1696 + (r - 1792);
    case 1:
        if (r < 1024) return (r >> 6) * 96 + (r & 63);
        { const int p = r - 1024; return (p >> 5) * 96 + 64 + (p & 31); }
    case 2:
        if (r < 1024) return (r >> 6) * 128 + (r & 63);
        { const int p = r - 1024; return (p >> 6) * 128 + 64 + (p & 63); }
    default: return r;
    }
}
__device__ __forceinline__ void transpose_item(const float* __restrict__ W, int Ks, int N, bf16* WT, int R, int Kd, int which, const float* __restrict__ gs, LAS float* scr, int item, int lane) {
    const int nblk = R / 32, kb = item / nblk, nb = item % nblk, k0 = 64 * kb, n0 = 32 * nb;
    const int sc = src_col(which, n0 + (lane & 31));
    float vals[32];
#pragma unroll
    for (int i = 0; i < 32; ++i) { const int k = k0 + 2 * i + (lane >> 5); float v = 0.f;
        if (sc >= 0 && k < Ks) { v = W[(size_t)k * N + sc]; if (gs) v *= gs[k]; }
        vals[i] = v; }
#pragma unroll
    for (int i = 0; i < 32; ++i) scr[(2 * i + (lane >> 5)) * 33 + (lane & 31)] = vals[i];
    asm volatile("s_waitcnt lgkmcnt(0)" ::: "memory");
    const int c = lane & 7;
#pragma unroll
    for (int j = 0; j < 4; ++j) { const int n = (lane >> 3) + 8 * j; const LAS float* s = scr + (8 * c) * 33 + n;
        u32x4 o; o.x = cvtpk(s[0 * 33], s[1 * 33]); o.y = cvtpk(s[2 * 33], s[3 * 33]); o.z = cvtpk(s[4 * 33], s[5 * 33]); o.w = cvtpk(s[6 * 33], s[7 * 33]);
        *(u32x4*)(WT + (size_t)(n0 + n) * Kd + k0 + 8 * c) = o; }
    asm volatile("s_waitcnt lgkmcnt(0)" ::: "memory");
}


__device__ __forceinline__ float sum16(const float* p) { const f32x4* q = (const f32x4*)p; const f32x4 a = q[0], b = q[1], c = q[2], d = q[3];
    return (((a[0] + a[1]) + (a[2] + a[3])) + ((b[0] + b[1]) + (b[2] + b[3]))) + (((c[0] + c[1]) + (c[2] + c[3])) + ((d[0] + d[1]) + (d[2] + d[3]))); }
template <bool FIRST>
__device__ __forceinline__ void rowpass(const float* xin, float* xo, const bf16* T, const float* part_t, const float* gpost, const float* gpre, bf16* XN, const float* part_e, float* rstd_e, int gw, int NGW, int lane) {
    for (int row0 = gw; row0 < M; row0 += 4 * NGW) {
        f32x4 xv[4][4]; u32x4 tw[4][2]; float rt[4];
#pragma unroll
        for (int r2 = 0; r2 < 4; ++r2) { const size_t row = (size_t)(row0 + r2 * NGW);
#pragma unroll
            for (int j = 0; j < 2; ++j) { const int col = 512 * j + 8 * lane; tw[r2][j] = *(const u32x4*)(T + row * DM + col);
                xv[r2][2 * j] = *(const f32x4*)(xin + row * DM + col); xv[r2][2 * j + 1] = *(const f32x4*)(xin + row * DM + col + 4); }
            rt[r2] = __builtin_amdgcn_rsqf(sum16(part_t + row * 16) * (1.0f / DM) + EPS); }
#pragma unroll
        for (int r2 = 0; r2 < 4; ++r2) { const size_t row = (size_t)(row0 + r2 * NGW); float ss = 0.f;
#pragma unroll
            for (int j = 0; j < 2; ++j) { const int col = 512 * j + 8 * lane;
                const f32x4 ta = unpack4((u32x2){tw[r2][j].x, tw[r2][j].y}), tb = unpack4((u32x2){tw[r2][j].z, tw[r2][j].w});
                const f32x4 ga = *(const f32x4*)(gpost + col), gb = *(const f32x4*)(gpost + col + 4);
                xv[r2][2 * j] += ta * rt[r2] * ga; xv[r2][2 * j + 1] += tb * rt[r2] * gb; ss += dot4(xv[r2][2 * j]) + dot4(xv[r2][2 * j + 1]);
                *(f32x4*)(xo + row * DM + col) = xv[r2][2 * j]; *(f32x4*)(xo + row * DM + col + 4) = xv[r2][2 * j + 1]; }
            if (FIRST) { const float r1 = __builtin_amdgcn_rsqf(wave_sum(ss) * (1.0f / DM) + EPS);
#pragma unroll
                for (int j = 0; j < 2; ++j) { const int col = 512 * j + 8 * lane; const f32x4 ga = *(const f32x4*)(gpre + col), gb = *(const f32x4*)(gpre + col + 4);
                    const u32x2 a = pack4(xv[r2][2 * j] * r1 * ga), b2 = pack4(xv[r2][2 * j + 1] * r1 * gb); *(u32x4*)(XN + row * DM + col) = (u32x4){a.x, a.y, b2.x, b2.y}; }
            } else {
#pragma unroll
                for (int j = 0; j < 2; ++j) { const int col = 512 * j + 8 * lane; const u32x2 a = pack4(xv[r2][2 * j]), b2 = pack4(xv[r2][2 * j + 1]); *(u32x4*)(XN + row * DM + col) = (u32x4){a.x, a.y, b2.x, b2.y}; }
                if (lane == 0) rstd_e[row] = __builtin_amdgcn_rsqf(sum16(part_e + row * 16) * (1.0f / DM) + EPS); }
        }
    }
}

#define XB_TMO      128
#define XB_XCNT(j)  (256  + 64 * (j))
#define XB_XSUB(j)  (1280 + 64 * (j))
#define XB_XGEN(j)  (2304 + 64 * (j))
#define XB_TOP      3328
#define XB_TOPGEN   3392
#define XCD_BAR_WORDS 3456
#define XB_SPIN_CAP (1u << 18)

__device__ __forceinline__ unsigned xb_ld(unsigned* p)              { return __hip_atomic_load(p, __ATOMIC_RELAXED, __HIP_MEMORY_SCOPE_AGENT); }
__device__ __forceinline__ unsigned xb_add(unsigned* p, unsigned v) { return __hip_atomic_fetch_add(p, v, __ATOMIC_RELAXED, __HIP_MEMORY_SCOPE_AGENT); }
__device__ __forceinline__ unsigned xb_xcc_id() { return (unsigned)__builtin_amdgcn_s_getreg((3 << 11) | 20) & 0xFu; }
#define XB_SPIN(cond, bar) do { unsigned _sp = 0; while (cond) { __builtin_amdgcn_s_sleep(1); \
    if ((++_sp & 255u) == 0u) { if (xb_ld(&(bar)[XB_TMO])) break; if (_sp > XB_SPIN_CAP) { atomicAdd(&(bar)[XB_TMO], 1u); break; } } } } while (0)

struct XcdBarrier {
    unsigned* bar; unsigned x;
    volatile LAS unsigned* st;
};

__device__ __forceinline__ XcdBarrier xcd_barrier_post(unsigned* bar, volatile LAS unsigned* st) {
    XcdBarrier b; b.bar = bar; b.x = xb_xcc_id(); b.st = st;
    if (threadIdx.x == 0) (void)xb_add(&bar[XB_XCNT(b.x)], 1u);
    return b;
}
__device__ __forceinline__ void xcd_barrier_complete(unsigned* bar, unsigned x, unsigned& nloc, unsigned& nx) {
    const unsigned G = gridDim.x * gridDim.y * gridDim.z;
    unsigned sum, cnt, mine, sp = 0u;
    for (;;) {
        sum = 0u; cnt = 0u; mine = 0u;
#pragma unroll
        for (unsigned j = 0; j < 16; ++j) { const unsigned c = xb_ld(&bar[XB_XCNT(j)]); sum += c; cnt += (c > 0u) ? 1u : 0u; mine = (j == x) ? c : mine; }
        if (sum == G) break;
        __builtin_amdgcn_s_sleep(1);
        if ((++sp & 255u) == 0u) { if (xb_ld(&bar[XB_TMO])) break; if (sp > XB_SPIN_CAP) { atomicAdd(&bar[XB_TMO], 1u); break; } }
    }
    nloc = mine > 0u ? mine : 1u; nx = cnt > 0u ? cnt : 1u;
}

__device__ __forceinline__ void xcd_barrier(const XcdBarrier& b) {
    asm volatile("s_waitcnt vmcnt(0)" ::: "memory");
    __syncthreads();
    if (threadIdx.x == 0) {
        unsigned* bar = b.bar;
        __builtin_amdgcn_s_waitcnt(0);
        unsigned nloc = b.st[0], nx = b.st[1];
        if (nloc == 0u) { xcd_barrier_complete(bar, b.x, nloc, nx); b.st[0] = nloc; b.st[1] = nx; }
        const unsigned old = xb_add(&bar[XB_XSUB(b.x)], 1u);
        const unsigned gen = old / nloc;
        if (old + 1u == (gen + 1u) * nloc) {
            __builtin_amdgcn_fence(__ATOMIC_RELEASE, "agent");
            asm volatile("s_waitcnt vmcnt(0)" ::: "memory");
            const unsigned og = xb_add(&bar[XB_TOP], 1u);
            const unsigned tg = og / nx;
            if (og + 1u == (tg + 1u) * nx) xb_add(&bar[XB_TOPGEN], 1u);
            else XB_SPIN(xb_ld(&bar[XB_TOPGEN]) == tg, bar);
            __builtin_amdgcn_fence(__ATOMIC_ACQUIRE, "agent");
            xb_add(&bar[XB_XGEN(b.x)], 1u);
            asm volatile("s_waitcnt vmcnt(0)" ::: "memory");
        } else {
            XB_SPIN(xb_ld(&bar[XB_XGEN(b.x)]) == gen, bar);
            __builtin_amdgcn_fence(__ATOMIC_ACQUIRE, "agent");
            asm volatile("s_waitcnt vmcnt(0)" ::: "memory");
        }
    }
    __syncthreads();
}

__global__ void __launch_bounds__(NWAVES * 64, 2) mega_fwd(Params P) {
    extern __shared__ __attribute__((aligned(16))) unsigned char lds_raw[];
    LAS unsigned char* lds = (LAS unsigned char*)lds_raw;
    const int tid = threadIdx.x, lane = tid & 63, wave = __builtin_amdgcn_readfirstlane(tid >> 6);
    const int G = gridDim.x, bx = blockIdx.x, vcu = (G % 8 == 0) ? (bx % 8) * (G / 8) + bx / 8 : bx;
    const int gw = vcu * NWAVES + wave, NGW = G * NWAVES;
    const int lo = P.ph_lo, hi = P.ph_hi;
#ifndef PH_MASK
#define PH_MASK 0x7ff
#endif
#define IN(k) (((PH_MASK >> (k)) & 1) && lo <= (k) && (k) < hi)
#ifdef PROBE_A
    unsigned long long t_a = 0, t_b = 0;
#define STAMP(id) do { if ((id) == PROBE_A) t_a = __builtin_amdgcn_s_memrealtime(); if ((id) == PROBE_B) t_b = __builtin_amdgcn_s_memrealtime(); } while (0)
#else
#define STAMP(id) do { } while (0)
#endif
    volatile LAS unsigned* bst = (volatile LAS unsigned*)(lds + 128 * 1024);
    if (tid < 2) bst[tid] = 0u;
    __syncthreads();
    XcdBarrier xbar = xcd_barrier_post((unsigned*)(P.ws + WS_CTL) + 1024, bst);
#define SEAM(k) do { if (IN(k) && IN((k) + 1)) { if (P.ph_hi > 64) cg::this_grid().sync(); else xcd_barrier(xbar); } STAMP((k) + 1); } while (0)
    STAMP(0);
#define tab ((const f32x2*)(P.ws + WS_TAB))
#define XN ((bf16*)(P.ws + WS_XN))
#define part_q ((float*)(P.ws + WS_PQ))
#define part_kv ((float*)(P.ws + WS_PKV))
#define part_t ((float*)(P.ws + WS_PT))
#define part_e ((float*)(P.ws + WS_PE))
#define rstd_e ((float*)(P.ws + WS_RSTDE))
#define gates ((bf16*)P.out)

    if (IN(0)) {
        LAS float* scr = (LAS float*)(lds + wave * 16384);
#define TR(IN_, KS, N_, R_, KD, WHICH, GSP, OFF) { const int nit = ((KD) / 64) * ((R_) / 32); for (; it < nit; it += nstep) transpose_item(P.in[IN_], KS, N_, (bf16*)(P.ws + (OFF)), R_, KD, WHICH, GSP, scr, it, lane); it -= nit; }
#define TR_LATE() do { \
        TR(5, 256, 1536, 1536, 256, 1, P.in[4], WS_WQKV) \
        TR(7, 128, 2048, 2048, 256, 2, P.in[6], WS_WQKV + (size_t)1536 * 256 * 2) \
        TR(9, 1024, 1024, 1024, 1024, 3, nullptr, WS_WUP) \
        TR(10, 1024, 1024, 1024, 1024, 3, nullptr, WS_WUP + (size_t)1024 * 1024 * 2) \
        TR(11, 1024, 1024, 1024, 1024, 3, nullptr, WS_WOUT) \
        TR(14, 1024, 4096, 4096, 1024, 3, nullptr, WS_W1) \
        TR(15, 4096, 1024, 1024, 4096, 3, nullptr, WS_W2) \
        TR(19, 1024, 1024, 1024, 1024, 3, nullptr, WS_WPG) \
        TR(17, 256, 1024, 1024, 256, 3, nullptr, WS_WPP) } while (0)
        { int it = gw; const int nstep = NGW;
          TR(3, 1024, 3744, N_IN_PAD, 1024, 0, nullptr, WS_WIN)
          if (G != 256) TR_LATE(); }
        { const float* x = P.in[0]; const float* g = P.in[2];
          for (int row0 = gw; row0 < M; row0 += 4 * NGW) {
              f32x4 v[4][4], pv[4]; float ss[4] = {0.f, 0.f, 0.f, 0.f};
#pragma unroll
              for (int r2 = 0; r2 < 4; ++r2) { const int row = row0 + r2 * NGW; const f32x4* xr = (const f32x4*)(x + (size_t)row * DM);
#pragma unroll
                  for (int j = 0; j < 4; ++j) v[r2][j] = xr[lane + 64 * j];
                  pv[r2] = ((const f32x4*)(P.in[1] + (size_t)row * 256))[lane]; }
#pragma unroll
              for (int r2 = 0; r2 < 4; ++r2) { const int row = row0 + r2 * NGW;
#pragma unroll
                  for (int j = 0; j < 4; ++j) ss[r2] += dot4(v[r2][j]);
                  const float rs = __builtin_amdgcn_rsqf(wave_sum(ss[r2]) * (1.0f / DM) + EPS);
#pragma unroll
                  for (int j = 0; j < 4; ++j) { const f32x4 gg = ((const f32x4*)g)[lane + 64 * j]; *(u32x2*)(XN + (size_t)row * DM + 4 * (lane + 64 * j)) = pack4(v[r2][j] * rs * gg); }
                  *(u32x2*)((bf16*)(P.ws + WS_PB) + (size_t)row * 256 + 4 * lane) = pack4(pv[r2]); }
          } }
        for (int i = (vcu * NWAVES + wave) * 64 + lane; i < SEQ * 32; i += NGW * 64) {
            const int pos = i >> 5, j = i & 31; const float inv = expf(-9.210340371976184f * (float)j * (2.0f / 64.0f)); const float ang = (float)pos * inv;
            ((f32x2*)(P.ws + WS_TAB))[i] = (f32x2){cosf(ang), sinf(ang)}; }
    }
    SEAM(0);
    if (IN(1)) {
        pg8::Gemm g{XN, (const bf16*)(P.ws + WS_WIN), M, N_IN_PAD, 1024}; Sched S = make_sched(G, bx, 15);
        EpiP1 E{(bf16*)(P.ws + WS_QA), (bf16*)(P.ws + WS_KVR), (bf16*)(P.ws + WS_KROPE), (bf16*)(P.ws + WS_QS), (bf16*)(P.ws + WS_KS), (bf16*)(P.ws + WS_VS), gates, part_q, part_kv, tab};
        pg8::gemm_phase<EpiP1, Sched, true, true>(lds, g, S, E);
        if (G == 256 && bx >= 128) {
            LAS float* scr = (LAS float*)(lds + wave * 16384);
            int it = (bx - 128) * NWAVES + wave; const int nstep = 128 * NWAVES;
            TR_LATE();
        }
    }
#undef TR
#undef TR_LATE
    SEAM(1);
    if (IN(2)) {
        pg8::Gemm g{(const bf16*)(P.ws + WS_QA), (const bf16*)(P.ws + WS_WQKV), 2 * M, 3584, 256};
        Sched S = make_sched(G, bx, 6); S.nseg = 2; S.nN[1] = 8; S.pmo[1] = 128; S.pno[1] = 6; S.start[1] = 768; S.start[2] = 768 + 1024;
        EpiP2 E{(bf16*)(P.ws + WS_QN), (bf16*)(P.ws + WS_QR), (bf16*)(P.ws + WS_KN), (bf16*)(P.ws + WS_VM), part_q, part_kv, tab};
        pg8::gemm_phase<EpiP2, Sched, true, true>(lds, g, S, E);
    }
    SEAM(2);
    if (IN(3)) {
        for (int U = vcu; U < 2048; U += G) {
            const int c8 = U & 255, i = U >> 8, bh = c8 >> 1, s = c8 & 1, k = i >> 1, qb = (i & 1) ? 15 - 2 * k - s : 2 * k + s;
            att::unit<0>(lds, (const bf16*)(P.ws + WS_QN), (const bf16*)(P.ws + WS_QR), (const bf16*)(P.ws + WS_KN), (const bf16*)(P.ws + WS_KROPE), (const bf16*)(P.ws + WS_VM), (bf16*)(P.ws + WS_QN), nullptr, bh >> 4, bh & 15, qb, 0);
        }
        STAMP(12);
        for (int U = vcu; U < 512; U += G) swa_unit(lds, (const bf16*)(P.ws + WS_QS), (const bf16*)(P.ws + WS_KS), (const bf16*)(P.ws + WS_VS), (bf16*)(P.ws + WS_QS), P.in[8], U >> 6, (U >> 5) & 1, U & 31);
    }
    SEAM(3);
    if (IN(4)) {
        pg8::Gemm g{(const bf16*)(P.ws + WS_QN), (const bf16*)(P.ws + WS_WUP), 2 * M, 2048, 1024}; Sched S = make_sched(G, bx, 4); S.pairs = 1;
        EpiP4 E{gates, XN, (bf16*)(P.ws + WS_QA)};
        pg8::gemm_phase<EpiP4, Sched, true, true>(lds, g, S, E);
    }
    SEAM(4);
    if (IN(5)) {
        pg8::Gemm g{XN, (const bf16*)(P.ws + WS_WOUT), M, 1024, 1024}; Sched S = make_sched(G, bx, 4);
        EpiT E{(bf16*)(P.ws + WS_T), part_t};
        pg8::gemm_phase<EpiT, Sched, true, true>(lds, g, S, E);
    }
    SEAM(5);
    if (IN(6)) rowpass<true>(P.in[0], P.out, (const bf16*)(P.ws + WS_T), part_t, P.in[12], P.in[13], XN, nullptr, nullptr, gw, NGW, lane);
    SEAM(6);
    if (IN(7)) {
        pg8::Gemm g{XN, (const bf16*)(P.ws + WS_W1), M, FF, 1024}; Sched S = make_sched(G, bx, 16);
        EpiRelu2 E{(bf16*)(P.ws + WS_U)};
        pg8::gemm_phase<EpiRelu2, Sched, true, true>(lds, g, S, E);
    }
    SEAM(7);
    if (IN(8)) {
        { pg8::Gemm g{(const bf16*)(P.ws + WS_U), (const bf16*)(P.ws + WS_W2), M, 1024, FF}; Sched S = make_sched(G, bx, 4);
          EpiT E{(bf16*)(P.ws + WS_T), part_t};
          pg8::gemm_phase<EpiT, Sched, true, true>(lds, g, S, E); }
        { pg8::Gemm g{(const bf16*)(P.ws + WS_PB), (const bf16*)(P.ws + WS_WPP), M, 1024, 256}; Sched S = make_sched(G, bx, 4);
          EpiT E{(bf16*)(P.ws + WS_ERAW), part_e};
          pg8::gemm_phase<EpiT, Sched, true, true>(lds, g, S, E); }
    }
    SEAM(8);
    if (IN(9)) rowpass<false>(P.out, P.out, (const bf16*)(P.ws + WS_T), part_t, P.in[16], nullptr, XN, part_e, rstd_e, gw, NGW, lane);
    SEAM(9);
    if (IN(10)) {
        pg8::Gemm g{XN, (const bf16*)(P.ws + WS_WPG), M, 1024, 1024}; Sched S = make_sched(G, bx, 4);
        EpiOut E{P.out, (const bf16*)(P.ws + WS_ERAW), rstd_e, P.in[18]};
        pg8::gemm_phase<EpiOut, Sched, true, true>(lds, g, S, E);
    }
    STAMP(11);
#ifdef PROBE_A
    cg::this_grid().sync();
    STAMP(13); cg::this_grid().sync(); cg::this_grid().sync(); cg::this_grid().sync(); cg::this_grid().sync(); STAMP(14);
    if (bx == 0 && tid == 0) P.out[0] += (float)(((t_b - t_a) / PROBE_Q) * (PROBE_Q / 100ull));
#endif
#undef IN
#undef SEAM
#undef tab
#undef XN
#undef part_q
#undef part_kv
#undef part_t
#undef part_e
#undef rstd_e
#undef gates
}

extern "C" void kernel_launch(void* const* d_in, const int* in_sizes, int n_in, void* d_out, int out_size, void* d_ws, size_t ws_size, hipStream_t stream) {
    static int grid = 0;
    if (grid == 0) {
        int dev = 0, cus = 0, per_cu = 0;
        hipGetDevice(&dev); hipDeviceGetAttribute(&cus, hipDeviceAttributeMultiprocessorCount, dev);
        if (hipFuncSetAttribute((const void*)mega_fwd, hipFuncAttributeMaxDynamicSharedMemorySize, LDS_BYTES) != hipSuccess) { fprintf(stderr, "hipFuncSetAttribute failed\n"); }
        if (hipOccupancyMaxActiveBlocksPerMultiprocessor(&per_cu, (const void*)mega_fwd, NWAVES * 64, LDS_BYTES) != hipSuccess || per_cu < 1) { fprintf(stderr, "occupancy query: %d\n", per_cu); per_cu = 1; }
        (void)hipGetLastError();
        grid = cus * per_cu;
        if (n_in != 20 || ws_size < WS_END) fprintf(stderr, "kernel_launch: unexpected n_in %d / ws %zu\n", n_in, ws_size);
    }
    Params p{};
    for (int i = 0; i < 20; ++i) p.in[i] = (const float*)d_in[i];
    p.out = (float*)d_out; p.ws = (unsigned char*)d_ws;
#if MK_N_LAUNCHES == 1
    (void)hipMemsetAsync((unsigned char*)d_ws + WS_CTL, 0, CTL_BYTES, stream);
    p.ph_lo = 0; p.ph_hi = 11;
    void* args[] = {&p};
    hipError_t e = hipLaunchCooperativeKernel((const void*)mega_fwd, dim3(grid), dim3(NWAVES * 64), args, LDS_BYTES, stream);
    if (e != hipSuccess) fprintf(stderr, "cooperative launch failed: %s (grid %d)\n", hipGetErrorString(e), grid);
#else
    for (int k = 0; k < 11; ++k) { p.ph_lo = k; p.ph_hi = k + 1; hipLaunchKernelGGL(mega_fwd, dim3(grid), dim3(NWAVES * 64), LDS_BYTES, stream, p); }
#endif
}
```

```cpp
#include <hip/hip_runtime.h>
#include <hip/hip_cooperative_groups.h>
#include <cstdio>
#include <cstdint>
namespace cg = cooperative_groups;
#ifndef MK_N_LAUNCHES
#define MK_N_LAUNCHES 1
#endif
namespace pg8 {
#define PG8_LAS __attribute__((address_space(3)))
typedef unsigned short bf16_t;
typedef short bf16x8 __attribute__((ext_vector_type(8)));
typedef float f32x4 __attribute__((ext_vector_type(4)));
typedef unsigned u32x4 __attribute__((ext_vector_type(4)));
constexpr int BM = 256, BK = 64, HALF = 128, HTB = HALF * BK * 2  , STAGE_BYTES = 8 * HTB, NXCD = 8, WGM = 8;

__host__ __device__ __forceinline__ int lds_byte(int r, int c) { const int st = (r >> 4) * 2 + (c >> 5), rr = r & 15, cc = c & 31, ob = rr * 64 + cc * 2; return st * 1024 + (ob ^ (((ob >> 9) & 1) << 5)); }
__host__ __device__ __forceinline__ void stage_rc(int b, int& R, int& C) { const int st = b / 1024, sb = b % 1024, swz = sb ^ (((sb >> 9) & 1) << 5); R = (st >> 1) * 16 + swz / 64; C = (st & 1) * 32 + (swz % 64) / 2; }
__host__ __device__ __forceinline__ int perm32(int rho) { const int n = rho >> 4, i = rho & 15; return 8 * (i >> 2) + 4 * n + (i & 3); }

struct Unit { int pm, pn, kind; };
struct Gemm { const bf16_t* A; const bf16_t* Bt; int M, N, K; };

template <class Epi, class Sched, bool ALIGN_EPI = false, bool SP2 = false>
__device__ __forceinline__ void gemm_phase(PG8_LAS unsigned char* lds, const Gemm g, const Sched& S, const Epi& E) {
    const int tid = threadIdx.x, wid = __builtin_amdgcn_readfirstlane(tid >> 6), lane = tid & 63, wr = wid >> 2, wc = wid & 3, fr = lane & 15, fq = lane >> 4;
    int K_ = g.K; asm volatile("" : "+s"(K_));
    const int K = K_, nt = K / BK;
    unsigned voffA[2], voffB[2];
#pragma unroll
    for (int i = 0; i < 2; ++i) { int R, C; stage_rc(tid * 16 + i * 8192, R, C); const int Rb = Epi::PERM ? ((R & ~31) + perm32(R & 31)) : R;
        voffA[i] = (unsigned)(R * K + C) * 2u; voffB[i] = (unsigned)(Rb * K + C) * 2u; }
    const size_t kstep = (size_t)(BK * 2);
    const size_t hstep = (size_t)HALF * K * 2;
    const size_t tstep = 2 * hstep;
    const unsigned ldsw = (unsigned)wid * 1024u;
    const int aoff = lds_byte(wr * 64 + fr, fq * 8), boff = lds_byte(wc * 32 + fr, fq * 8);
#define PG8_SA(b, h) (((b) * 2 + (h)) * HTB)
#define PG8_SB(b, h) ((4 + (b) * 2 + (h)) * HTB)
#define PG8_STAGE(bufoff, gbase, voff) do { _Pragma("unroll") for (int _i = 0; _i < 2; ++_i) \
        __builtin_amdgcn_global_load_lds((const unsigned*)((const char*)(gbase) + (voff)[_i]), (PG8_LAS unsigned*)(lds + (bufoff) + ldsw + _i * 8192), 16, 0, 0); } while (0)
#define PG8_LDA(dst, b, h) do { _Pragma("unroll") for (int m = 0; m < 4; ++m) _Pragma("unroll") for (int k = 0; k < 2; ++k) dst[m][k] = *(const PG8_LAS bf16x8*)(lds + PG8_SA(b, h) + aoff + m * 2048 + k * 1024); } while (0)
#define PG8_LDB(dst, b, h) do { _Pragma("unroll") for (int n = 0; n < 2; ++n) _Pragma("unroll") for (int k = 0; k < 2; ++k) dst[n][k] = *(const PG8_LAS bf16x8*)(lds + PG8_SB(b, h) + boff + n * 2048 + k * 1024); } while (0)
#define PG8_MMA(ai, bj, At, Bt) do { __builtin_amdgcn_s_setprio(1); _Pragma("unroll") for (int m = 0; m < 4; ++m) _Pragma("unroll") for (int n = 0; n < 2; ++n) _Pragma("unroll") for (int k = 0; k < 2; ++k) \
        acc[ai][bj][m][n] = __builtin_amdgcn_mfma_f32_16x16x32_bf16(Bt[n][k], At[m][k], acc[ai][bj][m][n], 0, 0, 0); __builtin_amdgcn_s_setprio(0); } while (0)
#define PG8_WAIT_V(n) asm volatile("s_waitcnt vmcnt(" #n ")" ::: "memory")
#define PG8_WAIT_L(n) asm volatile("s_waitcnt lgkmcnt(" #n ")" ::: "memory")
#define PG8_BAR __builtin_amdgcn_s_barrier()
#define PG8_SCHED __builtin_amdgcn_sched_barrier(0)
    Unit cur, nxt; int ui = 0;
    if (!S.next(0, cur)) return;
    f32x4 acc[2][2][4][2];
#pragma unroll
    for (int a = 0; a < 2; ++a)
#pragma unroll
        for (int b = 0; b < 2; ++b)
#pragma unroll
            for (int m = 0; m < 4; ++m)
#pragma unroll
                for (int n = 0; n < 2; ++n) acc[a][b][m][n] = (f32x4){0.f, 0.f, 0.f, 0.f};
    bf16x8 At[4][2], B0[2][2], B1[2][2];
    const char* cA = (const char*)g.A + (size_t)cur.pm * tstep; const char* cB = (const char*)g.Bt + (size_t)cur.pn * tstep;
    S.a_ready(cur);
    if constexpr (SP2) {
        PG8_STAGE(PG8_SB(0, 0), cB, voffB); PG8_STAGE(PG8_SB(0, 1), cB + hstep, voffB); PG8_STAGE(PG8_SA(0, 0), cA, voffA); PG8_STAGE(PG8_SA(0, 1), cA + hstep, voffA);
        if (wr == 1) PG8_BAR;
        PG8_WAIT_V(2); PG8_BAR;
        PG8_STAGE(PG8_SB(1, 0), cB + kstep, voffB); PG8_STAGE(PG8_SA(1, 0), cA + kstep, voffA); PG8_STAGE(PG8_SB(1, 1), cB + hstep + kstep, voffB);
        PG8_WAIT_V(6); PG8_BAR;
    } else {
        PG8_STAGE(PG8_SB(0, 0), cB, voffB); PG8_STAGE(PG8_SA(0, 0), cA, voffA); PG8_STAGE(PG8_SB(0, 1), cB + hstep, voffB); PG8_STAGE(PG8_SA(0, 1), cA + hstep, voffA);
        if (wr == 1) PG8_BAR;
        PG8_WAIT_V(4); PG8_BAR;
        PG8_STAGE(PG8_SB(1, 0), cB + kstep, voffB); PG8_STAGE(PG8_SA(1, 0), cA + kstep, voffA); PG8_STAGE(PG8_SB(1, 1), cB + hstep + kstep, voffB);
        PG8_WAIT_V(6); PG8_BAR;
    }
    for (;;) {
        const bool has_next = S.next(ui + 1, nxt);
        const char* nA = has_next ? (const char*)g.A + (size_t)nxt.pm * tstep : cA; const char* nB = has_next ? (const char*)g.Bt + (size_t)nxt.pn * tstep : cB;
        for (int t = 0; t < nt; t += 2) {
            const bool last = (t == nt - 2);
            const char* a1 = cA + (size_t)(t + 1) * kstep;
            const char* a2 = last ? nA : cA + (size_t)(t + 2) * kstep; const char* b2 = last ? nB : cB + (size_t)(t + 2) * kstep;
            const char* a3 = a2 + kstep; const char* b3 = b2 + kstep;
            if (last && has_next) S.a_ready(nxt);
            if constexpr (SP2) {
            PG8_LDB(B0, 0, 0); PG8_LDB(B1, 0, 1); PG8_SCHED; PG8_LDA(At, 0, 0); PG8_STAGE(PG8_SA(1, 1), a1 + hstep, voffA);
            PG8_WAIT_V(8); PG8_WAIT_L(0); PG8_BAR; PG8_MMA(0, 0, At, B0); PG8_MMA(0, 1, At, B1); PG8_BAR; PG8_SCHED;
            PG8_LDA(At, 0, 1); PG8_STAGE(PG8_SB(0, 0), b2, voffB); PG8_STAGE(PG8_SB(0, 1), b2 + hstep, voffB); PG8_STAGE(PG8_SA(0, 0), a2, voffA);
            PG8_WAIT_V(8); PG8_WAIT_L(0); PG8_BAR; PG8_MMA(1, 0, At, B0); PG8_MMA(1, 1, At, B1); PG8_BAR; PG8_SCHED;
            PG8_LDB(B0, 1, 0); PG8_LDB(B1, 1, 1); PG8_SCHED; PG8_LDA(At, 1, 0); PG8_STAGE(PG8_SA(0, 1), a2 + hstep, voffA);
            PG8_WAIT_V(8); PG8_WAIT_L(0); PG8_BAR; PG8_MMA(0, 0, At, B0); PG8_MMA(0, 1, At, B1); PG8_BAR; PG8_SCHED;
            PG8_LDA(At, 1, 1); PG8_STAGE(PG8_SB(1, 0), b3, voffB); PG8_STAGE(PG8_SB(1, 1), b3 + hstep, voffB); PG8_STAGE(PG8_SA(1, 0), a3, voffA);
            PG8_WAIT_V(8); PG8_WAIT_L(0); PG8_BAR; PG8_MMA(1, 0, At, B0); PG8_MMA(1, 1, At, B1); PG8_BAR; PG8_SCHED;
            } else {
            PG8_LDB(B0, 0, 0); PG8_SCHED; PG8_LDA(At, 0, 0); PG8_STAGE(PG8_SA(1, 1), a1 + hstep, voffA);
            PG8_WAIT_L(8); PG8_BAR; PG8_WAIT_L(0); PG8_MMA(0, 0, At, B0); PG8_BAR; PG8_SCHED;
            PG8_LDB(B1, 0, 1); PG8_STAGE(PG8_SB(0, 0), b2, voffB);
            PG8_BAR; PG8_WAIT_L(0); PG8_MMA(0, 1, At, B1); PG8_BAR;
            PG8_LDA(At, 0, 1); PG8_STAGE(PG8_SA(0, 0), a2, voffA);
            PG8_BAR; PG8_WAIT_L(0); PG8_MMA(1, 0, At, B0); PG8_BAR; PG8_SCHED;
            PG8_STAGE(PG8_SB(0, 1), b2 + hstep, voffB);
            PG8_WAIT_V(6); PG8_BAR; PG8_MMA(1, 1, At, B1); PG8_BAR;
            PG8_LDB(B0, 1, 0); PG8_SCHED; PG8_LDA(At, 1, 0); PG8_STAGE(PG8_SA(0, 1), a2 + hstep, voffA);
            PG8_WAIT_L(8); PG8_BAR; PG8_WAIT_L(0); PG8_MMA(0, 0, At, B0); PG8_BAR; PG8_SCHED;
            PG8_LDB(B1, 1, 1); PG8_STAGE(PG8_SB(1, 0), b3, voffB);
            PG8_BAR; PG8_WAIT_L(0); PG8_MMA(0, 1, At, B1); PG8_BAR;
            PG8_LDA(At, 1, 1); PG8_STAGE(PG8_SA(1, 0), a3, voffA);
            PG8_BAR; PG8_WAIT_L(0); PG8_MMA(1, 0, At, B0); PG8_BAR; PG8_SCHED;
            PG8_STAGE(PG8_SB(1, 1), b3 + hstep, voffB);
            PG8_WAIT_V(6); PG8_BAR; PG8_MMA(1, 1, At, B1); PG8_BAR;
            }
        }
        if constexpr (ALIGN_EPI) { if (wr == 0) PG8_BAR; }
        if constexpr (!Epi::AFTER_DRAIN) { if (cur.kind & 0x100) E.mid(acc, cur, wr, wc, fr, fq); else E(acc, cur, wr, wc, fr, fq); S.done(cur); }
        if (!has_next) break;
        {
#pragma unroll
        for (int a = 0; a < 2; ++a)
#pragma unroll
            for (int b = 0; b < 2; ++b)
#pragma unroll
                for (int m = 0; m < 4; ++m)
#pragma unroll
                    for (int n = 0; n < 2; ++n) acc[a][b][m][n] = (f32x4){0.f, 0.f, 0.f, 0.f};
        }
        cur = nxt; cA = nA; cB = nB; ++ui;
        if constexpr (ALIGN_EPI) { if (wr == 1) PG8_BAR; }
    }
    PG8_WAIT_V(0);
    if constexpr (!ALIGN_EPI) { if (wr == 0) PG8_BAR; }
    PG8_BAR;
    if constexpr (Epi::AFTER_DRAIN) { E.fused(acc, cur, wr, wc, fr, fq, lds, wid, lane); S.done(cur); }
#undef PG8_SA
#undef PG8_SB
#undef PG8_STAGE
#undef PG8_LDA
#undef PG8_LDB
#undef PG8_MMA
#undef PG8_WAIT_V
#undef PG8_WAIT_L
#undef PG8_BAR
#undef PG8_SCHED
}
}

#define LAS __attribute__((address_space(3)))
typedef unsigned short bf16;
typedef float f32x4 __attribute__((ext_vector_type(4)));
typedef float f32x2 __attribute__((ext_vector_type(2)));
typedef float f32x16 __attribute__((ext_vector_type(16)));
typedef short bf16x8 __attribute__((ext_vector_type(8)));
typedef short s16x4 __attribute__((ext_vector_type(4)));
typedef unsigned u32x4 __attribute__((ext_vector_type(4)));
typedef unsigned u32x2 __attribute__((ext_vector_type(2)));
typedef __bf16 bf16x2_t __attribute__((ext_vector_type(2)));

constexpr int DM = 1024, SEQ = 4096, NB = 8, M = NB * SEQ, FF = 4096;
constexpr int NWAVES = 8;
constexpr float EPS = 1e-6f, LOG2E = 1.4426950408889634f;
constexpr float C2_MLA = 0.10206207261596575f * LOG2E;
constexpr float C2_SWA = 0.125f * LOG2E;
constexpr int N_IN_PAD = 3840;

constexpr size_t MiB = 1u << 20;
constexpr size_t WS_CTL = 0, CTL_BYTES = 65536;
constexpr size_t WS_TAB = 1 * MiB, WS_PQ = 2 * MiB, WS_PKV = 2 * MiB + 512 * 1024, WS_PT = 3 * MiB, WS_PE = 5 * MiB, WS_RSTDE = 7 * MiB;
constexpr size_t WS_WIN = 8 * MiB, WS_WQKV = 16 * MiB, WS_WPP = 18 * MiB, WS_WUP = 19 * MiB, WS_WOUT = 23 * MiB, WS_W1 = 25 * MiB, WS_W2 = 33 * MiB, WS_WPG = 41 * MiB;
constexpr size_t WS_XN = 48 * MiB, WS_QA = 112 * MiB, WS_KVR = 128 * MiB, WS_KS = 144 * MiB, WS_VS = 152 * MiB, WS_KROPE = 160 * MiB, WS_ERAW = 112 * MiB;
constexpr size_t WS_T = 176 * MiB, WS_QR = 176 * MiB, WS_PB = 240 * MiB;
constexpr size_t WS_QN = 256 * MiB, WS_QS = 320 * MiB, WS_KN = 384 * MiB, WS_VM = 448 * MiB, WS_U = 256 * MiB, WS_END = 512 * MiB;

constexpr int LDS_BYTES = 132 * 1024;

struct Params { const float* in[20]; float* out; unsigned char* ws; int ph_lo, ph_hi; };

__device__ __forceinline__ unsigned cvtpk(float lo, float hi) { f32x2 v = {lo, hi}; bf16x2_t b = __builtin_convertvector(v, bf16x2_t); return __builtin_bit_cast(unsigned, b); }
__device__ __forceinline__ u32x2 pack4(f32x4 v) { u32x2 r; r.x = cvtpk(v[0], v[1]); r.y = cvtpk(v[2], v[3]); return r; }
__device__ __forceinline__ float bf2f(unsigned short h) { return __builtin_bit_cast(float, (unsigned)h << 16); }
__device__ __forceinline__ f32x4 unpack4(u32x2 w) { f32x4 r; r[0] = __builtin_bit_cast(float, w.x << 16); r[1] = __builtin_bit_cast(float, w.x & 0xffff0000u); r[2] = __builtin_bit_cast(float, w.y << 16); r[3] = __builtin_bit_cast(float, w.y & 0xffff0000u); return r; }
__device__ __forceinline__ float sigmoidf_(float x) { return __builtin_amdgcn_rcpf(1.0f + __builtin_amdgcn_exp2f(-x * LOG2E)); }
__device__ __forceinline__ f32x4 sigmoid4(f32x4 v) { f32x4 r; r[0] = sigmoidf_(v[0]); r[1] = sigmoidf_(v[1]); r[2] = sigmoidf_(v[2]); r[3] = sigmoidf_(v[3]); return r; }
__device__ __forceinline__ float wave_sum(float v) {
#pragma unroll
    for (int o = 1; o < 64; o <<= 1) v += __shfl_xor(v, o);
    return v;
}
__device__ __forceinline__ float dot4(f32x4 v) { return (v[0] * v[0] + v[1] * v[1]) + (v[2] * v[2] + v[3] * v[3]); }

struct Sched {
    int G, c, nseg, pairs;
    int nN[2], pmo[2], pno[2], start[3];
    __device__ __forceinline__ bool next(int i, pg8::Unit& u) const {
        const int ii = pairs ? (i >> 1) : i;
        const long L = (long)ii * G + c; if (L >= start[nseg]) return false;
        const int s = (nseg > 1 && L >= start[1]) ? 1 : 0; const int l = (int)L - start[s];
        const int nwg = start[s + 1] - start[s], q = nwg >> 3, id = (l & 7) * q + (l >> 3);
        const int nig = 8 * nN[s], gid = id / nig, r = id % nig;
        const int pm = gid * 8 + (r & 7), pn = r >> 3;
        u.pm = pmo[s] + pm; u.pn = pno[s] + pn; u.kind = u.pn;
        if (pairs) { if (i & 1) { u.pm += 128; u.pn += 4; u.kind = 0; } else u.kind = 0x100; }
        return true;
    }
    __device__ __forceinline__ void a_ready(const pg8::Unit&) const {}
    __device__ __forceinline__ void done(const pg8::Unit&) const {}
};
__device__ __forceinline__ Sched make_sched(int G, int c, int nN0) { Sched s; s.G = G; s.c = c; s.nseg = 1; s.pairs = 0; s.nN[0] = nN0; s.nN[1] = 1; s.pmo[0] = s.pmo[1] = 0; s.pno[0] = s.pno[1] = 0; s.start[0] = 0; s.start[1] = 128 * nN0; s.start[2] = s.start[1]; return s; }

typedef pg8::f32x4 A4;
#define EPI_ROWS(ai, m) for (int ai = 0; ai < 2; ++ai) _Pragma("unroll") for (int m = 0; m < 4; ++m)

struct EpiP1 {
    static constexpr bool PERM = false, AFTER_DRAIN = false;
    bf16 *qa, *kvr, *krope, *qs, *ks, *vs, *gates; float *part_q, *part_kv; const f32x2* tab;
    __device__ __forceinline__ void mid(const A4 (&acc)[2][2][4][2], const pg8::Unit& u, int wr, int wc, int fr, int fq) const {}
    __device__ __forceinline__ void operator()(const A4 (&acc)[2][2][4][2], const pg8::Unit& u, int wr, int wc, int fr, int fq) const {
        const int pn = u.kind, row0 = u.pm * 256 + wr * 64 + fr, cl0 = wc * 32 + fq * 4;
        if (pn <= 1) {
            bf16* dst = pn == 0 ? qa : kvr; float* part = pn == 0 ? part_q : part_kv;
#pragma unroll
            EPI_ROWS(ai, m) { const int row = row0 + ai * 128 + m * 16; float ss = 0.f;
#pragma unroll
                for (int bj = 0; bj < 2; ++bj)
#pragma unroll
                    for (int n = 0; n < 2; ++n) { const A4 v = acc[ai][bj][m][n]; if (pn == 0 || bj == 0) ss += dot4(v);
                        *(u32x2*)(dst + (size_t)row * 256 + bj * 128 + cl0 + n * 16) = pack4(v); }
                ss += __shfl_xor(ss, 16); ss += __shfl_xor(ss, 32);
                if (fq == 0) part[(size_t)row * 4 + wc] = ss;
                if (pn == 1 && wc == 0) {
                    const int pos = row & (SEQ - 1); const A4 x1 = acc[ai][1][m][0], x2 = acc[ai][1][m][1]; A4 o1, o2;
#pragma unroll
                    for (int e = 0; e < 4; ++e) { const f32x2 cs = tab[pos * 32 + 2 * (4 * fq + e)]; o1[e] = x1[e] * cs.x - x2[e] * cs.y; o2[e] = x2[e] * cs.x + x1[e] * cs.y; }
                    *(u32x2*)(krope + (size_t)row * 32 + 4 * fq) = pack4(o1); *(u32x2*)(krope + (size_t)row * 32 + 16 + 4 * fq) = pack4(o2);
                }
            }
        } else if (pn <= 6) {
            const int d1 = 16 * (wc & 1) + 4 * fq;
            f32x4 tb[2][2];
            { const int pos = row0 & (SEQ - 1); tb[0][0] = *(const f32x4*)(tab + pos * 32 + d1); tb[0][1] = *(const f32x4*)(tab + pos * 32 + d1 + 2); }
#pragma unroll
            for (int it = 0; it < 8; ++it) { const int ai = it >> 2, m = it & 3; const int row = row0 + ai * 128 + m * 16;
                if (it + 1 < 8) { const int pos = (row0 + ((it + 1) >> 2) * 128 + ((it + 1) & 3) * 16) & (SEQ - 1); tb[(it + 1) & 1][0] = *(const f32x4*)(tab + pos * 32 + d1); tb[(it + 1) & 1][1] = *(const f32x4*)(tab + pos * 32 + d1 + 2); }
                asm volatile("" ::: "memory");
                const f32x4 t0 = tb[it & 1][0], t1 = tb[it & 1][1];
                const float cc[4] = {t0[0], t0[2], t1[0], t1[2]}, sn[4] = {t0[1], t0[3], t1[1], t1[3]};
#pragma unroll
                for (int bj = 0; bj < 2; ++bj) {
                    if (pn == 6 && bj == 1) {
#pragma unroll
                        for (int n = 0; n < 2; ++n) *(u32x2*)(vs + (size_t)row * 128 + cl0 + n * 16) = pack4(acc[ai][1][m][n]);
                    } else {
                        const A4 x1 = acc[ai][bj][m][0], x2 = acc[ai][bj][m][1]; A4 o1, o2; const float sc = pn == 6 ? 1.0f : C2_SWA;
#pragma unroll
                        for (int e = 0; e < 4; ++e) { o1[e] = (x1[e] * cc[e] - x2[e] * sn[e]) * sc; o2[e] = (x2[e] * cc[e] + x1[e] * sn[e]) * sc; }
                        bf16* d = pn == 6 ? ks + (size_t)row * 128 + (wc >> 1) * 64 : qs + (size_t)row * 1024 + ((pn - 2) * 4 + bj * 2 + (wc >> 1)) * 64;
                        *(u32x2*)(d + d1) = pack4(o1); *(u32x2*)(d + 32 + d1) = pack4(o2);
                    }
                }
            }
        } else {
#pragma unroll
            EPI_ROWS(ai, m) { const int row = row0 + ai * 128 + m * 16;
#pragma unroll
                for (int bj = 0; bj < 2; ++bj)
#pragma unroll
                    for (int n = 0; n < 2; ++n) *(u32x2*)(gates + (size_t)row * 2048 + (pn - 7) * 256 + bj * 128 + cl0 + n * 16) = pack4(sigmoid4(acc[ai][bj][m][n]));
            }
        }
    }
};

struct EpiP2 {
    static constexpr bool PERM = false, AFTER_DRAIN = false;
    bf16 *qn, *qr, *kn, *vm; const float *part_q, *part_kv; const f32x2* tab;
    __device__ __forceinline__ void mid(const A4 (&acc)[2][2][4][2], const pg8::Unit& u, int wr, int wc, int fr, int fq) const {}
    __device__ __forceinline__ void operator()(const A4 (&acc)[2][2][4][2], const pg8::Unit& u, int wr, int wc, int fr, int fq) const {
        const int pn = u.kind, row0 = (u.pm & 127) * 256 + wr * 64 + fr, cl0 = wc * 32 + fq * 4;
        const bool isq = pn < 6, isrope = pn == 4 || pn == 5; const float* part = isq ? part_q : part_kv; const float invn = isq ? (1.0f / 256.0f) : (1.0f / 128.0f);
        f32x4 pp[2]; f32x4 tb[2][2];
        pp[0] = *(const f32x4*)(part + (size_t)row0 * 4);
        if (isrope) { const int pos = row0 & (SEQ - 1); tb[0][0] = *(const f32x4*)(tab + pos * 32 + 8 * fq); tb[0][1] = *(const f32x4*)(tab + pos * 32 + 8 * fq + 4); }
        f32x4 tc[2][2];
        if (isrope) { const int pos = row0 & (SEQ - 1); tc[0][0] = *(const f32x4*)(tab + pos * 32 + 8 * fq + 2); tc[0][1] = *(const f32x4*)(tab + pos * 32 + 8 * fq + 6); }
#pragma unroll
        for (int it = 0; it < 8; ++it) { const int ai = it >> 2, m = it & 3; const int row = row0 + ai * 128 + m * 16;
            if (it + 1 < 8) { const int rn = row0 + ((it + 1) >> 2) * 128 + ((it + 1) & 3) * 16; pp[(it + 1) & 1] = *(const f32x4*)(part + (size_t)rn * 4);
                if (isrope) { const int pos = rn & (SEQ - 1); tb[(it + 1) & 1][0] = *(const f32x4*)(tab + pos * 32 + 8 * fq); tb[(it + 1) & 1][1] = *(const f32x4*)(tab + pos * 32 + 8 * fq + 4);
                    tc[(it + 1) & 1][0] = *(const f32x4*)(tab + pos * 32 + 8 * fq + 2); tc[(it + 1) & 1][1] = *(const f32x4*)(tab + pos * 32 + 8 * fq + 6); } }
            asm volatile("" ::: "memory");
            const f32x4 p4 = pp[it & 1];
            float rs = __builtin_amdgcn_rsqf(((p4[0] + p4[1]) + (p4[2] + p4[3])) * invn + EPS);
            if (isq) rs *= C2_MLA;
            if (isrope) {
                const float cc[4] = {tb[it & 1][0][0], tc[it & 1][0][0], tb[it & 1][1][0], tc[it & 1][1][0]}, sn[4] = {tb[it & 1][0][1], tc[it & 1][0][1], tb[it & 1][1][1], tc[it & 1][1][1]};
#pragma unroll
                for (int bj = 0; bj < 2; ++bj) { const A4 x1 = acc[ai][bj][m][0], x2 = acc[ai][bj][m][1]; A4 o1, o2;
#pragma unroll
                    for (int e = 0; e < 4; ++e) { o1[e] = (x1[e] * cc[e] - x2[e] * sn[e]) * rs; o2[e] = (x2[e] * cc[e] + x1[e] * sn[e]) * rs; }
                    bf16* d = qr + (size_t)row * 512 + ((pn - 4) * 8 + bj * 4 + wc) * 32;
                    *(u32x2*)(d + 4 * fq) = pack4(o1); *(u32x2*)(d + 16 + 4 * fq) = pack4(o2); }
            } else {
                bf16* d = pn < 4 ? qn + (size_t)row * 1024 + pn * 256 : (pn < 10 ? kn + (size_t)row * 1024 + (pn - 6) * 256 : vm + (size_t)row * 1024 + (pn - 10) * 256);
#pragma unroll
                for (int bj = 0; bj < 2; ++bj)
#pragma unroll
                    for (int n = 0; n < 2; ++n) *(u32x2*)(d + bj * 128 + cl0 + n * 16) = pack4(acc[ai][bj][m][n] * rs);
            }
        }
    }
};

struct EpiP4 {
    static constexpr bool PERM = false, AFTER_DRAIN = false;
    const bf16* gates; bf16* y; bf16* ya;
    __device__ __forceinline__ void mid(const A4 (&acc)[2][2][4][2], const pg8::Unit& u, int wr, int wc, int fr, int fq) const {
        const int row0 = u.pm * 256 + wr * 64 + fr, col0 = u.pn * 256 + wc * 32 + fq * 4;
        u32x2 gq[2][2][2];
#define P4_LD(buf, it_) do { const bf16* g_ = gates + (size_t)(row0 + ((it_) >> 2) * 128 + ((it_) & 3) * 16) * 2048 + col0; \
        _Pragma("unroll") for (int bj = 0; bj < 2; ++bj) _Pragma("unroll") for (int n = 0; n < 2; ++n) gq[buf][bj][n] = *(const u32x2*)(g_ + bj * 128 + n * 16); } while (0)
        P4_LD(0, 0);
#pragma unroll
        for (int it = 0; it < 8; ++it) { const int ai = it >> 2, m = it & 3; const size_t row = (size_t)(row0 + ai * 128 + m * 16);
            if (it + 1 < 8) P4_LD((it + 1) & 1, it + 1);
            asm volatile("" ::: "memory");
#pragma unroll
            for (int bj = 0; bj < 2; ++bj)
#pragma unroll
                for (int n = 0; n < 2; ++n) *(u32x2*)(ya + row * 1024 + col0 + bj * 128 + n * 16) = pack4(acc[ai][bj][m][n] * unpack4(gq[it & 1][bj][n]));
        }
#undef P4_LD
    }
    __device__ __forceinline__ void operator()(const A4 (&acc)[2][2][4][2], const pg8::Unit& u, int wr, int wc, int fr, int fq) const {
        const int row0 = (u.pm - 128) * 256 + wr * 64 + fr, col0 = (u.pn - 4) * 256 + wc * 32 + fq * 4;
        u32x2 gq[2][2][2], yq[2][2][2];
#define P4_LD(buf, it_) do { const size_t r_ = (size_t)(row0 + ((it_) >> 2) * 128 + ((it_) & 3) * 16); const bf16* g_ = gates + r_ * 2048 + 1024 + col0; const bf16* y_ = ya + r_ * 1024 + col0; \
        _Pragma("unroll") for (int bj = 0; bj < 2; ++bj) _Pragma("unroll") for (int n = 0; n < 2; ++n) { gq[buf][bj][n] = *(const u32x2*)(g_ + bj * 128 + n * 16); yq[buf][bj][n] = *(const u32x2*)(y_ + bj * 128 + n * 16); } } while (0)
        P4_LD(0, 0);
#pragma unroll
        for (int it = 0; it < 8; ++it) { const int ai = it >> 2, m = it & 3; const size_t row = (size_t)(row0 + ai * 128 + m * 16);
            if (it + 1 < 8) P4_LD((it + 1) & 1, it + 1);
            asm volatile("" ::: "memory");
#pragma unroll
            for (int bj = 0; bj < 2; ++bj)
#pragma unroll
                for (int n = 0; n < 2; ++n) *(u32x2*)(y + row * 1024 + col0 + bj * 128 + n * 16) = pack4(unpack4(yq[it & 1][bj][n]) + acc[ai][bj][m][n] * unpack4(gq[it & 1][bj][n]));
        }
#undef P4_LD
    }
};

struct EpiT {
    static constexpr bool PERM = true, AFTER_DRAIN = false;
    bf16* o; float* part;
    __device__ __forceinline__ void mid(const A4 (&acc)[2][2][4][2], const pg8::Unit& u, int wr, int wc, int fr, int fq) const {}
    __device__ __forceinline__ void operator()(const A4 (&acc)[2][2][4][2], const pg8::Unit& u, int wr, int wc, int fr, int fq) const {
        const int row0 = u.pm * 256 + wr * 64 + fr, col0 = u.pn * 256 + wc * 32 + fq * 8;
#pragma unroll
        EPI_ROWS(ai, m) { const size_t row = (size_t)(row0 + ai * 128 + m * 16); float ss = 0.f;
#pragma unroll
            for (int bj = 0; bj < 2; ++bj) { const A4 v0 = acc[ai][bj][m][0], v1 = acc[ai][bj][m][1]; ss += dot4(v0) + dot4(v1);
                const u32x2 a = pack4(v0), b2 = pack4(v1);
                *(u32x4*)(o + row * 1024 + col0 + bj * 128) = (u32x4){a.x, a.y, b2.x, b2.y}; }
            ss += __shfl_xor(ss, 16); ss += __shfl_xor(ss, 32);
            if (fq == 0) part[row * 16 + u.pn * 4 + wc] = ss;
        }
    }
};

struct EpiRelu2 {
    static constexpr bool PERM = true, AFTER_DRAIN = false;
    bf16* o;
    __device__ __forceinline__ void mid(const A4 (&acc)[2][2][4][2], const pg8::Unit& u, int wr, int wc, int fr, int fq) const {}
    __device__ __forceinline__ void operator()(const A4 (&acc)[2][2][4][2], const pg8::Unit& u, int wr, int wc, int fr, int fq) const {
        const int row0 = u.pm * 256 + wr * 64 + fr, col0 = u.pn * 256 + wc * 32 + fq * 8;
#pragma unroll
        EPI_ROWS(ai, m) { const size_t row = (size_t)(row0 + ai * 128 + m * 16);
#pragma unroll
            for (int bj = 0; bj < 2; ++bj) { A4 v0 = acc[ai][bj][m][0], v1 = acc[ai][bj][m][1];
#pragma unroll
                for (int e = 0; e < 4; ++e) { const float r0 = __builtin_fmaxf(v0[e], 0.f), r1 = __builtin_fmaxf(v1[e], 0.f); v0[e] = r0 * r0; v1[e] = r1 * r1; }
                const u32x2 a = pack4(v0), b2 = pack4(v1);
                *(u32x4*)(o + row * FF + col0 + bj * 128) = (u32x4){a.x, a.y, b2.x, b2.y}; }
        }
    }
};

struct EpiOut {
    static constexpr bool PERM = false, AFTER_DRAIN = false;
    float* out; const bf16* eraw; const float* rstd_e; const float* gple;
    __device__ __forceinline__ void mid(const A4 (&acc)[2][2][4][2], const pg8::Unit& u, int wr, int wc, int fr, int fq) const {}
    __device__ __forceinline__ void operator()(const A4 (&acc)[2][2][4][2], const pg8::Unit& u, int wr, int wc, int fr, int fq) const {
        const int row0 = u.pm * 256 + wr * 64 + fr, col0 = u.pn * 256 + wc * 32 + fq * 4;
        f32x4 gv[2][2];
#pragma unroll
        for (int bj = 0; bj < 2; ++bj)
#pragma unroll
            for (int n = 0; n < 2; ++n) gv[bj][n] = *(const f32x4*)(gple + col0 + bj * 128 + n * 16);
        f32x4 xq[2][2][2]; u32x2 eq[2][2][2]; float rq[2];
#define PO_LD(buf, it_) do { const size_t r_ = (size_t)(row0 + ((it_) >> 2) * 128 + ((it_) & 3) * 16); rq[buf] = rstd_e[r_]; \
        _Pragma("unroll") for (int bj = 0; bj < 2; ++bj) _Pragma("unroll") for (int n = 0; n < 2; ++n) { const size_t off_ = r_ * 1024 + col0 + bj * 128 + n * 16; xq[buf][bj][n] = *(const f32x4*)(out + off_); eq[buf][bj][n] = *(const u32x2*)(eraw + off_); } } while (0)
        PO_LD(0, 0);
#pragma unroll
        for (int it = 0; it < 8; ++it) { const int ai = it >> 2, m = it & 3; const size_t row = (size_t)(row0 + ai * 128 + m * 16);
            if (it + 1 < 8) PO_LD((it + 1) & 1, it + 1);
            asm volatile("" ::: "memory");
#pragma unroll
            for (int bj = 0; bj < 2; ++bj)
#pragma unroll
                for (int n = 0; n < 2; ++n) { const size_t off = row * 1024 + col0 + bj * 128 + n * 16;
                    *(f32x4*)(out + off) = xq[it & 1][bj][n] + sigmoid4(acc[ai][bj][m][n]) * (unpack4(eq[it & 1][bj][n]) * rq[it & 1] * gv[bj][n]); }
        }
#undef PO_LD
    }
};

namespace att {
constexpr int KP = 208, VP = 192, KBUF = 64 * KP, VBUF = 64 * VP, STAGE = KBUF + VBUF;
__device__ __forceinline__ float max3f(float a, float b, float c) { float r; asm("v_max3_f32 %0, %1, %2, %3" : "=v"(r) : "v"(a), "v"(b), "v"(c)); return r; }
__device__ __forceinline__ float max2f(float a, float b) { float r; asm("v_max_f32_e32 %0, %1, %2" : "=v"(r) : "v"(a), "v"(b)); return r; }
__device__ __forceinline__ float xhalf_max(float v) { auto rr = __builtin_amdgcn_permlane32_swap(__float_as_uint(v), __float_as_uint(v), false, false); return max2f(__uint_as_float(rr[0]), __uint_as_float(rr[1])); }
__device__ __forceinline__ float xhalf_sum(float v) { auto rr = __builtin_amdgcn_permlane32_swap(__float_as_uint(v), __float_as_uint(v), false, false); return __uint_as_float(rr[0]) + __uint_as_float(rr[1]); }
__device__ __forceinline__ s16x4 vtr(const LAS unsigned char* p) { return __builtin_bit_cast(s16x4, __builtin_amdgcn_ds_read_tr16_b64_v4i16((LAS s16x4*)p)); }

template <int MODE>
__device__ __forceinline__ void unit(LAS unsigned char* lds, const bf16* __restrict__ Qa, const bf16* __restrict__ Qb, const bf16* __restrict__ Ka, const bf16* __restrict__ Kb, const bf16* __restrict__ Va, bf16* O,
                                     const float* __restrict__ sinks, int b, int h, int blk, int hp) {
    constexpr int NC = MODE == 0 ? 6 : 4;
    const int tid = threadIdx.x, lane = tid & 63, w = __builtin_amdgcn_readfirstlane(tid >> 6), l31 = lane & 31, hi = lane >> 5;
    int hq, qpos0w, t_beg, t_end, kpos_base; size_t krow_base; int kvpitch, kvcol;
    if (MODE == 0) { hq = h; qpos0w = blk * 256 + w * 32; t_beg = 0; t_end = 4 * blk + 4; kpos_base = 0; kvpitch = 1024; kvcol = h * 64; }
    else { hq = 8 * h + 2 * hp + (w >> 2); qpos0w = blk * 128 + (w & 3) * 32; t_beg = blk == 0 ? 2 : 0; t_end = 4; kpos_base = (blk - 1) * 128; kvpitch = 128; kvcol = h * 64; }
    const size_t seq0 = (size_t)b * SEQ;
    const int qpos = qpos0w + l31;
    bf16x8 qf[NC];
    { const bf16* qp = Qa + (seq0 + qpos) * 1024 + hq * 64 + hi * 8;
#pragma unroll
      for (int c = 0; c < 4; ++c) qf[c] = *(const bf16x8*)(qp + c * 16);
      if (MODE == 0) { const bf16* qp2 = Qb + (seq0 + qpos) * 512 + hq * 32 + hi * 8;
#pragma unroll
          for (int c = 4; c < NC; ++c) qf[c] = *(const bf16x8*)(qp2 + (c - 4) * 16); } }
    const int skey = tid >> 3, sch = tid & 7;
    const bf16* kg = Ka + ((long)seq0 + kpos_base + skey) * kvpitch + kvcol + sch * 8;
    const bf16* vg = Va + ((long)seq0 + kpos_base + skey) * kvpitch + kvcol + sch * 8;
    const bf16* rg = MODE == 0 ? Kb + (seq0 + (tid >> 2)) * 32 + (tid & 3) * 8 : nullptr;
    const int kw_off = skey * KP + sch * 16, vw_off = KBUF + skey * VP + sch * 16, rw_off = (tid >> 2) * KP + 128 + (tid & 3) * 16;
    const int pi = (l31 & 0x13) | ((l31 & 4) << 1) | ((l31 & 8) >> 1);
    const int kr_off = pi * KP + hi * 16;
    const int vr_off = KBUF + (8 * hi + ((lane & 15) >> 2)) * VP + (16 * ((lane >> 4) & 1) + 4 * (lane & 3)) * 2;
    float m_run, l_run;
    if (MODE == 0) { m_run = -1e30f; l_run = 0.f; } else { m_run = sinks[hq] * LOG2E; l_run = hi == 0 ? 1.f : 0.f; }
    f32x16 o0 = {}, o1 = {};
    u32x4 kreg, vreg, rreg = {};
    kreg = *(const u32x4*)(kg + (long)t_beg * 64 * kvpitch); vreg = *(const u32x4*)(vg + (long)t_beg * 64 * kvpitch);
    if (MODE == 0 && tid < 256) rreg = *(const u32x4*)(rg + (size_t)t_beg * 64 * 32);
    *(LAS u32x4*)(lds + kw_off) = kreg; *(LAS u32x4*)(lds + vw_off) = vreg;
    if (MODE == 0 && tid < 256) *(LAS u32x4*)(lds + rw_off) = rreg;
    __syncthreads();
    for (int t = t_beg; t < t_end; ++t) {
        const int st = ((t - t_beg) & 1) * STAGE, sn = STAGE - st;
        const bool more = t + 1 < t_end;
        if (more) { kreg = *(const u32x4*)(kg + (long)(t + 1) * 64 * kvpitch); vreg = *(const u32x4*)(vg + (long)(t + 1) * 64 * kvpitch);
            if (MODE == 0 && tid < 256) rreg = *(const u32x4*)(rg + (size_t)(t + 1) * 64 * 32); }
        const int kp0 = kpos_base + t * 64;
        bool doit, domask;
        if (MODE == 0) { doit = kp0 <= qpos0w + 31; domask = kp0 + 63 > qpos0w; }
        else { const int a = w & 3; doit = a < 2 ? (t <= 2) : (t >= 1); domask = true; }
        if (doit) {
            const LAS unsigned char* kb = lds + st + kr_off; const LAS unsigned char* vb = lds + st + vr_off;
            f32x16 s0 = {}, s1 = {};
#pragma unroll
            for (int c = 0; c < NC; ++c) { const bf16x8 k0 = *(const LAS bf16x8*)(kb + c * 32), k1 = *(const LAS bf16x8*)(kb + 32 * KP + c * 32);
                s0 = __builtin_amdgcn_mfma_f32_32x32x16_bf16(k0, qf[c], s0, 0, 0, 0); s1 = __builtin_amdgcn_mfma_f32_32x32x16_bf16(k1, qf[c], s1, 0, 0, 0); }
            if (domask) {
#pragma unroll
                for (int r = 0; r < 16; ++r) { const int kk = kp0 + 16 * (r >> 3) + 8 * hi + (r & 7); const int rel0 = qpos - kk, rel1 = rel0 - 32;
                    const bool ok0 = MODE == 0 ? rel0 >= 0 : (rel0 >= 0 && rel0 < 128), ok1 = MODE == 0 ? rel1 >= 0 : (rel1 >= 0 && rel1 < 128);
                    s0[r] = ok0 ? s0[r] : -1e30f; s1[r] = ok1 ? s1[r] : -1e30f; }
            }
            float mx = max2f(s0[0], s1[0]);
#pragma unroll
            for (int r = 1; r < 16; ++r) mx = max3f(mx, s0[r], s1[r]);
            mx = xhalf_max(mx);
            const float mnew = max2f(m_run, mx), alpha = __builtin_amdgcn_exp2f(m_run - mnew); m_run = mnew;
            f32x2 ps2 = {0.f, 0.f}; const f32x2 mn2 = {mnew, mnew};
#pragma unroll
            for (int r = 0; r < 16; r += 2) { f32x2 a2 = (f32x2){s0[r], s0[r + 1]} - mn2, b2 = (f32x2){s1[r], s1[r + 1]} - mn2;
                a2.x = __builtin_amdgcn_exp2f(a2.x); a2.y = __builtin_amdgcn_exp2f(a2.y); b2.x = __builtin_amdgcn_exp2f(b2.x); b2.y = __builtin_amdgcn_exp2f(b2.y);
                ps2 += a2; ps2 += b2; s0[r] = a2.x; s0[r + 1] = a2.y; s1[r] = b2.x; s1[r + 1] = b2.y; }
            l_run = l_run * alpha + (ps2.x + ps2.y);
            if (__builtin_amdgcn_ballot_w64(alpha != 1.0f) != 0ull) {
                const f32x2 al2 = {alpha, alpha};
#pragma unroll
                for (int r = 0; r < 16; r += 2) { f32x2 x = (f32x2){o0[r], o0[r + 1]} * al2, y = (f32x2){o1[r], o1[r + 1]} * al2; o0[r] = x.x; o0[r + 1] = x.y; o1[r] = y.x; o1[r + 1] = y.y; }
            }
            bf16x8 pk[4];
#pragma unroll
            for (int j = 0; j < 2; ++j) { u32x4 a, c2;
                a.x = cvtpk(s0[8 * j], s0[8 * j + 1]); a.y = cvtpk(s0[8 * j + 2], s0[8 * j + 3]); a.z = cvtpk(s0[8 * j + 4], s0[8 * j + 5]); a.w = cvtpk(s0[8 * j + 6], s0[8 * j + 7]);
                c2.x = cvtpk(s1[8 * j], s1[8 * j + 1]); c2.y = cvtpk(s1[8 * j + 2], s1[8 * j + 3]); c2.z = cvtpk(s1[8 * j + 4], s1[8 * j + 5]); c2.w = cvtpk(s1[8 * j + 6], s1[8 * j + 7]);
                pk[j] = __builtin_bit_cast(bf16x8, a); pk[2 + j] = __builtin_bit_cast(bf16x8, c2); }
#pragma unroll
            for (int j = 0; j < 4; ++j) {
                const s16x4 a0 = vtr(vb + (16 * j) * VP), a1 = vtr(vb + (16 * j + 4) * VP), b0 = vtr(vb + (16 * j) * VP + 64), b1 = vtr(vb + (16 * j + 4) * VP + 64);
                const bf16x8 va = {a0[0], a0[1], a0[2], a0[3], a1[0], a1[1], a1[2], a1[3]}, vb8 = {b0[0], b0[1], b0[2], b0[3], b1[0], b1[1], b1[2], b1[3]};
                o0 = __builtin_amdgcn_mfma_f32_32x32x16_bf16(va, pk[j], o0, 0, 0, 0); o1 = __builtin_amdgcn_mfma_f32_32x32x16_bf16(vb8, pk[j], o1, 0, 0, 0);
            }
        }
        if (more) { *(LAS u32x4*)(lds + sn + kw_off) = kreg; *(LAS u32x4*)(lds + sn + vw_off) = vreg;
            if (MODE == 0 && tid < 256) *(LAS u32x4*)(lds + sn + rw_off) = rreg; }
        __syncthreads();
    }
    const float inv = __builtin_amdgcn_rcpf(xhalf_sum(l_run));
    bf16* op = O + (seq0 + qpos) * 1024 + hq * 64 + 4 * hi;
#pragma unroll
    for (int g = 0; g < 4; ++g) { u32x2 w0, w1;
        w0.x = cvtpk(o0[4 * g] * inv, o0[4 * g + 1] * inv); w0.y = cvtpk(o0[4 * g + 2] * inv, o0[4 * g + 3] * inv);
        w1.x = cvtpk(o1[4 * g] * inv, o1[4 * g + 1] * inv); w1.y = cvtpk(o1[4 * g + 2] * inv, o1[4 * g + 3] * inv);
        *(u32x2*)(op + 8 * g) = w0; *(u32x2*)(op + 32 + 8 * g) = w1; }
}
}


__device__ __forceinline__ void swa_unit(LAS unsigned char* lds, const bf16* __restrict__ Qs, const bf16* __restrict__ Ks, const bf16* __restrict__ Vs, bf16* O, const float* __restrict__ sinks, int b, int g, int n) {
    using namespace att;
    constexpr int STG = KBUF + VBUF;
    const int tid = threadIdx.x, lane = tid & 63, w = __builtin_amdgcn_readfirstlane(tid >> 6), l31 = lane & 31, hi = lane >> 5;
    const int tb = n == 0 ? 2 : 0, kpos_base = (n - 1) * 128; const long seq0 = (long)b * SEQ;
    { const int skey = tid >> 3, sch = tid & 7; u32x4 kr[4], vr[4];
#pragma unroll
      for (int t = 0; t < 4; ++t) if (t >= tb) { const long off = (seq0 + kpos_base + t * 64 + skey) * 128 + g * 64 + sch * 8; kr[t] = *(const u32x4*)(Ks + off); vr[t] = *(const u32x4*)(Vs + off); }
#pragma unroll
      for (int t = 0; t < 4; ++t) if (t >= tb) { *(LAS u32x4*)(lds + t * STG + skey * KP + sch * 16) = kr[t]; *(LAS u32x4*)(lds + t * STG + KBUF + skey * VP + sch * 16) = vr[t]; } }
    __syncthreads();
    const int pi = (l31 & 0x13) | ((l31 & 4) << 1) | ((l31 & 8) >> 1);
    const int kr_k = pi * KP + hi * 16;
    const int vr_v = KBUF + (8 * hi + ((lane & 15) >> 2)) * VP + (16 * ((lane >> 4) & 1) + 4 * (lane & 3)) * 2;
    const int a = w & 3, qpos = n * 128 + a * 32 + l31;
    const int t0 = a < 2 ? tb : (tb > 1 ? tb : 1), t1 = a < 2 ? 2 : 3;
#pragma unroll 1
    for (int hp = 0; hp < 4; ++hp) {
        const int hq = 8 * g + 2 * hp + (w >> 2);
        bf16x8 qf[4];
        { const bf16* qp = Qs + (seq0 + qpos) * 1024 + hq * 64 + hi * 8;
#pragma unroll
          for (int c = 0; c < 4; ++c) qf[c] = *(const bf16x8*)(qp + c * 16); }
        float m_run = sinks[hq] * LOG2E, l_run = hi == 0 ? 1.f : 0.f;
        f32x16 o0 = {}, o1 = {};
#pragma unroll 1
        for (int t = t0; t <= t1; ++t) {
            const LAS unsigned char* kb = lds + t * STG + kr_k; const LAS unsigned char* vb = lds + t * STG + vr_v;
            f32x16 s0 = {}, s1 = {};
#pragma unroll
            for (int c = 0; c < 4; ++c) { const bf16x8 k0 = *(const LAS bf16x8*)(kb + c * 32), k1 = *(const LAS bf16x8*)(kb + 32 * KP + c * 32);
                s0 = __builtin_amdgcn_mfma_f32_32x32x16_bf16(k0, qf[c], s0, 0, 0, 0); s1 = __builtin_amdgcn_mfma_f32_32x32x16_bf16(k1, qf[c], s1, 0, 0, 0); }
            const int kp0 = kpos_base + t * 64;
#pragma unroll
            for (int r = 0; r < 16; ++r) { const int rel0 = qpos - (kp0 + 16 * (r >> 3) + 8 * hi + (r & 7)), rel1 = rel0 - 32;
                s0[r] = (rel0 >= 0 && rel0 < 128) ? s0[r] : -1e30f; s1[r] = (rel1 >= 0 && rel1 < 128) ? s1[r] : -1e30f; }
            float mx = max2f(s0[0], s1[0]);
#pragma unroll
            for (int r = 1; r < 16; ++r) mx = max3f(mx, s0[r], s1[r]);
            mx = xhalf_max(mx);
            const float mnew = max2f(m_run, mx), alpha = __builtin_amdgcn_exp2f(m_run - mnew); m_run = mnew;
            float ps = 0.f;
#pragma unroll
            for (int r = 0; r < 16; ++r) { s0[r] = __builtin_amdgcn_exp2f(s0[r] - mnew); s1[r] = __builtin_amdgcn_exp2f(s1[r] - mnew); ps += s0[r] + s1[r]; }
            l_run = l_run * alpha + ps;
#pragma unroll
            for (int r = 0; r < 16; ++r) { o0[r] *= alpha; o1[r] *= alpha; }
            bf16x8 pk[4];
#pragma unroll
            for (int j = 0; j < 2; ++j) { u32x4 a_, c_;
                a_.x = cvtpk(s0[8 * j], s0[8 * j + 1]); a_.y = cvtpk(s0[8 * j + 2], s0[8 * j + 3]); a_.z = cvtpk(s0[8 * j + 4], s0[8 * j + 5]); a_.w = cvtpk(s0[8 * j + 6], s0[8 * j + 7]);
                c_.x = cvtpk(s1[8 * j], s1[8 * j + 1]); c_.y = cvtpk(s1[8 * j + 2], s1[8 * j + 3]); c_.z = cvtpk(s1[8 * j + 4], s1[8 * j + 5]); c_.w = cvtpk(s1[8 * j + 6], s1[8 * j + 7]);
                pk[j] = __builtin_bit_cast(bf16x8, a_); pk[2 + j] = __builtin_bit_cast(bf16x8, c_); }
#pragma unroll
            for (int j = 0; j < 4; ++j) {
                const s16x4 a0 = vtr(vb + (16 * j) * VP), a1 = vtr(vb + (16 * j + 4) * VP), b0 = vtr(vb + (16 * j) * VP + 64), b1 = vtr(vb + (16 * j + 4) * VP + 64);
                const bf16x8 va = {a0[0], a0[1], a0[2], a0[3], a1[0], a1[1], a1[2], a1[3]}, vb8 = {b0[0], b0[1], b0[2], b0[3], b1[0], b1[1], b1[2], b1[3]};
                o0 = __builtin_amdgcn_mfma_f32_32x32x16_bf16(va, pk[j], o0, 0, 0, 0); o1 = __builtin_amdgcn_mfma_f32_32x32x16_bf16(vb8, pk[j], o1, 0, 0, 0); }
        }
        const float inv = __builtin_amdgcn_rcpf(xhalf_sum(l_run));
        bf16* op = O + (seq0 + qpos) * 1024 + hq * 64 + 4 * hi;
#pragma unroll
        for (int q4 = 0; q4 < 4; ++q4) { u32x2 w0, w1;
            w0.x = cvtpk(o0[4 * q4] * inv, o0[4 * q4 + 1] * inv); w0.y = cvtpk(o0[4 * q4 + 2] * inv, o0[4 * q4 + 3] * inv);
            w1.x = cvtpk(o1[4 * q4] * inv, o1[4 * q4 + 1] * inv); w1.y = cvtpk(o1[4 * q4 + 2] * inv, o1[4 * q4 + 3] * inv);
            *(u32x2*)(op + 8 * q4) = w0; *(u32x2*)(op + 32 + 8 * q4) = w1; }
    }
    __syncthreads();
}

__device__ __forceinline__ int swap45(int w) { return (w & 15) | (((w >> 4) & 1) << 5) | (((w >> 5) & 1) << 4); }
__device__ __forceinline__ int src_col(int which, int r) {
    switch (which) {
    case 0:
        if (r < 256) return r;
        if (r < 512) { const int p = r - 256; return p < 160 ? 256 + p : -1; }
        if (r < 1536) { const int p = r - 512; return 416 + (p & ~63) + swap45(p & 63); }
        if (r < 1792) { const int p = r - 1536; return p < 128 ? 1440 + (p & ~63) + swap45(p & 63) : 1568 + (p - 128); }
        return 1696 + (r - 1792);
    case 1:
        if (r < 1024) return (r >> 6) * 96 + (r & 63);
        { const int p = r - 1024; return (p >> 5) * 96 + 64 + (p & 31); }
    case 2:
        if (r < 1024) return (r >> 6) * 128 + (r & 63);
        { const int p = r - 1024; return (p >> 6) * 128 + 64 + (p & 63); }
    default: return r;
    }
}
__device__ __forceinline__ void transpose_item(const float* __restrict__ W, int Ks, int N, bf16* WT, int R, int Kd, int which, const float* __restrict__ gs, LAS float* scr, int item, int lane) {
    const int nblk = R / 32, kb = item / nblk, nb = item % nblk, k0 = 64 * kb, n0 = 32 * nb;
    const int sc = src_col(which, n0 + (lane & 31));
    float vals[32];
#pragma unroll
    for (int i = 0; i < 32; ++i) { const int k = k0 + 2 * i + (lane >> 5); float v = 0.f;
        if (sc >= 0 && k < Ks) { v = W[(size_t)k * N + sc]; if (gs) v *= gs[k]; }
        vals[i] = v; }
#pragma unroll
    for (int i = 0; i < 32; ++i) scr[(2 * i + (lane >> 5)) * 33 + (lane & 31)] = vals[i];
    asm volatile("s_waitcnt lgkmcnt(0)" ::: "memory");
    const int c = lane & 7;
#pragma unroll
    for (int j = 0; j < 4; ++j) { const int n = (lane >> 3) + 8 * j; const LAS float* s = scr + (8 * c) * 33 + n;
        u32x4 o; o.x = cvtpk(s[0 * 33], s[1 * 33]); o.y = cvtpk(s[2 * 33], s[3 * 33]); o.z = cvtpk(s[4 * 33], s[5 * 33]); o.w = cvtpk(s[6 * 33], s[7 * 33]);
        *(u32x4*)(WT + (size_t)(n0 + n) * Kd + k0 + 8 * c) = o; }
    asm volatile("s_waitcnt lgkmcnt(0)" ::: "memory");
}


__device__ __forceinline__ float sum16(const float* p) { const f32x4* q = (const f32x4*)p; const f32x4 a = q[0], b = q[1], c = q[2], d = q[3];
    return (((a[0] + a[1]) + (a[2] + a[3])) + ((b[0] + b[1]) + (b[2] + b[3]))) + (((c[0] + c[1]) + (c[2] + c[3])) + ((d[0] + d[1]) + (d[2] + d[3]))); }
template <bool FIRST>
__device__ __forceinline__ void rowpass(const float* xin, float* xo, const bf16* T, const float* part_t, const float* gpost, const float* gpre, bf16* XN, const float* part_e, float* rstd_e, int gw, int NGW, int lane) {
    for (int row0 = gw; row0 < M; row0 += 4 * NGW) {
        f32x4 xv[4][4]; u32x4 tw[4][2]; float rt[4];
#pragma unroll
        for (int r2 = 0; r2 < 4; ++r2) { const size_t row = (size_t)(row0 + r2 * NGW);
#pragma unroll
            for (int j = 0; j < 2; ++j) { const int col = 512 * j + 8 * lane; tw[r2][j] = *(const u32x4*)(T + row * DM + col);
                xv[r2][2 * j] = *(const f32x4*)(xin + row * DM + col); xv[r2][2 * j + 1] = *(const f32x4*)(xin + row * DM + col + 4); }
            rt[r2] = __builtin_amdgcn_rsqf(sum16(part_t + row * 16) * (1.0f / DM) + EPS); }
#pragma unroll
        for (int r2 = 0; r2 < 4; ++r2) { const size_t row = (size_t)(row0 + r2 * NGW); float ss = 0.f;
#pragma unroll
            for (int j = 0; j < 2; ++j) { const int col = 512 * j + 8 * lane;
                const f32x4 ta = unpack4((u32x2){tw[r2][j].x, tw[r2][j].y}), tb = unpack4((u32x2){tw[r2][j].z, tw[r2][j].w});
                const f32x4 ga = *(const f32x4*)(gpost + col), gb = *(const f32x4*)(gpost + col + 4);
                xv[r2][2 * j] += ta * rt[r2] * ga; xv[r2][2 * j + 1] += tb * rt[r2] * gb; ss += dot4(xv[r2][2 * j]) + dot4(xv[r2][2 * j + 1]);
                *(f32x4*)(xo + row * DM + col) = xv[r2][2 * j]; *(f32x4*)(xo + row * DM + col + 4) = xv[r2][2 * j + 1]; }
            if (FIRST) { const float r1 = __builtin_amdgcn_rsqf(wave_sum(ss) * (1.0f / DM) + EPS);
#pragma unroll
                for (int j = 0; j < 2; ++j) { const int col = 512 * j + 8 * lane; const f32x4 ga = *(const f32x4*)(gpre + col), gb = *(const f32x4*)(gpre + col + 4);
                    const u32x2 a = pack4(xv[r2][2 * j] * r1 * ga), b2 = pack4(xv[r2][2 * j + 1] * r1 * gb); *(u32x4*)(XN + row * DM + col) = (u32x4){a.x, a.y, b2.x, b2.y}; }
            } else {
#pragma unroll
                for (int j = 0; j < 2; ++j) { const int col = 512 * j + 8 * lane; const u32x2 a = pack4(xv[r2][2 * j]), b2 = pack4(xv[r2][2 * j + 1]); *(u32x4*)(XN + row * DM + col) = (u32x4){a.x, a.y, b2.x, b2.y}; }
                if (lane == 0) rstd_e[row] = __builtin_amdgcn_rsqf(sum16(part_e + row * 16) * (1.0f / DM) + EPS); }
        }
    }
}

#define XB_TMO      128
#define XB_XCNT(j)  (256  + 64 * (j))
#define XB_XSUB(j)  (1280 + 64 * (j))
#define XB_XGEN(j)  (2304 + 64 * (j))
#define XB_TOP      3328
#define XB_TOPGEN   3392
#define XCD_BAR_WORDS 3456
#define XB_SPIN_CAP (1u << 18)

__device__ __forceinline__ unsigned xb_ld(unsigned* p)              { return __hip_atomic_load(p, __ATOMIC_RELAXED, __HIP_MEMORY_SCOPE_AGENT); }
__device__ __forceinline__ unsigned xb_add(unsigned* p, unsigned v) { return __hip_atomic_fetch_add(p, v, __ATOMIC_RELAXED, __HIP_MEMORY_SCOPE_AGENT); }
__device__ __forceinline__ unsigned xb_xcc_id() { return (unsigned)__builtin_amdgcn_s_getreg((3 << 11) | 20) & 0xFu; }
#define XB_SPIN(cond, bar) do { unsigned _sp = 0; while (cond) { __builtin_amdgcn_s_sleep(1); \
    if ((++_sp & 255u) == 0u) { if (xb_ld(&(bar)[XB_TMO])) break; if (_sp > XB_SPIN_CAP) { atomicAdd(&(bar)[XB_TMO], 1u); break; } } } } while (0)

struct XcdBarrier {
    unsigned* bar; unsigned x;
    volatile LAS unsigned* st;
};

__device__ __forceinline__ XcdBarrier xcd_barrier_post(unsigned* bar, volatile LAS unsigned* st) {
    XcdBarrier b; b.bar = bar; b.x = xb_xcc_id(); b.st = st;
    if (threadIdx.x == 0) (void)xb_add(&bar[XB_XCNT(b.x)], 1u);
    return b;
}
__device__ __forceinline__ void xcd_barrier_complete(unsigned* bar, unsigned x, unsigned& nloc, unsigned& nx) {
    const unsigned G = gridDim.x * gridDim.y * gridDim.z;
    unsigned sum, cnt, mine, sp = 0u;
    for (;;) {
        sum = 0u; cnt = 0u; mine = 0u;
#pragma unroll
        for (unsigned j = 0; j < 16; ++j) { const unsigned c = xb_ld(&bar[XB_XCNT(j)]); sum += c; cnt += (c > 0u) ? 1u : 0u; mine = (j == x) ? c : mine; }
        if (sum == G) break;
        __builtin_amdgcn_s_sleep(1);
        if ((++sp & 255u) == 0u) { if (xb_ld(&bar[XB_TMO])) break; if (sp > XB_SPIN_CAP) { atomicAdd(&bar[XB_TMO], 1u); break; } }
    }
    nloc = mine > 0u ? mine : 1u; nx = cnt > 0u ? cnt : 1u;
}

__device__ __forceinline__ void xcd_barrier(const XcdBarrier& b) {
    asm volatile("s_waitcnt vmcnt(0)" ::: "memory");
    __syncthreads();
    if (threadIdx.x == 0) {
        unsigned* bar = b.bar;
        __builtin_amdgcn_s_waitcnt(0);
        unsigned nloc = b.st[0], nx = b.st[1];
        if (nloc == 0u) { xcd_barrier_complete(bar, b.x, nloc, nx); b.st[0] = nloc; b.st[1] = nx; }
        const unsigned old = xb_add(&bar[XB_XSUB(b.x)], 1u);
        const unsigned gen = old / nloc;
        if (old + 1u == (gen + 1u) * nloc) {
            __builtin_amdgcn_fence(__ATOMIC_RELEASE, "agent");
            asm volatile("s_waitcnt vmcnt(0)" ::: "memory");
            const unsigned og = xb_add(&bar[XB_TOP], 1u);
            const unsigned tg = og / nx;
            if (og + 1u == (tg + 1u) * nx) xb_add(&bar[XB_TOPGEN], 1u);
            else XB_SPIN(xb_ld(&bar[XB_TOPGEN]) == tg, bar);
            __builtin_amdgcn_fence(__ATOMIC_ACQUIRE, "agent");
            xb_add(&bar[XB_XGEN(b.x)], 1u);
            asm volatile("s_waitcnt vmcnt(0)" ::: "memory");
        } else {
            XB_SPIN(xb_ld(&bar[XB_XGEN(b.x)]) == gen, bar);
            __builtin_amdgcn_fence(__ATOMIC_ACQUIRE, "agent");
            asm volatile("s_waitcnt vmcnt(0)" ::: "memory");
        }
    }
    __syncthreads();
}

__global__ void __launch_bounds__(NWAVES * 64, 2) mega_fwd(Params P) {
    extern __shared__ __attribute__((aligned(16))) unsigned char lds_raw[];
    LAS unsigned char* lds = (LAS unsigned char*)lds_raw;
    const int tid = threadIdx.x, lane = tid & 63, wave = __builtin_amdgcn_readfirstlane(tid >> 6);
    const int G = gridDim.x, bx = blockIdx.x, vcu = (G % 8 == 0) ? (bx % 8) * (G / 8) + bx / 8 : bx;
    const int gw = vcu * NWAVES + wave, NGW = G * NWAVES;
    const int lo = P.ph_lo, hi = P.ph_hi;
#ifndef PH_MASK
#define PH_MASK 0x7ff
#endif
#define IN(k) (((PH_MASK >> (k)) & 1) && lo <= (k) && (k) < hi)
#ifdef PROBE_A
    unsigned long long t_a = 0, t_b = 0;
#define STAMP(id) do { if ((id) == PROBE_A) t_a = __builtin_amdgcn_s_memrealtime(); if ((id) == PROBE_B) t_b = __builtin_amdgcn_s_memrealtime(); } while (0)
#else
#define STAMP(id) do { } while (0)
#endif
    volatile LAS unsigned* bst = (volatile LAS unsigned*)(lds + 128 * 1024);
    if (tid < 2) bst[tid] = 0u;
    __syncthreads();
    XcdBarrier xbar = xcd_barrier_post((unsigned*)(P.ws + WS_CTL) + 1024, bst);
#define SEAM(k) do { if (IN(k) && IN((k) + 1)) { if (P.ph_hi > 64) cg::this_grid().sync(); else xcd_barrier(xbar); } STAMP((k) + 1); } while (0)
    STAMP(0);
#define tab ((const f32x2*)(P.ws + WS_TAB))
#define XN ((bf16*)(P.ws + WS_XN))
#define part_q ((float*)(P.ws + WS_PQ))
#define part_kv ((float*)(P.ws + WS_PKV))
#define part_t ((float*)(P.ws + WS_PT))
#define part_e ((float*)(P.ws + WS_PE))
#define rstd_e ((float*)(P.ws + WS_RSTDE))
#define gates ((bf16*)P.out)

    if (IN(0)) {
        LAS float* scr = (LAS float*)(lds + wave * 16384);
#define TR(IN_, KS, N_, R_, KD, WHICH, GSP, OFF) { const int nit = ((KD) / 64) * ((R_) / 32); for (; it < nit; it += nstep) transpose_item(P.in[IN_], KS, N_, (bf16*)(P.ws + (OFF)), R_, KD, WHICH, GSP, scr, it, lane); it -= nit; }
#define TR_LATE() do { \
        TR(5, 256, 1536, 1536, 256, 1, P.in[4], WS_WQKV) \
        TR(7, 128, 2048, 2048, 256, 2, P.in[6], WS_WQKV + (size_t)1536 * 256 * 2) \
        TR(9, 1024, 1024, 1024, 1024, 3, nullptr, WS_WUP) \
        TR(10, 1024, 1024, 1024, 1024, 3, nullptr, WS_WUP + (size_t)1024 * 1024 * 2) \
        TR(11, 1024, 1024, 1024, 1024, 3, nullptr, WS_WOUT) \
        TR(14, 1024, 4096, 4096, 1024, 3, nullptr, WS_W1) \
        TR(15, 4096, 1024, 1024, 4096, 3, nullptr, WS_W2) \
        TR(19, 1024, 1024, 1024, 1024, 3, nullptr, WS_WPG) \
        TR(17, 256, 1024, 1024, 256, 3, nullptr, WS_WPP) } while (0)
        { int it = gw; const int nstep = NGW;
          TR(3, 1024, 3744, N_IN_PAD, 1024, 0, nullptr, WS_WIN)
          if (G != 256) TR_LATE(); }
        { const float* x = P.in[0]; const float* g = P.in[2];
          for (int row0 = gw; row0 < M; row0 += 4 * NGW) {
              f32x4 v[4][4], pv[4]; float ss[4] = {0.f, 0.f, 0.f, 0.f};
#pragma unroll
              for (int r2 = 0; r2 < 4; ++r2) { const int row = row0 + r2 * NGW; const f32x4* xr = (const f32x4*)(x + (size_t)row * DM);
#pragma unroll
                  for (int j = 0; j < 4; ++j) v[r2][j] = xr[lane + 64 * j];
                  pv[r2] = ((const f32x4*)(P.in[1] + (size_t)row * 256))[lane]; }
#pragma unroll
              for (int r2 = 0; r2 < 4; ++r2) { const int row = row0 + r2 * NGW;
#pragma unroll
                  for (int j = 0; j < 4; ++j) ss[r2] += dot4(v[r2][j]);
                  const float rs = __builtin_amdgcn_rsqf(wave_sum(ss[r2]) * (1.0f / DM) + EPS);
#pragma unroll
                  for (int j = 0; j < 4; ++j) { const f32x4 gg = ((const f32x4*)g)[lane + 64 * j]; *(u32x2*)(XN + (size_t)row * DM + 4 * (lane + 64 * j)) = pack4(v[r2][j] * rs * gg); }
                  *(u32x2*)((bf16*)(P.ws + WS_PB) + (size_t)row * 256 + 4 * lane) = pack4(pv[r2]); }
          } }
        for (int i = (vcu * NWAVES + wave) * 64 + lane; i < SEQ * 32; i += NGW * 64) {
            const int pos = i >> 5, j = i & 31; const float inv = expf(-9.210340371976184f * (float)j * (2.0f / 64.0f)); const float ang = (float)pos * inv;
            ((f32x2*)(P.ws + WS_TAB))[i] = (f32x2){cosf(ang), sinf(ang)}; }
    }
    SEAM(0);
    if (IN(1)) {
        pg8::Gemm g{XN, (const bf16*)(P.ws + WS_WIN), M, N_IN_PAD, 1024}; Sched S = make_sched(G, bx, 15);
        EpiP1 E{(bf16*)(P.ws + WS_QA), (bf16*)(P.ws + WS_KVR), (bf16*)(P.ws + WS_KROPE), (bf16*)(P.ws + WS_QS), (bf16*)(P.ws + WS_KS), (bf16*)(P.ws + WS_VS), gates, part_q, part_kv, tab};
        pg8::gemm_phase<EpiP1, Sched, true, true>(lds, g, S, E);
        if (G == 256 && bx >= 128) {
            LAS float* scr = (LAS float*)(lds + wave * 16384);
            int it = (bx - 128) * NWAVES + wave; const int nstep = 128 * NWAVES;
            TR_LATE();
        }
    }
#undef TR
#undef TR_LATE
    SEAM(1);
    if (IN(2)) {
        pg8::Gemm g{(const bf16*)(P.ws + WS_QA), (const bf16*)(P.ws + WS_WQKV), 2 * M, 3584, 256};
        Sched S = make_sched(G, bx, 6); S.nseg = 2; S.nN[1] = 8; S.pmo[1] = 128; S.pno[1] = 6; S.start[1] = 768; S.start[2] = 768 + 1024;
        EpiP2 E{(bf16*)(P.ws + WS_QN), (bf16*)(P.ws + WS_QR), (bf16*)(P.ws + WS_KN), (bf16*)(P.ws + WS_VM), part_q, part_kv, tab};
        pg8::gemm_phase<EpiP2, Sched, true, true>(lds, g, S, E);
    }
    SEAM(2);
    if (IN(3)) {
        for (int U = vcu; U < 2048; U += G) {
            const int c8 = U & 255, i = U >> 8, bh = c8 >> 1, s = c8 & 1, k = i >> 1, qb = (i & 1) ? 15 - 2 * k - s : 2 * k + s;
            att::unit<0>(lds, (const bf16*)(P.ws + WS_QN), (const bf16*)(P.ws + WS_QR), (const bf16*)(P.ws + WS_KN), (const bf16*)(P.ws + WS_KROPE), (const bf16*)(P.ws + WS_VM), (bf16*)(P.ws + WS_QN), nullptr, bh >> 4, bh & 15, qb, 0);
        }
        STAMP(12);
        for (int U = vcu; U < 512; U += G) swa_unit(lds, (const bf16*)(P.ws + WS_QS), (const bf16*)(P.ws + WS_KS), (const bf16*)(P.ws + WS_VS), (bf16*)(P.ws + WS_QS), P.in[8], U >> 6, (U >> 5) & 1, U & 31);
    }
    SEAM(3);
    if (IN(4)) {
        pg8::Gemm g{(const bf16*)(P.ws + WS_QN), (const bf16*)(P.ws + WS_WUP), 2 * M, 2048, 1024}; Sched S = make_sched(G, bx, 4); S.pairs = 1;
        EpiP4 E{gates, XN, (bf16*)(P.ws + WS_QA)};
        pg8::gemm_phase<EpiP4, Sched, true, true>(lds, g, S, E);
    }
    SEAM(4);
    if (IN(5)) {
        pg8::Gemm g{XN, (const bf16*)(P.ws + WS_WOUT), M, 1024, 1024}; Sched S = make_sched(G, bx, 4);
        EpiT E{(bf16*)(P.ws + WS_T), part_t};
        pg8::gemm_phase<EpiT, Sched, true, true>(lds, g, S, E);
    }
    SEAM(5);
    if (IN(6)) rowpass<true>(P.in[0], P.out, (const bf16*)(P.ws + WS_T), part_t, P.in[12], P.in[13], XN, nullptr, nullptr, gw, NGW, lane);
    SEAM(6);
    if (IN(7)) {
        pg8::Gemm g{XN, (const bf16*)(P.ws + WS_W1), M, FF, 1024}; Sched S = make_sched(G, bx, 16);
        EpiRelu2 E{(bf16*)(P.ws + WS_U)};
        pg8::gemm_phase<EpiRelu2, Sched, true, true>(lds, g, S, E);
    }
    SEAM(7);
    if (IN(8)) {
        { pg8::Gemm g{(const bf16*)(P.ws + WS_U), (const bf16*)(P.ws + WS_W2), M, 1024, FF}; Sched S = make_sched(G, bx, 4);
          EpiT E{(bf16*)(P.ws + WS_T), part_t};
          pg8::gemm_phase<EpiT, Sched, true, true>(lds, g, S, E); }
        { pg8::Gemm g{(const bf16*)(P.ws + WS_PB), (const bf16*)(P.ws + WS_WPP), M, 1024, 256}; Sched S = make_sched(G, bx, 4);
          EpiT E{(bf16*)(P.ws + WS_ERAW), part_e};
          pg8::gemm_phase<EpiT, Sched, true, true>(lds, g, S, E); }
    }
    SEAM(8);
    if (IN(9)) rowpass<false>(P.out, P.out, (const bf16*)(P.ws + WS_T), part_t, P.in[16], nullptr, XN, part_e, rstd_e, gw, NGW, lane);
    SEAM(9);
    if (IN(10)) {
        pg8::Gemm g{XN, (const bf16*)(P.ws + WS_WPG), M, 1024, 1024}; Sched S = make_sched(G, bx, 4);
        EpiOut E{P.out, (const bf16*)(P.ws + WS_ERAW), rstd_e, P.in[18]};
        pg8::gemm_phase<EpiOut, Sched, true, true>(lds, g, S, E);
    }
    STAMP(11);
#ifdef PROBE_A
    cg::this_grid().sync();
    STAMP(13); cg::this_grid().sync(); cg::this_grid().sync(); cg::this_grid().sync(); cg::this_grid().sync(); STAMP(14);
    if (bx == 0 && tid == 0) P.out[0] += (float)(((t_b - t_a) / PROBE_Q) * (PROBE_Q / 100ull));
#endif
#undef IN
#undef SEAM
#undef tab
#undef XN
#undef part_q
#undef part_kv
#undef part_t
#undef part_e
#undef rstd_e
#undef gates
}

extern "C" void kernel_launch(void* const* d_in, const int* in_sizes, int n_in, void* d_out, int out_size, void* d_ws, size_t ws_size, hipStream_t stream) {
    static int grid = 0;
    if (grid == 0) {
        int dev = 0, cus = 0, per_cu = 0;
        hipGetDevice(&dev); hipDeviceGetAttribute(&cus, hipDeviceAttributeMultiprocessorCount, dev);
        if (hipFuncSetAttribute((const void*)mega_fwd, hipFuncAttributeMaxDynamicSharedMemorySize, LDS_BYTES) != hipSuccess) { fprintf(stderr, "hipFuncSetAttribute failed\n"); }
        if (hipOccupancyMaxActiveBlocksPerMultiprocessor(&per_cu, (const void*)mega_fwd, NWAVES * 64, LDS_BYTES) != hipSuccess || per_cu < 1) { fprintf(stderr, "occupancy query: %d\n", per_cu); per_cu = 1; }
        (void)hipGetLastError();
        grid = cus * per_cu;
        if (n_in != 20 || ws_size < WS_END) fprintf(stderr, "kernel_launch: unexpected n_in %d / ws %zu\n", n_in, ws_size);
    }
    Params p{};
    for (int i = 0; i < 20; ++i) p.in[i] = (const float*)d_in[i];
    p.out = (float*)d_out; p.ws = (unsigned char*)d_ws;
#if MK_N_LAUNCHES == 1
    (void)hipMemsetAsync((unsigned char*)d_ws + WS_CTL, 0, CTL_BYTES, stream);
    p.ph_lo = 0; p.ph_hi = 11;
    void* args[] = {&p};
    hipError_t e = hipLaunchCooperativeKernel((const void*)mega_fwd, dim3(grid), dim3(NWAVES * 64), args, LDS_BYTES, stream);
    if (e != hipSuccess) fprintf(stderr, "cooperative launch failed: %s (grid %d)\n", hipGetErrorString(e), grid);
#else
    for (int k = 0; k < 11; ++k) { p.ph_lo = k; p.ph_hi = k + 1; hipLaunchKernelGGL(mega_fwd, dim3(grid), dim3(NWAVES * 64), LDS_BYTES, stream, p); }
#endif
}
```

```cpp
#include <hip/hip_runtime.h>
#include <hip/hip_cooperative_groups.h>
#include <cstdio>
#include <cstdint>
namespace cg = cooperative_groups;
#ifndef MK_N_LAUNCHES
#define MK_N_LAUNCHES 1
#endif
namespace pg8 {
#define PG8_LAS __attribute__((address_space(3)))
typedef unsigned short bf16_t;
typedef short bf16x8 __attribute__((ext_vector_type(8)));
typedef float f32x4 __attribute__((ext_vector_type(4)));
typedef unsigned u32x4 __attribute__((ext_vector_type(4)));
constexpr int BM = 256, BK = 64, HALF = 128, HTB = HALF * BK * 2  , STAGE_BYTES = 8 * HTB, NXCD = 8, WGM = 8;

__host__ __device__ __forceinline__ int lds_byte(int r, int c) { const int st = (r >> 4) * 2 + (c >> 5), rr = r & 15, cc = c & 31, ob = rr * 64 + cc * 2; return st * 1024 + (ob ^ (((ob >> 9) & 1) << 5)); }
__host__ __device__ __forceinline__ void stage_rc(int b, int& R, int& C) { const int st = b / 1024, sb = b % 1024, swz = sb ^ (((sb >> 9) & 1) << 5); R = (st >> 1) * 16 + swz / 64; C = (st & 1) * 32 + (swz % 64) / 2; }
__host__ __device__ __forceinline__ int perm32(int rho) { const int n = rho >> 4, i = rho & 15; return 8 * (i >> 2) + 4 * n + (i & 3); }

struct Unit { int pm, pn, kind; };
struct Gemm { const bf16_t* A; const bf16_t* Bt; int M, N, K; };

template <class Epi, class Sched, bool ALIGN_EPI = false, bool SP2 = false>
__device__ __forceinline__ void gemm_phase(PG8_LAS unsigned char* lds, const Gemm g, const Sched& S, const Epi& E) {
    const int tid = threadIdx.x, wid = __builtin_amdgcn_readfirstlane(tid >> 6), lane = tid & 63, wr = wid >> 2, wc = wid & 3, fr = lane & 15, fq = lane >> 4;
    int K_ = g.K; asm volatile("" : "+s"(K_));
    const int K = K_, nt = K / BK;
    unsigned voffA[2], voffB[2];
#pragma unroll
    for (int i = 0; i < 2; ++i) { int R, C; stage_rc(tid * 16 + i * 8192, R, C); const int Rb = Epi::PERM ? ((R & ~31) + perm32(R & 31)) : R;
        voffA[i] = (unsigned)(R * K + C) * 2u; voffB[i] = (unsigned)(Rb * K + C) * 2u; }
    const size_t kstep = (size_t)(BK * 2);
    const size_t hstep = (size_t)HALF * K * 2;
    const size_t tstep = 2 * hstep;
    const unsigned ldsw = (unsigned)wid * 1024u;
    const int aoff = lds_byte(wr * 64 + fr, fq * 8), boff = lds_byte(wc * 32 + fr, fq * 8);
#define PG8_SA(b, h) (((b) * 2 + (h)) * HTB)
#define PG8_SB(b, h) ((4 + (b) * 2 + (h)) * HTB)
#define PG8_STAGE(bufoff, gbase, voff) do { _Pragma("unroll") for (int _i = 0; _i < 2; ++_i) \
        __builtin_amdgcn_global_load_lds((const unsigned*)((const char*)(gbase) + (voff)[_i]), (PG8_LAS unsigned*)(lds + (bufoff) + ldsw + _i * 8192), 16, 0, 0); } while (0)
#define PG8_LDA(dst, b, h) do { _Pragma("unroll") for (int m = 0; m < 4; ++m) _Pragma("unroll") for (int k = 0; k < 2; ++k) dst[m][k] = *(const PG8_LAS bf16x8*)(lds + PG8_SA(b, h) + aoff + m * 2048 + k * 1024); } while (0)
#define PG8_LDB(dst, b, h) do { _Pragma("unroll") for (int n = 0; n < 2; ++n) _Pragma("unroll") for (int k = 0; k < 2; ++k) dst[n][k] = *(const PG8_LAS bf16x8*)(lds + PG8_SB(b, h) + boff + n * 2048 + k * 1024); } while (0)
#define PG8_MMA(ai, bj, At, Bt) do { __builtin_amdgcn_s_setprio(1); _Pragma("unroll") for (int m = 0; m < 4; ++m) _Pragma("unroll") for (int n = 0; n < 2; ++n) _Pragma("unroll") for (int k = 0; k < 2; ++k) \
        acc[ai][bj][m][n] = __builtin_amdgcn_mfma_f32_16x16x32_bf16(Bt[n][k], At[m][k], acc[ai][bj][m][n], 0, 0, 0); __builtin_amdgcn_s_setprio(0); } while (0)
#define PG8_WAIT_V(n) asm volatile("s_waitcnt vmcnt(" #n ")" ::: "memory")
#define PG8_WAIT_L(n) asm volatile("s_waitcnt lgkmcnt(" #n ")" ::: "memory")
#define PG8_BAR __builtin_amdgcn_s_barrier()
#define PG8_SCHED __builtin_amdgcn_sched_barrier(0)
    Unit cur, nxt; int ui = 0;
    if (!S.next(0, cur)) return;
    f32x4 acc[2][2][4][2];
#pragma unroll
    for (int a = 0; a < 2; ++a)
#pragma unroll
        for (int b = 0; b < 2; ++b)
#pragma unroll
            for (int m = 0; m < 4; ++m)
#pragma unroll
                for (int n = 0; n < 2; ++n) acc[a][b][m][n] = (f32x4){0.f, 0.f, 0.f, 0.f};
    bf16x8 At[4][2], B0[2][2], B1[2][2];
    const char* cA = (const char*)g.A + (size_t)cur.pm * tstep; const char* cB = (const char*)g.Bt + (size_t)cur.pn * tstep;
    S.a_ready(cur);
    if constexpr (SP2) {
        PG8_STAGE(PG8_SB(0, 0), cB, voffB); PG8_STAGE(PG8_SB(0, 1), cB + hstep, voffB); PG8_STAGE(PG8_SA(0, 0), cA, voffA); PG8_STAGE(PG8_SA(0, 1), cA + hstep, voffA);
        if (wr == 1) PG8_BAR;
        PG8_WAIT_V(2); PG8_BAR;
        PG8_STAGE(PG8_SB(1, 0), cB + kstep, voffB); PG8_STAGE(PG8_SA(1, 0), cA + kstep, voffA); PG8_STAGE(PG8_SB(1, 1), cB + hstep + kstep, voffB);
        PG8_WAIT_V(6); PG8_BAR;
    } else {
        PG8_STAGE(PG8_SB(0, 0), cB, voffB); PG8_STAGE(PG8_SA(0, 0), cA, voffA); PG8_STAGE(PG8_SB(0, 1), cB + hstep, voffB); PG8_STAGE(PG8_SA(0, 1), cA + hstep, voffA);
        if (wr == 1) PG8_BAR;
        PG8_WAIT_V(4); PG8_BAR;
        PG8_STAGE(PG8_SB(1, 0), cB + kstep, voffB); PG8_STAGE(PG8_SA(1, 0), cA + kstep, voffA); PG8_STAGE(PG8_SB(1, 1), cB + hstep + kstep, voffB);
        PG8_WAIT_V(6); PG8_BAR;
    }
    for (;;) {
        const bool has_next = S.next(ui + 1, nxt);
        const char* nA = has_next ? (const char*)g.A + (size_t)nxt.pm * tstep : cA; const char* nB = has_next ? (const char*)g.Bt + (size_t)nxt.pn * tstep : cB;
        for (int t = 0; t < nt; t += 2) {
            const bool last = (t == nt - 2);
            const char* a1 = cA + (size_t)(t + 1) * kstep;
            const char* a2 = last ? nA : cA + (size_t)(t + 2) * kstep; const char* b2 = last ? nB : cB + (size_t)(t + 2) * kstep;
            const char* a3 = a2 + kstep; const char* b3 = b2 + kstep;
            if (last && has_next) S.a_ready(nxt);
            if constexpr (SP2) {
            PG8_LDB(B0, 0, 0); PG8_LDB(B1, 0, 1); PG8_SCHED; PG8_LDA(At, 0, 0); PG8_STAGE(PG8_SA(1, 1), a1 + hstep, voffA);
            PG8_WAIT_V(8); PG8_WAIT_L(0); PG8_BAR; PG8_MMA(0, 0, At, B0); PG8_MMA(0, 1, At, B1); PG8_BAR; PG8_SCHED;
            PG8_LDA(At, 0, 1); PG8_STAGE(PG8_SB(0, 0), b2, voffB); PG8_STAGE(PG8_SB(0, 1), b2 + hstep, voffB); PG8_STAGE(PG8_SA(0, 0), a2, voffA);
            PG8_WAIT_V(8); PG8_WAIT_L(0); PG8_BAR; PG8_MMA(1, 0, At, B0); PG8_MMA(1, 1, At, B1); PG8_BAR; PG8_SCHED;
            PG8_LDB(B0, 1, 0); PG8_LDB(B1, 1, 1); PG8_SCHED; PG8_LDA(At, 1, 0); PG8_STAGE(PG8_SA(0, 1), a2 + hstep, voffA);
            PG8_WAIT_V(8); PG8_WAIT_L(0); PG8_BAR; PG8_MMA(0, 0, At, B0); PG8_MMA(0, 1, At, B1); PG8_BAR; PG8_SCHED;
            PG8_LDA(At, 1, 1); PG8_STAGE(PG8_SB(1, 0), b3, voffB); PG8_STAGE(PG8_SB(1, 1), b3 + hstep, voffB); PG8_STAGE(PG8_SA(1, 0), a3, voffA);
            PG8_WAIT_V(8); PG8_WAIT_L(0); PG8_BAR; PG8_MMA(1, 0, At, B0); PG8_MMA(1, 1, At, B1); PG8_BAR; PG8_SCHED;
            } else {
            PG8_LDB(B0, 0, 0); PG8_SCHED; PG8_LDA(At, 0, 0); PG8_STAGE(PG8_SA(1, 1), a1 + hstep, voffA);
            PG8_WAIT_L(8); PG8_BAR; PG8_WAIT_L(0); PG8_MMA(0, 0, At, B0); PG8_BAR; PG8_SCHED;
            PG8_LDB(B1, 0, 1); PG8_STAGE(PG8_SB(0, 0), b2, voffB);
            PG8_BAR; PG8_WAIT_L(0); PG8_MMA(0, 1, At, B1); PG8_BAR;
            PG8_LDA(At, 0, 1); PG8_STAGE(PG8_SA(0, 0), a2, voffA);
            PG8_BAR; PG8_WAIT_L(0); PG8_MMA(1, 0, At, B0); PG8_BAR; PG8_SCHED;
            PG8_STAGE(PG8_SB(0, 1), b2 + hstep, voffB);
            PG8_WAIT_V(6); PG8_BAR; PG8_MMA(1, 1, At, B1); PG8_BAR;
            PG8_LDB(B0, 1, 0); PG8_SCHED; PG8_LDA(At, 1, 0); PG8_STAGE(PG8_SA(0, 1), a2 + hstep, voffA);
            PG8_WAIT_L(8); PG8_BAR; PG8_WAIT_L(0); PG8_MMA(0, 0, At, B0); PG8_BAR; PG8_SCHED;
            PG8_LDB(B1, 1, 1); PG8_STAGE(PG8_SB(1, 0), b3, voffB);
            PG8_BAR; PG8_WAIT_L(0); PG8_MMA(0, 1, At, B1); PG8_BAR;
            PG8_LDA(At, 1, 1); PG8_STAGE(PG8_SA(1, 0), a3, voffA);
            PG8_BAR; PG8_WAIT_L(0); PG8_MMA(1, 0, At, B0); PG8_BAR; PG8_SCHED;
            PG8_STAGE(PG8_SB(1, 1), b3 + hstep, voffB);
            PG8_WAIT_V(6); PG8_BAR; PG8_MMA(1, 1, At, B1); PG8_BAR;
            }
        }
        if constexpr (ALIGN_EPI) { if (wr == 0) PG8_BAR; }
        if constexpr (!Epi::AFTER_DRAIN) { if (cur.kind & 0x100) E.mid(acc, cur, wr, wc, fr, fq); else E(acc, cur, wr, wc, fr, fq); S.done(cur); }
        if (!has_next) break;
        {
#pragma unroll
        for (int a = 0; a < 2; ++a)
#pragma unroll
            for (int b = 0; b < 2; ++b)
#pragma unroll
                for (int m = 0; m < 4; ++m)
#pragma unroll
                    for (int n = 0; n < 2; ++n) acc[a][b][m][n] = (f32x4){0.f, 0.f, 0.f, 0.f};
        }
        cur = nxt; cA = nA; cB = nB; ++ui;
        if constexpr (ALIGN_EPI) { if (wr == 1) PG8_BAR; }
    }
    PG8_WAIT_V(0);
    if constexpr (!ALIGN_EPI) { if (wr == 0) PG8_BAR; }
    PG8_BAR;
    if constexpr (Epi::AFTER_DRAIN) { E.fused(acc, cur, wr, wc, fr, fq, lds, wid, lane); S.done(cur); }
#undef PG8_SA
#undef PG8_SB
#undef PG8_STAGE
#undef PG8_LDA
#undef PG8_LDB
#undef PG8_MMA
#undef PG8_WAIT_V
#undef PG8_WAIT_L
#undef PG8_BAR
#undef PG8_SCHED
}
}

#define LAS __attribute__((address_space(3)))
typedef unsigned short bf16;
typedef float f32x4 __attribute__((ext_vector_type(4)));
typedef float f32x2 __attribute__((ext_vector_type(2)));
typedef float f32x16 __attribute__((ext_vector_type(16)));
typedef short bf16x8 __attribute__((ext_vector_type(8)));
typedef short s16x4 __attribute__((ext_vector_type(4)));
typedef unsigned u32x4 __attribute__((ext_vector_type(4)));
typedef unsigned u32x2 __attribute__((ext_vector_type(2)));
typedef __bf16 bf16x2_t __attribute__((ext_vector_type(2)));

constexpr int DM = 1024, SEQ = 4096, NB = 8, M = NB * SEQ, FF = 4096;
constexpr int NWAVES = 8;
constexpr float EPS = 1e-6f, LOG2E = 1.4426950408889634f;
constexpr float C2_MLA = 0.10206207261596575f * LOG2E;
constexpr float C2_SWA = 0.125f * LOG2E;
constexpr int N_IN_PAD = 3840;

constexpr size_t MiB = 1u << 20;
constexpr size_t WS_CTL = 0, CTL_BYTES = 65536;
constexpr size_t WS_TAB = 1 * MiB, WS_PQ = 2 * MiB, WS_PKV = 2 * MiB + 512 * 1024, WS_PT = 3 * MiB, WS_PE = 5 * MiB, WS_RSTDE = 7 * MiB;
constexpr size_t WS_WIN = 8 * MiB, WS_WQKV = 16 * MiB, WS_WPP = 18 * MiB, WS_WUP = 19 * MiB, WS_WOUT = 23 * MiB, WS_W1 = 25 * MiB, WS_W2 = 33 * MiB, WS_WPG = 41 * MiB;
constexpr size_t WS_XN = 48 * MiB, WS_QA = 112 * MiB, WS_KVR = 128 * MiB, WS_KS = 144 * MiB, WS_VS = 152 * MiB, WS_KROPE = 160 * MiB, WS_ERAW = 112 * MiB;
constexpr size_t WS_T = 176 * MiB, WS_QR = 176 * MiB, WS_PB = 240 * MiB;
constexpr size_t WS_QN = 256 * MiB, WS_QS = 320 * MiB, WS_KN = 384 * MiB, WS_VM = 448 * MiB, WS_U = 256 * MiB, WS_END = 512 * MiB;

constexpr int LDS_BYTES = 132 * 1024;

struct Params { const float* in[20]; float* out; unsigned char* ws; int ph_lo, ph_hi; };

__device__ __forceinline__ unsigned cvtpk(float lo, float hi) { f32x2 v = {lo, hi}; bf16x2_t b = __builtin_convertvector(v, bf16x2_t); return __builtin_bit_cast(unsigned, b); }
__device__ __forceinline__ u32x2 pack4(f32x4 v) { u32x2 r; r.x = cvtpk(v[0], v[1]); r.y = cvtpk(v[2], v[3]); return r; }
__device__ __forceinline__ float bf2f(unsigned short h) { return __builtin_bit_cast(float, (unsigned)h << 16); }
__device__ __forceinline__ f32x4 unpack4(u32x2 w) { f32x4 r; r[0] = __builtin_bit_cast(float, w.x << 16); r[1] = __builtin_bit_cast(float, w.x & 0xffff0000u); r[2] = __builtin_bit_cast(float, w.y << 16); r[3] = __builtin_bit_cast(float, w.y & 0xffff0000u); return r; }
__device__ __forceinline__ float sigmoidf_(float x) { return __builtin_amdgcn_rcpf(1.0f + __builtin_amdgcn_exp2f(-x * LOG2E)); }
__device__ __forceinline__ f32x4 sigmoid4(f32x4 v) { f32x4 r; r[0] = sigmoidf_(v[0]); r[1] = sigmoidf_(v[1]); r[2] = sigmoidf_(v[2]); r[3] = sigmoidf_(v[3]); return r; }
__device__ __forceinline__ float wave_sum(float v) {
#pragma unroll
    for (int o = 1; o < 64; o <<= 1) v += __shfl_xor(v, o);
    return v;
}
__device__ __forceinline__ float dot4(f32x4 v) { return (v[0] * v[0] + v[1] * v[1]) + (v[2] * v[2] + v[3] * v[3]); }

struct Sched {
    int G, c, nseg, pairs;
    int nN[2], pmo[2], pno[2], start[3];
    __device__ __forceinline__ bool next(int i, pg8::Unit& u) const {
        const int ii = pairs ? (i >> 1) : i;
        const long L = (long)ii * G + c; if (L >= start[nseg]) return false;
        const int s = (nseg > 1 && L >= start[1]) ? 1 : 0; const int l = (int)L - start[s];
        const int nwg = start[s + 1] - start[s], q = nwg >> 3, id = (l & 7) * q + (l >> 3);
        const int nig = 8 * nN[s], gid = id / nig, r = id % nig;
        const int pm = gid * 8 + (r & 7), pn = r >> 3;
        u.pm = pmo[s] + pm; u.pn = pno[s] + pn; u.kind = u.pn;
        if (pairs) { if (i & 1) { u.pm += 128; u.pn += 4; u.kind = 0; } else u.kind = 0x100; }
        return true;
    }
    __device__ __forceinline__ void a_ready(const pg8::Unit&) const {}
    __device__ __forceinline__ void done(const pg8::Unit&) const {}
};
__device__ __forceinline__ Sched make_sched(int G, int c, int nN0) { Sched s; s.G = G; s.c = c; s.nseg = 1; s.pairs = 0; s.nN[0] = nN0; s.nN[1] = 1; s.pmo[0] = s.pmo[1] = 0; s.pno[0] = s.pno[1] = 0; s.start[0] = 0; s.start[1] = 128 * nN0; s.start[2] = s.start[1]; return s; }

typedef pg8::f32x4 A4;
#define EPI_ROWS(ai, m) for (int ai = 0; ai < 2; ++ai) _Pragma("unroll") for (int m = 0; m < 4; ++m)

struct EpiP1 {
    static constexpr bool PERM = true, AFTER_DRAIN = false;
    bf16 *qa, *kvr, *krope, *qs, *ks, *vs, *gates; float *part_q, *part_kv; const f32x2* tab;
    __device__ __forceinline__ void mid(const A4 (&acc)[2][2][4][2], const pg8::Unit& u, int wr, int wc, int fr, int fq) const {}
    __device__ __forceinline__ void operator()(const A4 (&acc)[2][2][4][2], const pg8::Unit& u, int wr, int wc, int fr, int fq) const {
        const int pn = u.kind, row0 = u.pm * 256 + wr * 64 + fr, cl8 = wc * 32 + fq * 8;
        if (pn <= 1) {
            bf16* dst = pn == 0 ? qa : kvr; float* part = pn == 0 ? part_q : part_kv;
#pragma unroll
            EPI_ROWS(ai, m) { const int row = row0 + ai * 128 + m * 16; float ss = 0.f;
#pragma unroll
                for (int bj = 0; bj < 2; ++bj) { const A4 v0 = acc[ai][bj][m][0], v1 = acc[ai][bj][m][1]; if (pn == 0 || bj == 0) ss += dot4(v0) + dot4(v1);
                    const u32x2 a = pack4(v0), b2 = pack4(v1); *(u32x4*)(dst + (size_t)row * 256 + bj * 128 + cl8) = (u32x4){a.x, a.y, b2.x, b2.y}; }
                ss += __shfl_xor(ss, 16); ss += __shfl_xor(ss, 32);
                if (fq == 0) part[(size_t)row * 4 + wc] = ss;
                if (pn == 1 && wc == 0) {
                    const int pos = row & (SEQ - 1); const A4 x1 = acc[ai][1][m][0], x2 = acc[ai][1][m][1]; A4 o1, o2;
#pragma unroll
                    for (int e = 0; e < 4; ++e) { const f32x2 cs = tab[pos * 32 + 2 * (4 * fq + e)]; o1[e] = x1[e] * cs.x - x2[e] * cs.y; o2[e] = x2[e] * cs.x + x1[e] * cs.y; }
                    *(u32x2*)(krope + (size_t)row * 32 + 4 * fq) = pack4(o1); *(u32x2*)(krope + (size_t)row * 32 + 16 + 4 * fq) = pack4(o2);
                }
            }
        } else if (pn <= 6) {
            const int d1 = 16 * (wc & 1) + 4 * fq;
            f32x4 tb[2][2];
            { const int pos = row0 & (SEQ - 1); tb[0][0] = *(const f32x4*)(tab + pos * 32 + d1); tb[0][1] = *(const f32x4*)(tab + pos * 32 + d1 + 2); }
#pragma unroll
            for (int it = 0; it < 8; ++it) { const int ai = it >> 2, m = it & 3; const int row = row0 + ai * 128 + m * 16;
                if (it + 1 < 8) { const int pos = (row0 + ((it + 1) >> 2) * 128 + ((it + 1) & 3) * 16) & (SEQ - 1); tb[(it + 1) & 1][0] = *(const f32x4*)(tab + pos * 32 + d1); tb[(it + 1) & 1][1] = *(const f32x4*)(tab + pos * 32 + d1 + 2); }
                asm volatile("" ::: "memory");
                const f32x4 t0 = tb[it & 1][0], t1 = tb[it & 1][1];
                const float cc[4] = {t0[0], t0[2], t1[0], t1[2]}, sn[4] = {t0[1], t0[3], t1[1], t1[3]};
#pragma unroll
                for (int bj = 0; bj < 2; ++bj) {
                    if (pn == 6 && bj == 1) {
                        { const u32x2 a = pack4(acc[ai][1][m][0]), b2 = pack4(acc[ai][1][m][1]); *(u32x4*)(vs + (size_t)row * 128 + cl8) = (u32x4){a.x, a.y, b2.x, b2.y}; }
                    } else {
                        const A4 x1 = acc[ai][bj][m][0], x2 = acc[ai][bj][m][1]; A4 o1, o2; const float sc = pn == 6 ? 1.0f : C2_SWA;
#pragma unroll
                        for (int e = 0; e < 4; ++e) { o1[e] = (x1[e] * cc[e] - x2[e] * sn[e]) * sc; o2[e] = (x2[e] * cc[e] + x1[e] * sn[e]) * sc; }
                        bf16* d = pn == 6 ? ks + (size_t)row * 128 + (wc >> 1) * 64 : qs + (size_t)row * 1024 + ((pn - 2) * 4 + bj * 2 + (wc >> 1)) * 64;
                        *(u32x2*)(d + d1) = pack4(o1); *(u32x2*)(d + 32 + d1) = pack4(o2);
                    }
                }
            }
        } else {
#pragma unroll
            EPI_ROWS(ai, m) { const int row = row0 + ai * 128 + m * 16;
#pragma unroll
                for (int bj = 0; bj < 2; ++bj) { const u32x2 a = pack4(sigmoid4(acc[ai][bj][m][0])), b2 = pack4(sigmoid4(acc[ai][bj][m][1]));
                    *(u32x4*)(gates + (size_t)row * 2048 + (pn - 7) * 256 + bj * 128 + cl8) = (u32x4){a.x, a.y, b2.x, b2.y}; }
            }
        }
    }
};

struct EpiP2 {
    static constexpr bool PERM = true, AFTER_DRAIN = false;
    bf16 *qn, *qr, *kn, *vm; const float *part_q, *part_kv; const f32x2* tab;
    __device__ __forceinline__ void mid(const A4 (&acc)[2][2][4][2], const pg8::Unit& u, int wr, int wc, int fr, int fq) const {}
    __device__ __forceinline__ void operator()(const A4 (&acc)[2][2][4][2], const pg8::Unit& u, int wr, int wc, int fr, int fq) const {
        const int pn = u.kind, row0 = (u.pm & 127) * 256 + wr * 64 + fr, cl8 = wc * 32 + fq * 8;
        const bool isq = pn < 6, isrope = pn == 4 || pn == 5; const float* part = isq ? part_q : part_kv; const float invn = isq ? (1.0f / 256.0f) : (1.0f / 128.0f);
        f32x4 pp[2]; f32x4 tb[2][2];
        pp[0] = *(const f32x4*)(part + (size_t)row0 * 4);
        if (isrope) { const int pos = row0 & (SEQ - 1); tb[0][0] = *(const f32x4*)(tab + pos * 32 + 8 * fq); tb[0][1] = *(const f32x4*)(tab + pos * 32 + 8 * fq + 4); }
        f32x4 tc[2][2];
        if (isrope) { const int pos = row0 & (SEQ - 1); tc[0][0] = *(const f32x4*)(tab + pos * 32 + 8 * fq + 2); tc[0][1] = *(const f32x4*)(tab + pos * 32 + 8 * fq + 6); }
#pragma unroll
        for (int it = 0; it < 8; ++it) { const int ai = it >> 2, m = it & 3; const int row = row0 + ai * 128 + m * 16;
            if (it + 1 < 8) { const int rn = row0 + ((it + 1) >> 2) * 128 + ((it + 1) & 3) * 16; pp[(it + 1) & 1] = *(const f32x4*)(part + (size_t)rn * 4);
                if (isrope) { const int pos = rn & (SEQ - 1); tb[(it + 1) & 1][0] = *(const f32x4*)(tab + pos * 32 + 8 * fq); tb[(it + 1) & 1][1] = *(const f32x4*)(tab + pos * 32 + 8 * fq + 4);
                    tc[(it + 1) & 1][0] = *(const f32x4*)(tab + pos * 32 + 8 * fq + 2); tc[(it + 1) & 1][1] = *(const f32x4*)(tab + pos * 32 + 8 * fq + 6); } }
            asm volatile("" ::: "memory");
            const f32x4 p4 = pp[it & 1];
            float rs = __builtin_amdgcn_rsqf(((p4[0] + p4[1]) + (p4[2] + p4[3])) * invn + EPS);
            if (isq) rs *= C2_MLA;
            if (isrope) {
                const float cc[4] = {tb[it & 1][0][0], tc[it & 1][0][0], tb[it & 1][1][0], tc[it & 1][1][0]}, sn[4] = {tb[it & 1][0][1], tc[it & 1][0][1], tb[it & 1][1][1], tc[it & 1][1][1]};
#pragma unroll
                for (int bj = 0; bj < 2; ++bj) { const A4 x1 = acc[ai][bj][m][0], x2 = acc[ai][bj][m][1]; A4 o1, o2;
#pragma unroll
                    for (int e = 0; e < 4; ++e) { o1[e] = (x1[e] * cc[e] - x2[e] * sn[e]) * rs; o2[e] = (x2[e] * cc[e] + x1[e] * sn[e]) * rs; }
                    bf16* d = qr + (size_t)row * 512 + ((pn - 4) * 8 + bj * 4 + wc) * 32;
                    *(u32x2*)(d + 4 * fq) = pack4(o1); *(u32x2*)(d + 16 + 4 * fq) = pack4(o2); }
            } else {
                bf16* d = pn < 4 ? qn + (size_t)row * 1024 + pn * 256 : (pn < 10 ? kn + (size_t)row * 1024 + (pn - 6) * 256 : vm + (size_t)row * 1024 + (pn - 10) * 256);
#pragma unroll
                for (int bj = 0; bj < 2; ++bj) { const u32x2 a = pack4(acc[ai][bj][m][0] * rs), b2 = pack4(acc[ai][bj][m][1] * rs); *(u32x4*)(d + bj * 128 + cl8) = (u32x4){a.x, a.y, b2.x, b2.y}; }
            }
        }
    }
};

struct EpiP4 {
    static constexpr bool PERM = true, AFTER_DRAIN = false;
    const bf16* gates; bf16* y; bf16* ya;
    __device__ __forceinline__ void mid(const A4 (&acc)[2][2][4][2], const pg8::Unit& u, int wr, int wc, int fr, int fq) const {
        const int row0 = u.pm * 256 + wr * 64 + fr, col0 = u.pn * 256 + wc * 32 + fq * 8;
        u32x4 gq[2][2];
#define P4_LD(buf, it_) do { const bf16* g_ = gates + (size_t)(row0 + ((it_) >> 2) * 128 + ((it_) & 3) * 16) * 2048 + col0; \
        _Pragma("unroll") for (int bj = 0; bj < 2; ++bj) gq[buf][bj] = *(const u32x4*)(g_ + bj * 128); } while (0)
        P4_LD(0, 0);
#pragma unroll
        for (int it = 0; it < 8; ++it) { const int ai = it >> 2, m = it & 3; const size_t row = (size_t)(row0 + ai * 128 + m * 16);
            if (it + 1 < 8) P4_LD((it + 1) & 1, it + 1);
            asm volatile("" ::: "memory");
#pragma unroll
            for (int bj = 0; bj < 2; ++bj) { const u32x4 g4 = gq[it & 1][bj];
                const u32x2 a = pack4(acc[ai][bj][m][0] * unpack4((u32x2){g4.x, g4.y})), b2 = pack4(acc[ai][bj][m][1] * unpack4((u32x2){g4.z, g4.w}));
                *(u32x4*)(ya + row * 1024 + col0 + bj * 128) = (u32x4){a.x, a.y, b2.x, b2.y}; }
        }
#undef P4_LD
    }
    __device__ __forceinline__ void operator()(const A4 (&acc)[2][2][4][2], const pg8::Unit& u, int wr, int wc, int fr, int fq) const {
        const int row0 = (u.pm - 128) * 256 + wr * 64 + fr, col0 = (u.pn - 4) * 256 + wc * 32 + fq * 8;
        u32x4 gq[2][2], yq[2][2];
#define P4_LD(buf, it_) do { const size_t r_ = (size_t)(row0 + ((it_) >> 2) * 128 + ((it_) & 3) * 16); const bf16* g_ = gates + r_ * 2048 + 1024 + col0; const bf16* y_ = ya + r_ * 1024 + col0; \
        _Pragma("unroll") for (int bj = 0; bj < 2; ++bj) { gq[buf][bj] = *(const u32x4*)(g_ + bj * 128); yq[buf][bj] = *(const u32x4*)(y_ + bj * 128); } } while (0)
        P4_LD(0, 0);
#pragma unroll
        for (int it = 0; it < 8; ++it) { const int ai = it >> 2, m = it & 3; const size_t row = (size_t)(row0 + ai * 128 + m * 16);
            if (it + 1 < 8) P4_LD((it + 1) & 1, it + 1);
            asm volatile("" ::: "memory");
#pragma unroll
            for (int bj = 0; bj < 2; ++bj) { const u32x4 g4 = gq[it & 1][bj], y4 = yq[it & 1][bj];
                const u32x2 a = pack4(unpack4((u32x2){y4.x, y4.y}) + acc[ai][bj][m][0] * unpack4((u32x2){g4.x, g4.y})), b2 = pack4(unpack4((u32x2){y4.z, y4.w}) + acc[ai][bj][m][1] * unpack4((u32x2){g4.z, g4.w}));
                *(u32x4*)(y + row * 1024 + col0 + bj * 128) = (u32x4){a.x, a.y, b2.x, b2.y}; }
        }
#undef P4_LD
    }
};

struct EpiT {
    static constexpr bool PERM = true, AFTER_DRAIN = false;
    bf16* o; float* part;
    __device__ __forceinline__ void mid(const A4 (&acc)[2][2][4][2], const pg8::Unit& u, int wr, int wc, int fr, int fq) const {}
    __device__ __forceinline__ void operator()(const A4 (&acc)[2][2][4][2], const pg8::Unit& u, int wr, int wc, int fr, int fq) const {
        const int row0 = u.pm * 256 + wr * 64 + fr, col0 = u.pn * 256 + wc * 32 + fq * 8;
#pragma unroll
        EPI_ROWS(ai, m) { const size_t row = (size_t)(row0 + ai * 128 + m * 16); float ss = 0.f;
#pragma unroll
            for (int bj = 0; bj < 2; ++bj) { const A4 v0 = acc[ai][bj][m][0], v1 = acc[ai][bj][m][1]; ss += dot4(v0) + dot4(v1);
                const u32x2 a = pack4(v0), b2 = pack4(v1);
                *(u32x4*)(o + row * 1024 + col0 + bj * 128) = (u32x4){a.x, a.y, b2.x, b2.y}; }
            ss += __shfl_xor(ss, 16); ss += __shfl_xor(ss, 32);
            if (fq == 0) part[row * 16 + u.pn * 4 + wc] = ss;
        }
    }
};

struct EpiRelu2 {
    static constexpr bool PERM = true, AFTER_DRAIN = false;
    bf16* o;
    __device__ __forceinline__ void mid(const A4 (&acc)[2][2][4][2], const pg8::Unit& u, int wr, int wc, int fr, int fq) const {}
    __device__ __forceinline__ void operator()(const A4 (&acc)[2][2][4][2], const pg8::Unit& u, int wr, int wc, int fr, int fq) const {
        const int row0 = u.pm * 256 + wr * 64 + fr, col0 = u.pn * 256 + wc * 32 + fq * 8;
#pragma unroll
        EPI_ROWS(ai, m) { const size_t row = (size_t)(row0 + ai * 128 + m * 16);
#pragma unroll
            for (int bj = 0; bj < 2; ++bj) { A4 v0 = acc[ai][bj][m][0], v1 = acc[ai][bj][m][1];
#pragma unroll
                for (int e = 0; e < 4; ++e) { const float r0 = __builtin_fmaxf(v0[e], 0.f), r1 = __builtin_fmaxf(v1[e], 0.f); v0[e] = r0 * r0; v1[e] = r1 * r1; }
                const u32x2 a = pack4(v0), b2 = pack4(v1);
                *(u32x4*)(o + row * FF + col0 + bj * 128) = (u32x4){a.x, a.y, b2.x, b2.y}; }
        }
    }
};

struct EpiOut {
    static constexpr bool PERM = true, AFTER_DRAIN = false;
    float* out; const bf16* eraw; const float* rstd_e; const float* gple;
    __device__ __forceinline__ void mid(const A4 (&acc)[2][2][4][2], const pg8::Unit& u, int wr, int wc, int fr, int fq) const {}
    __device__ __forceinline__ void operator()(const A4 (&acc)[2][2][4][2], const pg8::Unit& u, int wr, int wc, int fr, int fq) const {
        const int row0 = u.pm * 256 + wr * 64 + fr, col0 = u.pn * 256 + wc * 32 + fq * 8;
        f32x4 gv[2][2];
#pragma unroll
        for (int bj = 0; bj < 2; ++bj)
#pragma unroll
            for (int n = 0; n < 2; ++n) gv[bj][n] = *(const f32x4*)(gple + col0 + bj * 128 + n * 4);
        f32x4 xq[2][2][2]; u32x4 eq[2][2]; float rq[2];
#define PO_LD(buf, it_) do { const size_t r_ = (size_t)(row0 + ((it_) >> 2) * 128 + ((it_) & 3) * 16); rq[buf] = rstd_e[r_]; \
        _Pragma("unroll") for (int bj = 0; bj < 2; ++bj) { const size_t off_ = r_ * 1024 + col0 + bj * 128; xq[buf][bj][0] = *(const f32x4*)(out + off_); xq[buf][bj][1] = *(const f32x4*)(out + off_ + 4); eq[buf][bj] = *(const u32x4*)(eraw + off_); } } while (0)
        PO_LD(0, 0);
#pragma unroll
        for (int it = 0; it < 8; ++it) { const int ai = it >> 2, m = it & 3; const size_t row = (size_t)(row0 + ai * 128 + m * 16);
            if (it + 1 < 8) PO_LD((it + 1) & 1, it + 1);
            asm volatile("" ::: "memory");
#pragma unroll
            for (int bj = 0; bj < 2; ++bj) { const size_t off = row * 1024 + col0 + bj * 128; const u32x4 e4 = eq[it & 1][bj];
                *(f32x4*)(out + off) = xq[it & 1][bj][0] + sigmoid4(acc[ai][bj][m][0]) * (unpack4((u32x2){e4.x, e4.y}) * rq[it & 1] * gv[bj][0]);
                *(f32x4*)(out + off + 4) = xq[it & 1][bj][1] + sigmoid4(acc[ai][bj][m][1]) * (unpack4((u32x2){e4.z, e4.w}) * rq[it & 1] * gv[bj][1]); }
        }
#undef PO_LD
    }
};

namespace att {
constexpr int KP = 208, VP = 192, KBUF = 64 * KP, VBUF = 64 * VP, STAGE = KBUF + VBUF;
__device__ __forceinline__ float max3f(float a, float b, float c) { float r; asm("v_max3_f32 %0, %1, %2, %3" : "=v"(r) : "v"(a), "v"(b), "v"(c)); return r; }
__device__ __forceinline__ float max2f(float a, float b) { float r; asm("v_max_f32_e32 %0, %1, %2" : "=v"(r) : "v"(a), "v"(b)); return r; }
__device__ __forceinline__ float xhalf_max(float v) { auto rr = __builtin_amdgcn_permlane32_swap(__float_as_uint(v), __float_as_uint(v), false, false); return max2f(__uint_as_float(rr[0]), __uint_as_float(rr[1])); }
__device__ __forceinline__ float xhalf_sum(float v) { auto rr = __builtin_amdgcn_permlane32_swap(__float_as_uint(v), __float_as_uint(v), false, false); return __uint_as_float(rr[0]) + __uint_as_float(rr[1]); }
__device__ __forceinline__ s16x4 vtr(const LAS unsigned char* p) { return __builtin_bit_cast(s16x4, __builtin_amdgcn_ds_read_tr16_b64_v4i16((LAS s16x4*)p)); }

template <int MODE>
__device__ __forceinline__ void unit(LAS unsigned char* lds, const bf16* __restrict__ Qa, const bf16* __restrict__ Qb, const bf16* __restrict__ Ka, const bf16* __restrict__ Kb, const bf16* __restrict__ Va, bf16* O,
                                     const float* __restrict__ sinks, int b, int h, int blk, int hp) {
    constexpr int NC = MODE == 0 ? 6 : 4;
    const int tid = threadIdx.x, lane = tid & 63, w = __builtin_amdgcn_readfirstlane(tid >> 6), l31 = lane & 31, hi = lane >> 5;
    int hq, qpos0w, t_beg, t_end, kpos_base; size_t krow_base; int kvpitch, kvcol;
    if (MODE == 0) { hq = h; qpos0w = blk * 256 + w * 32; t_beg = 0; t_end = 4 * blk + 4; kpos_base = 0; kvpitch = 1024; kvcol = h * 64; }
    else { hq = 8 * h + 2 * hp + (w >> 2); qpos0w = blk * 128 + (w & 3) * 32; t_beg = blk == 0 ? 2 : 0; t_end = 4; kpos_base = (blk - 1) * 128; kvpitch = 128; kvcol = h * 64; }
    const size_t seq0 = (size_t)b * SEQ;
    const int qpos = qpos0w + l31;
    bf16x8 qf[NC];
    { const bf16* qp = Qa + (seq0 + qpos) * 1024 + hq * 64 + hi * 8;
#pragma unroll
      for (int c = 0; c < 4; ++c) qf[c] = *(const bf16x8*)(qp + c * 16);
      if (MODE == 0) { const bf16* qp2 = Qb + (seq0 + qpos) * 512 + hq * 32 + hi * 8;
#pragma unroll
          for (int c = 4; c < NC; ++c) qf[c] = *(const bf16x8*)(qp2 + (c - 4) * 16); } }
    const int skey = tid >> 3, sch = tid & 7;
    const bf16* kg = Ka + ((long)seq0 + kpos_base + skey) * kvpitch + kvcol + sch * 8;
    const bf16* vg = Va + ((long)seq0 + kpos_base + skey) * kvpitch + kvcol + sch * 8;
    const bf16* rg = MODE == 0 ? Kb + (seq0 + (tid >> 2)) * 32 + (tid & 3) * 8 : nullptr;
    const int kw_off = skey * KP + sch * 16, vw_off = KBUF + skey * VP + sch * 16, rw_off = (tid >> 2) * KP + 128 + (tid & 3) * 16;
    const int pi = (l31 & 0x13) | ((l31 & 4) << 1) | ((l31 & 8) >> 1);
    const int kr_off = pi * KP + hi * 16;
    const int vr_off = KBUF + (8 * hi + ((lane & 15) >> 2)) * VP + (16 * ((lane >> 4) & 1) + 4 * (lane & 3)) * 2;
    float m_run, l_run;
    if (MODE == 0) { m_run = -1e30f; l_run = 0.f; } else { m_run = sinks[hq] * LOG2E; l_run = hi == 0 ? 1.f : 0.f; }
    f32x16 o0 = {}, o1 = {};
    u32x4 kreg, vreg, rreg = {};
    kreg = *(const u32x4*)(kg + (long)t_beg * 64 * kvpitch); vreg = *(const u32x4*)(vg + (long)t_beg * 64 * kvpitch);
    if (MODE == 0 && tid < 256) rreg = *(const u32x4*)(rg + (size_t)t_beg * 64 * 32);
    *(LAS u32x4*)(lds + kw_off) = kreg; *(LAS u32x4*)(lds + vw_off) = vreg;
    if (MODE == 0 && tid < 256) *(LAS u32x4*)(lds + rw_off) = rreg;
    __syncthreads();
    for (int t = t_beg; t < t_end; ++t) {
        const int st = ((t - t_beg) & 1) * STAGE, sn = STAGE - st;
        const bool more = t + 1 < t_end;
        if (more) { kreg = *(const u32x4*)(kg + (long)(t + 1) * 64 * kvpitch); vreg = *(const u32x4*)(vg + (long)(t + 1) * 64 * kvpitch);
            if (MODE == 0 && tid < 256) rreg = *(const u32x4*)(rg + (size_t)(t + 1) * 64 * 32); }
        const int kp0 = kpos_base + t * 64;
        bool doit, domask;
        if (MODE == 0) { doit = kp0 <= qpos0w + 31; domask = kp0 + 63 > qpos0w; }
        else { const int a = w & 3; doit = a < 2 ? (t <= 2) : (t >= 1); domask = true; }
        if (doit) {
            const LAS unsigned char* kb = lds + st + kr_off; const LAS unsigned char* vb = lds + st + vr_off;
            f32x16 s0 = {}, s1 = {};
#pragma unroll
            for (int c = 0; c < NC; ++c) { const bf16x8 k0 = *(const LAS bf16x8*)(kb + c * 32), k1 = *(const LAS bf16x8*)(kb + 32 * KP + c * 32);
                s0 = __builtin_amdgcn_mfma_f32_32x32x16_bf16(k0, qf[c], s0, 0, 0, 0); s1 = __builtin_amdgcn_mfma_f32_32x32x16_bf16(k1, qf[c], s1, 0, 0, 0); }
            if (domask) {
#pragma unroll
                for (int r = 0; r < 16; ++r) { const int kk = kp0 + 16 * (r >> 3) + 8 * hi + (r & 7); const int rel0 = qpos - kk, rel1 = rel0 - 32;
                    const bool ok0 = MODE == 0 ? rel0 >= 0 : (rel0 >= 0 && rel0 < 128), ok1 = MODE == 0 ? rel1 >= 0 : (rel1 >= 0 && rel1 < 128);
                    s0[r] = ok0 ? s0[r] : -1e30f; s1[r] = ok1 ? s1[r] : -1e30f; }
            }
            float mx = max2f(s0[0], s1[0]);
#pragma unroll
            for (int r = 1; r < 16; ++r) mx = max3f(mx, s0[r], s1[r]);
            mx = xhalf_max(mx);
            const float mnew = max2f(m_run, mx), alpha = __builtin_amdgcn_exp2f(m_run - mnew); m_run = mnew;
            f32x2 ps2 = {0.f, 0.f}; const f32x2 mn2 = {mnew, mnew};
#pragma unroll
            for (int r = 0; r < 16; r += 2) { f32x2 a2 = (f32x2){s0[r], s0[r + 1]} - mn2, b2 = (f32x2){s1[r], s1[r + 1]} - mn2;
                a2.x = __builtin_amdgcn_exp2f(a2.x); a2.y = __builtin_amdgcn_exp2f(a2.y); b2.x = __builtin_amdgcn_exp2f(b2.x); b2.y = __builtin_amdgcn_exp2f(b2.y);
                ps2 += a2; ps2 += b2; s0[r] = a2.x; s0[r + 1] = a2.y; s1[r] = b2.x; s1[r + 1] = b2.y; }
            l_run = l_run * alpha + (ps2.x + ps2.y);
            if (__builtin_amdgcn_ballot_w64(alpha != 1.0f) != 0ull) {
                const f32x2 al2 = {alpha, alpha};
#pragma unroll
                for (int r = 0; r < 16; r += 2) { f32x2 x = (f32x2){o0[r], o0[r + 1]} * al2, y = (f32x2){o1[r], o1[r + 1]} * al2; o0[r] = x.x; o0[r + 1] = x.y; o1[r] = y.x; o1[r + 1] = y.y; }
            }
            bf16x8 pk[4];
#pragma unroll
            for (int j = 0; j < 2; ++j) { u32x4 a, c2;
                a.x = cvtpk(s0[8 * j], s0[8 * j + 1]); a.y = cvtpk(s0[8 * j + 2], s0[8 * j + 3]); a.z = cvtpk(s0[8 * j + 4], s0[8 * j + 5]); a.w = cvtpk(s0[8 * j + 6], s0[8 * j + 7]);
                c2.x = cvtpk(s1[8 * j], s1[8 * j + 1]); c2.y = cvtpk(s1[8 * j + 2], s1[8 * j + 3]); c2.z = cvtpk(s1[8 * j + 4], s1[8 * j + 5]); c2.w = cvtpk(s1[8 * j + 6], s1[8 * j + 7]);
                pk[j] = __builtin_bit_cast(bf16x8, a); pk[2 + j] = __builtin_bit_cast(bf16x8, c2); }
#pragma unroll
            for (int j = 0; j < 4; ++j) {
                const s16x4 a0 = vtr(vb + (16 * j) * VP), a1 = vtr(vb + (16 * j + 4) * VP), b0 = vtr(vb + (16 * j) * VP + 64), b1 = vtr(vb + (16 * j + 4) * VP + 64);
                const bf16x8 va = {a0[0], a0[1], a0[2], a0[3], a1[0], a1[1], a1[2], a1[3]}, vb8 = {b0[0], b0[1], b0[2], b0[3], b1[0], b1[1], b1[2], b1[3]};
                o0 = __builtin_amdgcn_mfma_f32_32x32x16_bf16(va, pk[j], o0, 0, 0, 0); o1 = __builtin_amdgcn_mfma_f32_32x32x16_bf16(vb8, pk[j], o1, 0, 0, 0);
            }
        }
        if (more) { *(LAS u32x4*)(lds + sn + kw_off) = kreg; *(LAS u32x4*)(lds + sn + vw_off) = vreg;
            if (MODE == 0 && tid < 256) *(LAS u32x4*)(lds + sn + rw_off) = rreg; }
        __syncthreads();
    }
    const float inv = __builtin_amdgcn_rcpf(xhalf_sum(l_run));
    bf16* op = O + (seq0 + qpos) * 1024 + hq * 64 + 4 * hi;
#pragma unroll
    for (int g = 0; g < 4; ++g) { u32x2 w0, w1;
        w0.x = cvtpk(o0[4 * g] * inv, o0[4 * g + 1] * inv); w0.y = cvtpk(o0[4 * g + 2] * inv, o0[4 * g + 3] * inv);
        w1.x = cvtpk(o1[4 * g] * inv, o1[4 * g + 1] * inv); w1.y = cvtpk(o1[4 * g + 2] * inv, o1[4 * g + 3] * inv);
        *(u32x2*)(op + 8 * g) = w0; *(u32x2*)(op + 32 + 8 * g) = w1; }
}
}


__device__ __forceinline__ void swa_unit(LAS unsigned char* lds, const bf16* __restrict__ Qs, const bf16* __restrict__ Ks, const bf16* __restrict__ Vs, bf16* O, const float* __restrict__ sinks, int b, int g, int n) {
    using namespace att;
    constexpr int STG = KBUF + VBUF;
    const int tid = threadIdx.x, lane = tid & 63, w = __builtin_amdgcn_readfirstlane(tid >> 6), l31 = lane & 31, hi = lane >> 5;
    const int tb = n == 0 ? 2 : 0, kpos_base = (n - 1) * 128; const long seq0 = (long)b * SEQ;
    { const int skey = tid >> 3, sch = tid & 7; u32x4 kr[4], vr[4];
#pragma unroll
      for (int t = 0; t < 4; ++t) if (t >= tb) { const long off = (seq0 + kpos_base + t * 64 + skey) * 128 + g * 64 + sch * 8; kr[t] = *(const u32x4*)(Ks + off); vr[t] = *(const u32x4*)(Vs + off); }
#pragma unroll
      for (int t = 0; t < 4; ++t) if (t >= tb) { *(LAS u32x4*)(lds + t * STG + skey * KP + sch * 16) = kr[t]; *(LAS u32x4*)(lds + t * STG + KBUF + skey * VP + sch * 16) = vr[t]; } }
    __syncthreads();
    const int pi = (l31 & 0x13) | ((l31 & 4) << 1) | ((l31 & 8) >> 1);
    const int kr_k = pi * KP + hi * 16;
    const int vr_v = KBUF + (8 * hi + ((lane & 15) >> 2)) * VP + (16 * ((lane >> 4) & 1) + 4 * (lane & 3)) * 2;
    const int a = w & 3, qpos = n * 128 + a * 32 + l31;
    const int t0 = a < 2 ? tb : (tb > 1 ? tb : 1), t1 = a < 2 ? 2 : 3;
#pragma unroll 1
    for (int hp = 0; hp < 4; ++hp) {
        const int hq = 8 * g + 2 * hp + (w >> 2);
        bf16x8 qf[4];
        { const bf16* qp = Qs + (seq0 + qpos) * 1024 + hq * 64 + hi * 8;
#pragma unroll
          for (int c = 0; c < 4; ++c) qf[c] = *(const bf16x8*)(qp + c * 16); }
        float m_run = sinks[hq] * LOG2E, l_run = hi == 0 ? 1.f : 0.f;
        f32x16 o0 = {}, o1 = {};
#pragma unroll 1
        for (int t = t0; t <= t1; ++t) {
            const LAS unsigned char* kb = lds + t * STG + kr_k; const LAS unsigned char* vb = lds + t * STG + vr_v;
            f32x16 s0 = {}, s1 = {};
#pragma unroll
            for (int c = 0; c < 4; ++c) { const bf16x8 k0 = *(const LAS bf16x8*)(kb + c * 32), k1 = *(const LAS bf16x8*)(kb + 32 * KP + c * 32);
                s0 = __builtin_amdgcn_mfma_f32_32x32x16_bf16(k0, qf[c], s0, 0, 0, 0); s1 = __builtin_amdgcn_mfma_f32_32x32x16_bf16(k1, qf[c], s1, 0, 0, 0); }
            const int kp0 = kpos_base + t * 64;
#pragma unroll
            for (int r = 0; r < 16; ++r) { const int rel0 = qpos - (kp0 + 16 * (r >> 3) + 8 * hi + (r & 7)), rel1 = rel0 - 32;
                s0[r] = (rel0 >= 0 && rel0 < 128) ? s0[r] : -1e30f; s1[r] = (rel1 >= 0 && rel1 < 128) ? s1[r] : -1e30f; }
            float mx = max2f(s0[0], s1[0]);
#pragma unroll
            for (int r = 1; r < 16; ++r) mx = max3f(mx, s0[r], s1[r]);
            mx = xhalf_max(mx);
            const float mnew = max2f(m_run, mx), alpha = __builtin_amdgcn_exp2f(m_run - mnew); m_run = mnew;
            float ps = 0.f;
#pragma unroll
            for (int r = 0; r < 16; ++r) { s0[r] = __builtin_amdgcn_exp2f(s0[r] - mnew); s1[r] = __builtin_amdgcn_exp2f(s1[r] - mnew); ps += s0[r] + s1[r]; }
            l_run = l_run * alpha + ps;
#pragma unroll
            for (int r = 0; r < 16; ++r) { o0[r] *= alpha; o1[r] *= alpha; }
            bf16x8 pk[4];
#pragma unroll
            for (int j = 0; j < 2; ++j) { u32x4 a_, c_;
                a_.x = cvtpk(s0[8 * j], s0[8 * j + 1]); a_.y = cvtpk(s0[8 * j + 2], s0[8 * j + 3]); a_.z = cvtpk(s0[8 * j + 4], s0[8 * j + 5]); a_.w = cvtpk(s0[8 * j + 6], s0[8 * j + 7]);
                c_.x = cvtpk(s1[8 * j], s1[8 * j + 1]); c_.y = cvtpk(s1[8 * j + 2], s1[8 * j + 3]); c_.z = cvtpk(s1[8 * j + 4], s1[8 * j + 5]); c_.w = cvtpk(s1[8 * j + 6], s1[8 * j + 7]);
                pk[j] = __builtin_bit_cast(bf16x8, a_); pk[2 + j] = __builtin_bit_cast(bf16x8, c_); }
#pragma unroll
            for (int j = 0; j < 4; ++j) {
                const s16x4 a0 = vtr(vb + (16 * j) * VP), a1 = vtr(vb + (16 * j + 4) * VP), b0 = vtr(vb + (16 * j) * VP + 64), b1 = vtr(vb + (16 * j + 4) * VP + 64);
                const bf16x8 va = {a0[0], a0[1], a0[2], a0[3], a1[0], a1[1], a1[2], a1[3]}, vb8 = {b0[0], b0[1], b0[2], b0[3], b1[0], b1[1], b1[2], b1[3]};
                o0 = __builtin_amdgcn_mfma_f32_32x32x16_bf16(va, pk[j], o0, 0, 0, 0); o1 = __builtin_amdgcn_mfma_f32_32x32x16_bf16(vb8, pk[j], o1, 0, 0, 0); }
        }
        const float inv = __builtin_amdgcn_rcpf(xhalf_sum(l_run));
        bf16* op = O + (seq0 + qpos) * 1024 + hq * 64 + 4 * hi;
#pragma unroll
        for (int q4 = 0; q4 < 4; ++q4) { u32x2 w0, w1;
            w0.x = cvtpk(o0[4 * q4] * inv, o0[4 * q4 + 1] * inv); w0.y = cvtpk(o0[4 * q4 + 2] * inv, o0[4 * q4 + 3] * inv);
            w1.x = cvtpk(o1[4 * q4] * inv, o1[4 * q4 + 1] * inv); w1.y = cvtpk(o1[4 * q4 + 2] * inv, o1[4 * q4 + 3] * inv);
            *(u32x2*)(op + 8 * q4) = w0; *(u32x2*)(op + 32 + 8 * q4) = w1; }
    }
    __syncthreads();
}

__device__ __forceinline__ int rope64(int w) { return ((w >> 2) & 1) * 32 + ((w >> 5) & 1) * 16 + ((w >> 3) & 3) * 4 + (w & 3); }
__device__ __forceinline__ int rope32(int p) { return ((p >> 2) & 1) * 16 + ((p >> 3) & 3) * 4 + (p & 3); }
__device__ __forceinline__ int src_col(int which, int r) {
    switch (which) {
    case 0:
        if (r < 256) return r;
        if (r < 512) { const int p = r - 256; return p < 128 ? 256 + p : (p < 160 ? 384 + rope32(p - 128) : -1); }
        if (r < 1536) { const int p = r - 512; return 416 + (p & ~63) + rope64(p & 63); }
        if (r < 1792) { const int p = r - 1536; return p < 128 ? 1440 + (p & ~63) + rope64(p & 63) : 1568 + (p - 128); }
        return 1696 + (r - 1792);
    case 1:
        if (r < 1024) return (r >> 6) * 96 + (r & 63);
        { const int p = r - 1024; return (p >> 5) * 96 + 64 + rope32(p & 31); }
    case 2:
        if (r < 1024) return (r >> 6) * 128 + (r & 63);
        { const int p = r - 1024; return (p >> 6) * 128 + 64 + (p & 63); }
    default: return r;
    }
}
__device__ __forceinline__ void transpose_item(const float* __restrict__ W, int Ks, int N, bf16* WT, int R, int Kd, int which, const float* __restrict__ gs, LAS float* scr, int item, int lane) {
    const int nblk = R / 32, kb = item / nblk, nb = item % nblk, k0 = 64 * kb, n0 = 32 * nb;
    const int sc = src_col(which, n0 + (lane & 31));
    float vals[32];
#pragma unroll
    for (int i = 0; i < 32; ++i) { const int k = k0 + 2 * i + (lane >> 5); float v = 0.f;
        if (sc >= 0 && k < Ks) { v = W[(size_t)k * N + sc]; if (gs) v *= gs[k]; }
        vals[i] = v; }
#pragma unroll
    for (int i = 0; i < 32; ++i) scr[(2 * i + (lane >> 5)) * 33 + (lane & 31)] = vals[i];
    asm volatile("s_waitcnt lgkmcnt(0)" ::: "memory");
    const int c = lane & 7;
#pragma unroll
    for (int j = 0; j < 4; ++j) { const int n = (lane >> 3) + 8 * j; const LAS float* s = scr + (8 * c) * 33 + n;
        u32x4 o; o.x = cvtpk(s[0 * 33], s[1 * 33]); o.y = cvtpk(s[2 * 33], s[3 * 33]); o.z = cvtpk(s[4 * 33], s[5 * 33]); o.w = cvtpk(s[6 * 33], s[7 * 33]);
        *(u32x4*)(WT + (size_t)(n0 + n) * Kd + k0 + 8 * c) = o; }
    asm volatile("s_waitcnt lgkmcnt(0)" ::: "memory");
}


__device__ __forceinline__ float sum16(const float* p) { const f32x4* q = (const f32x4*)p; const f32x4 a = q[0], b = q[1], c = q[2], d = q[3];
    return (((a[0] + a[1]) + (a[2] + a[3])) + ((b[0] + b[1]) + (b[2] + b[3]))) + (((c[0] + c[1]) + (c[2] + c[3])) + ((d[0] + d[1]) + (d[2] + d[3]))); }
template <bool FIRST>
__device__ __forceinline__ void rowpass(const float* xin, float* xo, const bf16* T, const float* part_t, const float* gpost, const float* gpre, bf16* XN, const float* part_e, float* rstd_e, int gw, int NGW, int lane) {
    for (int row0 = gw; row0 < M; row0 += 4 * NGW) {
        f32x4 xv[4][4]; u32x4 tw[4][2]; float rt[4];
#pragma unroll
        for (int r2 = 0; r2 < 4; ++r2) { const size_t row = (size_t)(row0 + r2 * NGW);
#pragma unroll
            for (int j = 0; j < 2; ++j) { const int col = 512 * j + 8 * lane; tw[r2][j] = *(const u32x4*)(T + row * DM + col);
                xv[r2][2 * j] = *(const f32x4*)(xin + row * DM + col); xv[r2][2 * j + 1] = *(const f32x4*)(xin + row * DM + col + 4); }
            rt[r2] = __builtin_amdgcn_rsqf(sum16(part_t + row * 16) * (1.0f / DM) + EPS); }
#pragma unroll
        for (int r2 = 0; r2 < 4; ++r2) { const size_t row = (size_t)(row0 + r2 * NGW); float ss = 0.f;
#pragma unroll
            for (int j = 0; j < 2; ++j) { const int col = 512 * j + 8 * lane;
                const f32x4 ta = unpack4((u32x2){tw[r2][j].x, tw[r2][j].y}), tb = unpack4((u32x2){tw[r2][j].z, tw[r2][j].w});
                const f32x4 ga = *(const f32x4*)(gpost + col), gb = *(const f32x4*)(gpost + col + 4);
                xv[r2][2 * j] += ta * rt[r2] * ga; xv[r2][2 * j + 1] += tb * rt[r2] * gb; ss += dot4(xv[r2][2 * j]) + dot4(xv[r2][2 * j + 1]);
                *(f32x4*)(xo + row * DM + col) = xv[r2][2 * j]; *(f32x4*)(xo + row * DM + col + 4) = xv[r2][2 * j + 1]; }
            if (FIRST) { const float r1 = __builtin_amdgcn_rsqf(wave_sum(ss) * (1.0f / DM) + EPS);
#pragma unroll
                for (int j = 0; j < 2; ++j) { const int col = 512 * j + 8 * lane; const f32x4 ga = *(const f32x4*)(gpre + col), gb = *(const f32x4*)(gpre + col + 4);
                    const u32x2 a = pack4(xv[r2][2 * j] * r1 * ga), b2 = pack4(xv[r2][2 * j + 1] * r1 * gb); *(u32x4*)(XN + row * DM + col) = (u32x4){a.x, a.y, b2.x, b2.y}; }
            } else {
#pragma unroll
                for (int j = 0; j < 2; ++j) { const int col = 512 * j + 8 * lane; const u32x2 a = pack4(xv[r2][2 * j]), b2 = pack4(xv[r2][2 * j + 1]); *(u32x4*)(XN + row * DM + col) = (u32x4){a.x, a.y, b2.x, b2.y}; }
                if (lane == 0) rstd_e[row] = __builtin_amdgcn_rsqf(sum16(part_e + row * 16) * (1.0f / DM) + EPS); }
        }
    }
}

#define XB_TMO      128
#define XB_XCNT(j)  (256  + 64 * (j))
#define XB_XSUB(j)  (1280 + 64 * (j))
#define XB_XGEN(j)  (2304 + 64 * (j))
#define XB_TOP      3328
#define XB_TOPGEN   3392
#define XCD_BAR_WORDS 3456
#define XB_SPIN_CAP (1u << 18)

__device__ __forceinline__ unsigned xb_ld(unsigned* p)              { return __hip_atomic_load(p, __ATOMIC_RELAXED, __HIP_MEMORY_SCOPE_AGENT); }
__device__ __forceinline__ unsigned xb_add(unsigned* p, unsigned v) { return __hip_atomic_fetch_add(p, v, __ATOMIC_RELAXED, __HIP_MEMORY_SCOPE_AGENT); }
__device__ __forceinline__ unsigned xb_xcc_id() { return (unsigned)__builtin_amdgcn_s_getreg((3 << 11) | 20) & 0xFu; }
#define XB_SPIN(cond, bar) do { unsigned _sp = 0; while (cond) { __builtin_amdgcn_s_sleep(1); \
    if ((++_sp & 255u) == 0u) { if (xb_ld(&(bar)[XB_TMO])) break; if (_sp > XB_SPIN_CAP) { atomicAdd(&(bar)[XB_TMO], 1u); break; } } } } while (0)

struct XcdBarrier {
    unsigned* bar; unsigned x;
    volatile LAS unsigned* st;
};

__device__ __forceinline__ XcdBarrier xcd_barrier_post(unsigned* bar, volatile LAS unsigned* st) {
    XcdBarrier b; b.bar = bar; b.x = xb_xcc_id(); b.st = st;
    if (threadIdx.x == 0) (void)xb_add(&bar[XB_XCNT(b.x)], 1u);
    return b;
}
__device__ __forceinline__ void xcd_barrier_complete(unsigned* bar, unsigned x, unsigned& nloc, unsigned& nx) {
    const unsigned G = gridDim.x * gridDim.y * gridDim.z;
    unsigned sum, cnt, mine, sp = 0u;
    for (;;) {
        sum = 0u; cnt = 0u; mine = 0u;
#pragma unroll
        for (unsigned j = 0; j < 16; ++j) { const unsigned c = xb_ld(&bar[XB_XCNT(j)]); sum += c; cnt += (c > 0u) ? 1u : 0u; mine = (j == x) ? c : mine; }
        if (sum == G) break;
        __builtin_amdgcn_s_sleep(1);
        if ((++sp & 255u) == 0u) { if (xb_ld(&bar[XB_TMO])) break; if (sp > XB_SPIN_CAP) { atomicAdd(&bar[XB_TMO], 1u); break; } }
    }
    nloc = mine > 0u ? mine : 1u; nx = cnt > 0u ? cnt : 1u;
}

__device__ __forceinline__ void xcd_barrier(const XcdBarrier& b) {
    asm volatile("s_waitcnt vmcnt(0)" ::: "memory");
    __syncthreads();
    if (threadIdx.x == 0) {
        unsigned* bar = b.bar;
        __builtin_amdgcn_s_waitcnt(0);
        unsigned nloc = b.st[0], nx = b.st[1];
        if (nloc == 0u) { xcd_barrier_complete(bar, b.x, nloc, nx); b.st[0] = nloc; b.st[1] = nx; }
        const unsigned old = xb_add(&bar[XB_XSUB(b.x)], 1u);
        const unsigned gen = old / nloc;
        if (old + 1u == (gen + 1u) * nloc) {
            __builtin_amdgcn_fence(__ATOMIC_RELEASE, "agent");
            asm volatile("s_waitcnt vmcnt(0)" ::: "memory");
            const unsigned og = xb_add(&bar[XB_TOP], 1u);
            const unsigned tg = og / nx;
            if (og + 1u == (tg + 1u) * nx) xb_add(&bar[XB_TOPGEN], 1u);
            else XB_SPIN(xb_ld(&bar[XB_TOPGEN]) == tg, bar);
            __builtin_amdgcn_fence(__ATOMIC_ACQUIRE, "agent");
            xb_add(&bar[XB_XGEN(b.x)], 1u);
            asm volatile("s_waitcnt vmcnt(0)" ::: "memory");
        } else {
            XB_SPIN(xb_ld(&bar[XB_XGEN(b.x)]) == gen, bar);
            __builtin_amdgcn_fence(__ATOMIC_ACQUIRE, "agent");
            asm volatile("s_waitcnt vmcnt(0)" ::: "memory");
        }
    }
    __syncthreads();
}

__global__ void __launch_bounds__(NWAVES * 64, 2) mega_fwd(Params P) {
    extern __shared__ __attribute__((aligned(16))) unsigned char lds_raw[];
    LAS unsigned char* lds = (LAS unsigned char*)lds_raw;
    const int tid = threadIdx.x, lane = tid & 63, wave = __builtin_amdgcn_readfirstlane(tid >> 6);
    const int G = gridDim.x, bx = blockIdx.x, vcu = (G % 8 == 0) ? (bx % 8) * (G / 8) + bx / 8 : bx;
    const int gw = vcu * NWAVES + wave, NGW = G * NWAVES;
    const int lo = P.ph_lo, hi = P.ph_hi;
#ifndef PH_MASK
#define PH_MASK 0x7ff
#endif
#define IN(k) (((PH_MASK >> (k)) & 1) && lo <= (k) && (k) < hi)
#ifdef PROBE_A
    unsigned long long t_a = 0, t_b = 0;
#define STAMP(id) do { if ((id) == PROBE_A) t_a = __builtin_amdgcn_s_memrealtime(); if ((id) == PROBE_B) t_b = __builtin_amdgcn_s_memrealtime(); } while (0)
#else
#define STAMP(id) do { } while (0)
#endif
    volatile LAS unsigned* bst = (volatile LAS unsigned*)(lds + 128 * 1024);
    if (tid < 2) bst[tid] = 0u;
    __syncthreads();
    XcdBarrier xbar = xcd_barrier_post((unsigned*)(P.ws + WS_CTL) + 1024, bst);
#define SEAM(k) do { if (IN(k) && IN((k) + 1)) { if (P.ph_hi > 64) cg::this_grid().sync(); else xcd_barrier(xbar); } STAMP((k) + 1); } while (0)
    STAMP(0);
#define tab ((const f32x2*)(P.ws + WS_TAB))
#define XN ((bf16*)(P.ws + WS_XN))
#define part_q ((float*)(P.ws + WS_PQ))
#define part_kv ((float*)(P.ws + WS_PKV))
#define part_t ((float*)(P.ws + WS_PT))
#define part_e ((float*)(P.ws + WS_PE))
#define rstd_e ((float*)(P.ws + WS_RSTDE))
#define gates ((bf16*)P.out)

    if (IN(0)) {
        LAS float* scr = (LAS float*)(lds + wave * 16384);
#define TR(IN_, KS, N_, R_, KD, WHICH, GSP, OFF) { const int nit = ((KD) / 64) * ((R_) / 32); for (; it < nit; it += nstep) transpose_item(P.in[IN_], KS, N_, (bf16*)(P.ws + (OFF)), R_, KD, WHICH, GSP, scr, it, lane); it -= nit; }
#define TR_LATE() do { \
        TR(5, 256, 1536, 1536, 256, 1, P.in[4], WS_WQKV) \
        TR(7, 128, 2048, 2048, 256, 2, P.in[6], WS_WQKV + (size_t)1536 * 256 * 2) \
        TR(9, 1024, 1024, 1024, 1024, 3, nullptr, WS_WUP) \
        TR(10, 1024, 1024, 1024, 1024, 3, nullptr, WS_WUP + (size_t)1024 * 1024 * 2) \
        TR(11, 1024, 1024, 1024, 1024, 3, nullptr, WS_WOUT) \
        TR(14, 1024, 4096, 4096, 1024, 3, nullptr, WS_W1) \
        TR(15, 4096, 1024, 1024, 4096, 3, nullptr, WS_W2) \
        TR(19, 1024, 1024, 1024, 1024, 3, nullptr, WS_WPG) \
        TR(17, 256, 1024, 1024, 256, 3, nullptr, WS_WPP) } while (0)
        { int it = gw; const int nstep = NGW;
          TR(3, 1024, 3744, N_IN_PAD, 1024, 0, nullptr, WS_WIN)
          if (G != 256) TR_LATE(); }
        { const float* x = P.in[0]; const float* g = P.in[2];
          for (int row0 = gw; row0 < M; row0 += 4 * NGW) {
              f32x4 v[4][4], pv[4]; float ss[4] = {0.f, 0.f, 0.f, 0.f};
#pragma unroll
              for (int r2 = 0; r2 < 4; ++r2) { const int row = row0 + r2 * NGW; const f32x4* xr = (const f32x4*)(x + (size_t)row * DM);
#pragma unroll
                  for (int j = 0; j < 4; ++j) v[r2][j] = xr[lane + 64 * j];
                  pv[r2] = ((const f32x4*)(P.in[1] + (size_t)row * 256))[lane]; }
#pragma unroll
              for (int r2 = 0; r2 < 4; ++r2) { const int row = row0 + r2 * NGW;
#pragma unroll
                  for (int j = 0; j < 4; ++j) ss[r2] += dot4(v[r2][j]);
                  const float rs = __builtin_amdgcn_rsqf(wave_sum(ss[r2]) * (1.0f / DM) + EPS);
#pragma unroll
                  for (int j = 0; j < 4; ++j) { const f32x4 gg = ((const f32x4*)g)[lane + 64 * j]; *(u32x2*)(XN + (size_t)row * DM + 4 * (lane + 64 * j)) = pack4(v[r2][j] * rs * gg); }
                  *(u32x2*)((bf16*)(P.ws + WS_PB) + (size_t)row * 256 + 4 * lane) = pack4(pv[r2]); }
          } }
        for (int i = (vcu * NWAVES + wave) * 64 + lane; i < SEQ * 32; i += NGW * 64) {
            const int pos = i >> 5, j = i & 31; const float inv = expf(-9.210340371976184f * (float)j * (2.0f / 64.0f)); const float ang = (float)pos * inv;
            ((f32x2*)(P.ws + WS_TAB))[i] = (f32x2){cosf(ang), sinf(ang)}; }
    }
    SEAM(0);
    if (IN(1)) {
        pg8::Gemm g{XN, (const bf16*)(P.ws + WS_WIN), M, N_IN_PAD, 1024}; Sched S = make_sched(G, bx, 15);
        EpiP1 E{(bf16*)(P.ws + WS_QA), (bf16*)(P.ws + WS_KVR), (bf16*)(P.ws + WS_KROPE), (bf16*)(P.ws + WS_QS), (bf16*)(P.ws + WS_KS), (bf16*)(P.ws + WS_VS), gates, part_q, part_kv, tab};
        pg8::gemm_phase<EpiP1, Sched, true, true>(lds, g, S, E);
        if (G == 256 && bx >= 128) {
            LAS float* scr = (LAS float*)(lds + wave * 16384);
            int it = (bx - 128) * NWAVES + wave; const int nstep = 128 * NWAVES;
            TR_LATE();
        }
    }
#undef TR
#undef TR_LATE
    SEAM(1);
    if (IN(2)) {
        pg8::Gemm g{(const bf16*)(P.ws + WS_QA), (const bf16*)(P.ws + WS_WQKV), 2 * M, 3584, 256};
        Sched S = make_sched(G, bx, 6); S.nseg = 2; S.nN[1] = 8; S.pmo[1] = 128; S.pno[1] = 6; S.start[1] = 768; S.start[2] = 768 + 1024;
        EpiP2 E{(bf16*)(P.ws + WS_QN), (bf16*)(P.ws + WS_QR), (bf16*)(P.ws + WS_KN), (bf16*)(P.ws + WS_VM), part_q, part_kv, tab};
        pg8::gemm_phase<EpiP2, Sched, true, true>(lds, g, S, E);
    }
    SEAM(2);
    if (IN(3)) {
        for (int U = vcu; U < 2048; U += G) {
            const int c8 = U & 255, i = U >> 8, bh = c8 >> 1, s = c8 & 1, k = i >> 1, qb = (i & 1) ? 15 - 2 * k - s : 2 * k + s;
            att::unit<0>(lds, (const bf16*)(P.ws + WS_QN), (const bf16*)(P.ws + WS_QR), (const bf16*)(P.ws + WS_KN), (const bf16*)(P.ws + WS_KROPE), (const bf16*)(P.ws + WS_VM), (bf16*)(P.ws + WS_QN), nullptr, bh >> 4, bh & 15, qb, 0);
        }
        STAMP(12);
        for (int U = vcu; U < 512; U += G) swa_unit(lds, (const bf16*)(P.ws + WS_QS), (const bf16*)(P.ws + WS_KS), (const bf16*)(P.ws + WS_VS), (bf16*)(P.ws + WS_QS), P.in[8], U >> 6, (U >> 5) & 1, U & 31);
    }
    SEAM(3);
    if (IN(4)) {
        pg8::Gemm g{(const bf16*)(P.ws + WS_QN), (const bf16*)(P.ws + WS_WUP), 2 * M, 2048, 1024}; Sched S = make_sched(G, bx, 4); S.pairs = 1;
        EpiP4 E{gates, XN, (bf16*)(P.ws + WS_QA)};
        pg8::gemm_phase<EpiP4, Sched, true, true>(lds, g, S, E);
    }
    SEAM(4);
    if (IN(5)) {
        pg8::Gemm g{XN, (const bf16*)(P.ws + WS_WOUT), M, 1024, 1024}; Sched S = make_sched(G, bx, 4);
        EpiT E{(bf16*)(P.ws + WS_T), part_t};
        pg8::gemm_phase<EpiT, Sched, true, true>(lds, g, S, E);
    }
    SEAM(5);
    if (IN(6)) rowpass<true>(P.in[0], P.out, (const bf16*)(P.ws + WS_T), part_t, P.in[12], P.in[13], XN, nullptr, nullptr, gw, NGW, lane);
    SEAM(6);
    if (IN(7)) {
        pg8::Gemm g{XN, (const bf16*)(P.ws + WS_W1), M, FF, 1024}; Sched S = make_sched(G, bx, 16);
        EpiRelu2 E{(bf16*)(P.ws + WS_U)};
        pg8::gemm_phase<EpiRelu2, Sched, true, true>(lds, g, S, E);
    }
    SEAM(7);
    if (IN(8)) {
        { pg8::Gemm g{(const bf16*)(P.ws + WS_U), (const bf16*)(P.ws + WS_W2), M, 1024, FF}; Sched S = make_sched(G, bx, 4);
          EpiT E{(bf16*)(P.ws + WS_T), part_t};
          pg8::gemm_phase<EpiT, Sched, true, true>(lds, g, S, E); }
        { pg8::Gemm g{(const bf16*)(P.ws + WS_PB), (const bf16*)(P.ws + WS_WPP), M, 1024, 256}; Sched S = make_sched(G, bx, 4);
          EpiT E{(bf16*)(P.ws + WS_ERAW), part_e};
          pg8::gemm_phase<EpiT, Sched, true, true>(lds, g, S, E); }
    }
    SEAM(8);
    if (IN(9)) rowpass<false>(P.out, P.out, (const bf16*)(P.ws + WS_T), part_t, P.in[16], nullptr, XN, part_e, rstd_e, gw, NGW, lane);
    SEAM(9);
    if (IN(10)) {
        pg8::Gemm g{XN, (const bf16*)(P.ws + WS_WPG), M, 1024, 1024}; Sched S = make_sched(G, bx, 4);
        EpiOut E{P.out, (const bf16*)(P.ws + WS_ERAW), rstd_e, P.in[18]};
        pg8::gemm_phase<EpiOut, Sched, true, true>(lds, g, S, E);
    }
    STAMP(11);
#ifdef PROBE_A
    cg::this_grid().sync();
    STAMP(13); cg::this_grid().sync(); cg::this_grid().sync(); cg::this_grid().sync(); cg::this_grid().sync(); STAMP(14);
    if (bx == 0 && tid == 0) P.out[0] += (float)(((t_b - t_a) / PROBE_Q) * (PROBE_Q / 100ull));
#endif
#undef IN
#undef SEAM
#undef tab
#undef XN
#undef part_q
#undef part_kv
#undef part_t
#undef part_e
#undef rstd_e
#undef gates
}

extern "C" void kernel_launch(void* const* d_in, const int* in_sizes, int n_in, void* d_out, int out_size, void* d_ws, size_t ws_size, hipStream_t stream) {
    static int grid = 0;
    if (grid == 0) {
        int dev = 0, cus = 0, per_cu = 0;
        hipGetDevice(&dev); hipDeviceGetAttribute(&cus, hipDeviceAttributeMultiprocessorCount, dev);
        if (hipFuncSetAttribute((const void*)mega_fwd, hipFuncAttributeMaxDynamicSharedMemorySize, LDS_BYTES) != hipSuccess) { fprintf(stderr, "hipFuncSetAttribute failed\n"); }
        if (hipOccupancyMaxActiveBlocksPerMultiprocessor(&per_cu, (const void*)mega_fwd, NWAVES * 64, LDS_BYTES) != hipSuccess || per_cu < 1) { fprintf(stderr, "occupancy query: %d\n", per_cu); per_cu = 1; }
        (void)hipGetLastError();
        grid = cus * per_cu;
        if (n_in != 20 || ws_size < WS_END) fprintf(stderr, "kernel_launch: unexpected n_in %d / ws %zu\n", n_in, ws_size);
    }
    Params p{};
    for (int i = 0; i < 20; ++i) p.in[i] = (const float*)d_in[i];
    p.out = (float*)d_out; p.ws = (unsigned char*)d_ws;
#if MK_N_LAUNCHES == 1
    (void)hipMemsetAsync((unsigned char*)d_ws + WS_CTL, 0, CTL_BYTES, stream);
    p.ph_lo = 0; p.ph_hi = 11;
    void* args[] = {&p};
    hipError_t e = hipLaunchCooperativeKernel((const void*)mega_fwd, dim3(grid), dim3(NWAVES * 64), args, LDS_BYTES, stream);
    if (e != hipSuccess) fprintf(stderr, "cooperative launch failed: %s (grid %d)\n", hipGetErrorString(e), grid);
#else
    for (int k = 0; k < 11; ++k) { p.ph_lo = k; p.ph_hi = k + 1; hipLaunchKernelGGL(mega_fwd, dim3(grid), dim3(NWAVES * 64), LDS_BYTES, stream, p); }
#endif
}
```

```cpp
#include <hip/hip_runtime.h>
#include <hip/hip_cooperative_groups.h>
#include <cstdio>
#include <cstdint>
namespace cg = cooperative_groups;
#ifndef MK_N_LAUNCHES
#define MK_N_LAUNCHES 1
#endif
namespace pg8 {
#define PG8_LAS __attribute__((address_space(3)))
typedef unsigned short bf16_t;
typedef short bf16x8 __attribute__((ext_vector_type(8)));
typedef float f32x4 __attribute__((ext_vector_type(4)));
typedef unsigned u32x4 __attribute__((ext_vector_type(4)));
constexpr int BM = 256, BK = 64, HALF = 128, HTB = HALF * BK * 2  , STAGE_BYTES = 8 * HTB, NXCD = 8, WGM = 8;

__host__ __device__ __forceinline__ int lds_byte(int r, int c) { const int st = (r >> 4) * 2 + (c >> 5), rr = r & 15, cc = c & 31, ob = rr * 64 + cc * 2; return st * 1024 + (ob ^ (((ob >> 9) & 1) << 5)); }
__host__ __device__ __forceinline__ void stage_rc(int b, int& R, int& C) { const int st = b / 1024, sb = b % 1024, swz = sb ^ (((sb >> 9) & 1) << 5); R = (st >> 1) * 16 + swz / 64; C = (st & 1) * 32 + (swz % 64) / 2; }
__host__ __device__ __forceinline__ int perm32(int rho) { const int n = rho >> 4, i = rho & 15; return 8 * (i >> 2) + 4 * n + (i & 3); }

struct Unit { int pm, pn, kind; };
struct Gemm { const bf16_t* A; const bf16_t* Bt; int M, N, K; };

template <class Epi, class Sched, bool ALIGN_EPI = false, bool SP2 = false>
__device__ __forceinline__ void gemm_phase(PG8_LAS unsigned char* lds, const Gemm g, const Sched& S, const Epi& E) {
    const int tid = threadIdx.x, wid = __builtin_amdgcn_readfirstlane(tid >> 6), lane = tid & 63, wr = wid >> 2, wc = wid & 3, fr = lane & 15, fq = lane >> 4;
    int K_ = g.K; asm volatile("" : "+s"(K_));
    const int K = K_, nt = K / BK;
    unsigned voffA[2], voffB[2];
#pragma unroll
    for (int i = 0; i < 2; ++i) { int R, C; stage_rc(tid * 16 + i * 8192, R, C); const int Rb = Epi::PERM ? ((R & ~31) + perm32(R & 31)) : R;
        voffA[i] = (unsigned)(R * K + C) * 2u; voffB[i] = (unsigned)(Rb * K + C) * 2u; }
    const size_t kstep = (size_t)(BK * 2);
    const size_t hstep = (size_t)HALF * K * 2;
    const size_t tstep = 2 * hstep;
    const unsigned ldsw = (unsigned)wid * 1024u;
    const int aoff = lds_byte(wr * 64 + fr, fq * 8), boff = lds_byte(wc * 32 + fr, fq * 8);
#define PG8_SA(b, h) (((b) * 2 + (h)) * HTB)
#define PG8_SB(b, h) ((4 + (b) * 2 + (h)) * HTB)
#define PG8_STAGE(bufoff, gbase, voff) do { _Pragma("unroll") for (int _i = 0; _i < 2; ++_i) \
        __builtin_amdgcn_global_load_lds((const unsigned*)((const char*)(gbase) + (voff)[_i]), (PG8_LAS unsigned*)(lds + (bufoff) + ldsw + _i * 8192), 16, 0, 0); } while (0)
#define PG8_LDA(dst, b, h) do { _Pragma("unroll") for (int m = 0; m < 4; ++m) _Pragma("unroll") for (int k = 0; k < 2; ++k) dst[m][k] = *(const PG8_LAS bf16x8*)(lds + PG8_SA(b, h) + aoff + m * 2048 + k * 1024); } while (0)
#define PG8_LDB(dst, b, h) do { _Pragma("unroll") for (int n = 0; n < 2; ++n) _Pragma("unroll") for (int k = 0; k < 2; ++k) dst[n][k] = *(const PG8_LAS bf16x8*)(lds + PG8_SB(b, h) + boff + n * 2048 + k * 1024); } while (0)
#define PG8_MMA(ai, bj, At, Bt) do { __builtin_amdgcn_s_setprio(1); _Pragma("unroll") for (int m = 0; m < 4; ++m) _Pragma("unroll") for (int n = 0; n < 2; ++n) _Pragma("unroll") for (int k = 0; k < 2; ++k) \
        acc[ai][bj][m][n] = __builtin_amdgcn_mfma_f32_16x16x32_bf16(Bt[n][k], At[m][k], acc[ai][bj][m][n], 0, 0, 0); __builtin_amdgcn_s_setprio(0); } while (0)
#define PG8_WAIT_V(n) asm volatile("s_waitcnt vmcnt(" #n ")" ::: "memory")
#define PG8_WAIT_L(n) asm volatile("s_waitcnt lgkmcnt(" #n ")" ::: "memory")
#define PG8_BAR __builtin_amdgcn_s_barrier()
#define PG8_SCHED __builtin_amdgcn_sched_barrier(0)
    Unit cur, nxt; int ui = 0;
    if (!S.next(0, cur)) return;
    f32x4 acc[2][2][4][2];
#pragma unroll
    for (int a = 0; a < 2; ++a)
#pragma unroll
        for (int b = 0; b < 2; ++b)
#pragma unroll
            for (int m = 0; m < 4; ++m)
#pragma unroll
                for (int n = 0; n < 2; ++n) acc[a][b][m][n] = (f32x4){0.f, 0.f, 0.f, 0.f};
    bf16x8 At[4][2], B0[2][2], B1[2][2];
    const char* cA = (const char*)g.A + (size_t)cur.pm * tstep; const char* cB = (const char*)g.Bt + (size_t)cur.pn * tstep;
    S.a_ready(cur);
    if constexpr (SP2) {
        PG8_STAGE(PG8_SB(0, 0), cB, voffB); PG8_STAGE(PG8_SB(0, 1), cB + hstep, voffB); PG8_STAGE(PG8_SA(0, 0), cA, voffA); PG8_STAGE(PG8_SA(0, 1), cA + hstep, voffA);
        if (wr == 1) PG8_BAR;
        PG8_WAIT_V(2); PG8_BAR;
        PG8_STAGE(PG8_SB(1, 0), cB + kstep, voffB); PG8_STAGE(PG8_SA(1, 0), cA + kstep, voffA); PG8_STAGE(PG8_SB(1, 1), cB + hstep + kstep, voffB);
        PG8_WAIT_V(6); PG8_BAR;
    } else {
        PG8_STAGE(PG8_SB(0, 0), cB, voffB); PG8_STAGE(PG8_SA(0, 0), cA, voffA); PG8_STAGE(PG8_SB(0, 1), cB + hstep, voffB); PG8_STAGE(PG8_SA(0, 1), cA + hstep, voffA);
        if (wr == 1) PG8_BAR;
        PG8_WAIT_V(4); PG8_BAR;
        PG8_STAGE(PG8_SB(1, 0), cB + kstep, voffB); PG8_STAGE(PG8_SA(1, 0), cA + kstep, voffA); PG8_STAGE(PG8_SB(1, 1), cB + hstep + kstep, voffB);
        PG8_WAIT_V(6); PG8_BAR;
    }
    for (;;) {
        const bool has_next = S.next(ui + 1, nxt);
        const char* nA = has_next ? (const char*)g.A + (size_t)nxt.pm * tstep : cA; const char* nB = has_next ? (const char*)g.Bt + (size_t)nxt.pn * tstep : cB;
        for (int t = 0; t < nt; t += 2) {
            const bool last = (t == nt - 2);
            const char* a1 = cA + (size_t)(t + 1) * kstep;
            const char* a2 = last ? nA : cA + (size_t)(t + 2) * kstep; const char* b2 = last ? nB : cB + (size_t)(t + 2) * kstep;
            const char* a3 = a2 + kstep; const char* b3 = b2 + kstep;
            if (last && has_next) S.a_ready(nxt);
            if constexpr (SP2) {
            PG8_LDB(B0, 0, 0); PG8_LDB(B1, 0, 1); PG8_SCHED; PG8_LDA(At, 0, 0); PG8_STAGE(PG8_SA(1, 1), a1 + hstep, voffA);
            PG8_WAIT_V(8); PG8_WAIT_L(0); PG8_BAR; PG8_MMA(0, 0, At, B0); PG8_MMA(0, 1, At, B1); PG8_BAR; PG8_SCHED;
            PG8_LDA(At, 0, 1); PG8_STAGE(PG8_SB(0, 0), b2, voffB); PG8_STAGE(PG8_SB(0, 1), b2 + hstep, voffB); PG8_STAGE(PG8_SA(0, 0), a2, voffA);
            PG8_WAIT_V(8); PG8_WAIT_L(0); PG8_BAR; PG8_MMA(1, 0, At, B0); PG8_MMA(1, 1, At, B1); PG8_BAR; PG8_SCHED;
            PG8_LDB(B0, 1, 0); PG8_LDB(B1, 1, 1); PG8_SCHED; PG8_LDA(At, 1, 0); PG8_STAGE(PG8_SA(0, 1), a2 + hstep, voffA);
            PG8_WAIT_V(8); PG8_WAIT_L(0); PG8_BAR; PG8_MMA(0, 0, At, B0); PG8_MMA(0, 1, At, B1); PG8_BAR; PG8_SCHED;
            PG8_LDA(At, 1, 1); PG8_STAGE(PG8_SB(1, 0), b3, voffB); PG8_STAGE(PG8_SB(1, 1), b3 + hstep, voffB); PG8_STAGE(PG8_SA(1, 0), a3, voffA);
            PG8_WAIT_V(8); PG8_WAIT_L(0); PG8_BAR; PG8_MMA(1, 0, At, B0); PG8_MMA(1, 1, At, B1); PG8_BAR; PG8_SCHED;
            } else {
            PG8_LDB(B0, 0, 0); PG8_SCHED; PG8_LDA(At, 0, 0); PG8_STAGE(PG8_SA(1, 1), a1 + hstep, voffA);
            PG8_WAIT_L(8); PG8_BAR; PG8_WAIT_L(0); PG8_MMA(0, 0, At, B0); PG8_BAR; PG8_SCHED;
            PG8_LDB(B1, 0, 1); PG8_STAGE(PG8_SB(0, 0), b2, voffB);
            PG8_BAR; PG8_WAIT_L(0); PG8_MMA(0, 1, At, B1); PG8_BAR;
            PG8_LDA(At, 0, 1); PG8_STAGE(PG8_SA(0, 0), a2, voffA);
            PG8_BAR; PG8_WAIT_L(0); PG8_MMA(1, 0, At, B0); PG8_BAR; PG8_SCHED;
            PG8_STAGE(PG8_SB(0, 1), b2 + hstep, voffB);
            PG8_WAIT_V(6); PG8_BAR; PG8_MMA(1, 1, At, B1); PG8_BAR;
            PG8_LDB(B0, 1, 0); PG8_SCHED; PG8_LDA(At, 1, 0); PG8_STAGE(PG8_SA(0, 1), a2 + hstep, voffA);
            PG8_WAIT_L(8); PG8_BAR; PG8_WAIT_L(0); PG8_MMA(0, 0, At, B0); PG8_BAR; PG8_SCHED;
            PG8_LDB(B1, 1, 1); PG8_STAGE(PG8_SB(1, 0), b3, voffB);
            PG8_BAR; PG8_WAIT_L(0); PG8_MMA(0, 1, At, B1); PG8_BAR;
            PG8_LDA(At, 1, 1); PG8_STAGE(PG8_SA(1, 0), a3, voffA);
            PG8_BAR; PG8_WAIT_L(0); PG8_MMA(1, 0, At, B0); PG8_BAR; PG8_SCHED;
            PG8_STAGE(PG8_SB(1, 1), b3 + hstep, voffB);
            PG8_WAIT_V(6); PG8_BAR; PG8_MMA(1, 1, At, B1); PG8_BAR;
            }
        }
        if constexpr (ALIGN_EPI) { if (wr == 0) PG8_BAR; }
        if constexpr (!Epi::AFTER_DRAIN) { if (cur.kind & 0x100) E.mid(acc, cur, wr, wc, fr, fq); else E(acc, cur, wr, wc, fr, fq); S.done(cur); }
        if (!has_next) break;
        {
#pragma unroll
        for (int a = 0; a < 2; ++a)
#pragma unroll
            for (int b = 0; b < 2; ++b)
#pragma unroll
                for (int m = 0; m < 4; ++m)
#pragma unroll
                    for (int n = 0; n < 2; ++n) acc[a][b][m][n] = (f32x4){0.f, 0.f, 0.f, 0.f};
        }
        cur = nxt; cA = nA; cB = nB; ++ui;
        if constexpr (ALIGN_EPI) { if (wr == 1) PG8_BAR; }
    }
    PG8_WAIT_V(0);
    if constexpr (!ALIGN_EPI) { if (wr == 0) PG8_BAR; }
    PG8_BAR;
    if constexpr (Epi::AFTER_DRAIN) { E.fused(acc, cur, wr, wc, fr, fq, lds, wid, lane); S.done(cur); }
#undef PG8_SA
#undef PG8_SB
#undef PG8_STAGE
#undef PG8_LDA
#undef PG8_LDB
#undef PG8_MMA
#undef PG8_WAIT_V
#undef PG8_WAIT_L
#undef PG8_BAR
#undef PG8_SCHED
}
}

#define LAS __attribute__((address_space(3)))
typedef unsigned short bf16;
typedef float f32x4 __attribute__((ext_vector_type(4)));
typedef float f32x2 __attribute__((ext_vector_type(2)));
typedef float f32x16 __attribute__((ext_vector_type(16)));
typedef short bf16x8 __attribute__((ext_vector_type(8)));
typedef short s16x4 __attribute__((ext_vector_type(4)));
typedef unsigned u32x4 __attribute__((ext_vector_type(4)));
typedef unsigned u32x2 __attribute__((ext_vector_type(2)));
typedef __bf16 bf16x2_t __attribute__((ext_vector_type(2)));

constexpr int DM = 1024, SEQ = 4096, NB = 8, M = NB * SEQ, FF = 4096;
constexpr int NWAVES = 8;
constexpr float EPS = 1e-6f, LOG2E = 1.4426950408889634f;
constexpr float C2_MLA = 0.10206207261596575f * LOG2E;
constexpr float C2_SWA = 0.125f * LOG2E;
constexpr int N_IN_PAD = 3840;

constexpr size_t MiB = 1u << 20;
constexpr size_t WS_CTL = 0, CTL_BYTES = 65536;
constexpr size_t WS_TAB = 1 * MiB, WS_PQ = 2 * MiB, WS_PKV = 2 * MiB + 512 * 1024, WS_PT = 3 * MiB, WS_PE = 5 * MiB, WS_RSTDE = 7 * MiB;
constexpr size_t WS_WIN = 8 * MiB, WS_WQKV = 16 * MiB, WS_WPP = 18 * MiB, WS_WUP = 19 * MiB, WS_WOUT = 23 * MiB, WS_W1 = 25 * MiB, WS_W2 = 33 * MiB, WS_WPG = 41 * MiB;
constexpr size_t WS_XN = 48 * MiB, WS_QA = 112 * MiB, WS_KVR = 128 * MiB, WS_KS = 144 * MiB, WS_VS = 152 * MiB, WS_KROPE = 160 * MiB, WS_ERAW = 112 * MiB;
constexpr size_t WS_T = 176 * MiB, WS_QR = 176 * MiB, WS_PB = 240 * MiB;
constexpr size_t WS_QN = 256 * MiB, WS_QS = 320 * MiB, WS_KN = 384 * MiB, WS_VM = 448 * MiB, WS_U = 256 * MiB, WS_END = 512 * MiB;

constexpr int LDS_BYTES = 132 * 1024;

struct Params { const float* in[20]; float* out; unsigned char* ws; int ph_lo, ph_hi; };

__device__ __forceinline__ unsigned cvtpk(float lo, float hi) { f32x2 v = {lo, hi}; bf16x2_t b = __builtin_convertvector(v, bf16x2_t); return __builtin_bit_cast(unsigned, b); }
__device__ __forceinline__ u32x2 pack4(f32x4 v) { u32x2 r; r.x = cvtpk(v[0], v[1]); r.y = cvtpk(v[2], v[3]); return r; }
__device__ __forceinline__ float bf2f(unsigned short h) { return __builtin_bit_cast(float, (unsigned)h << 16); }
__device__ __forceinline__ f32x4 unpack4(u32x2 w) { f32x4 r; r[0] = __builtin_bit_cast(float, w.x << 16); r[1] = __builtin_bit_cast(float, w.x & 0xffff0000u); r[2] = __builtin_bit_cast(float, w.y << 16); r[3] = __builtin_bit_cast(float, w.y & 0xffff0000u); return r; }
__device__ __forceinline__ float sigmoidf_(float x) { return __builtin_amdgcn_rcpf(1.0f + __builtin_amdgcn_exp2f(-x * LOG2E)); }
__device__ __forceinline__ f32x4 sigmoid4(f32x4 v) { f32x4 r; r[0] = sigmoidf_(v[0]); r[1] = sigmoidf_(v[1]); r[2] = sigmoidf_(v[2]); r[3] = sigmoidf_(v[3]); return r; }
__device__ __forceinline__ float wave_sum(float v) {
#pragma unroll
    for (int o = 1; o < 64; o <<= 1) v += __shfl_xor(v, o);
    return v;
}
__device__ __forceinline__ float dot4(f32x4 v) { return (v[0] * v[0] + v[1] * v[1]) + (v[2] * v[2] + v[3] * v[3]); }

struct Sched {
    int G, c, nseg, pairs;
    int nN[2], pmo[2], pno[2], start[3];
    __device__ __forceinline__ bool next(int i, pg8::Unit& u) const {
        const int ii = pairs ? (i >> 1) : i;
        const long L = (long)ii * G + c; if (L >= start[nseg]) return false;
        const int s = (nseg > 1 && L >= start[1]) ? 1 : 0; const int l = (int)L - start[s];
        const int nwg = start[s + 1] - start[s], q = nwg >> 3, id = (l & 7) * q + (l >> 3);
        const int nig = 8 * nN[s], gid = id / nig, r = id % nig;
        const int pm = gid * 8 + (r & 7), pn = r >> 3;
        u.pm = pmo[s] + pm; u.pn = pno[s] + pn; u.kind = u.pn;
        if (pairs) { if (i & 1) { u.pm += 128; u.pn += 4; u.kind = 0; } else u.kind = 0x100; }
        return true;
    }
    __device__ __forceinline__ void a_ready(const pg8::Unit&) const {}
    __device__ __forceinline__ void done(const pg8::Unit&) const {}
};
__device__ __forceinline__ Sched make_sched(int G, int c, int nN0) { Sched s; s.G = G; s.c = c; s.nseg = 1; s.pairs = 0; s.nN[0] = nN0; s.nN[1] = 1; s.pmo[0] = s.pmo[1] = 0; s.pno[0] = s.pno[1] = 0; s.start[0] = 0; s.start[1] = 128 * nN0; s.start[2] = s.start[1]; return s; }

typedef pg8::f32x4 A4;
#define EPI_ROWS(ai, m) for (int ai = 0; ai < 2; ++ai) _Pragma("unroll") for (int m = 0; m < 4; ++m)

struct EpiP1 {
    static constexpr bool PERM = true, AFTER_DRAIN = false;
    bf16 *qa, *kvr, *krope, *qs, *ks, *vs, *gates; float *part_q, *part_kv; const f32x2* tab;
    __device__ __forceinline__ void mid(const A4 (&acc)[2][2][4][2], const pg8::Unit& u, int wr, int wc, int fr, int fq) const {}
    __device__ __forceinline__ void operator()(const A4 (&acc)[2][2][4][2], const pg8::Unit& u, int wr, int wc, int fr, int fq) const {
        const int pn = u.kind, row0 = u.pm * 256 + wr * 64 + fr, cl8 = wc * 32 + fq * 8;
        if (pn <= 1) {
            bf16* dst = pn == 0 ? qa : kvr; float* part = pn == 0 ? part_q : part_kv;
#pragma unroll
            EPI_ROWS(ai, m) { const int row = row0 + ai * 128 + m * 16; float ss = 0.f;
#pragma unroll
                for (int bj = 0; bj < 2; ++bj) { const A4 v0 = acc[ai][bj][m][0], v1 = acc[ai][bj][m][1]; if (pn == 0 || bj == 0) ss += dot4(v0) + dot4(v1);
                    const u32x2 a = pack4(v0), b2 = pack4(v1); *(u32x4*)(dst + (size_t)row * 256 + bj * 128 + cl8) = (u32x4){a.x, a.y, b2.x, b2.y}; }
                ss += __shfl_xor(ss, 16); ss += __shfl_xor(ss, 32);
                if (fq == 0) part[(size_t)row * 4 + wc] = ss;
                if (pn == 1 && wc == 0) {
                    const int pos = row & (SEQ - 1); const A4 x1 = acc[ai][1][m][0], x2 = acc[ai][1][m][1]; A4 o1, o2;
#pragma unroll
                    for (int e = 0; e < 4; ++e) { const f32x2 cs = tab[pos * 32 + 2 * (4 * fq + e)]; o1[e] = x1[e] * cs.x - x2[e] * cs.y; o2[e] = x2[e] * cs.x + x1[e] * cs.y; }
                    *(u32x2*)(krope + (size_t)row * 32 + 4 * fq) = pack4(o1); *(u32x2*)(krope + (size_t)row * 32 + 16 + 4 * fq) = pack4(o2);
                }
            }
        } else if (pn <= 6) {
            const int d1 = 16 * (wc & 1) + 4 * fq;
            f32x4 tb[2][2];
            { const int pos = row0 & (SEQ - 1); tb[0][0] = *(const f32x4*)(tab + pos * 32 + d1); tb[0][1] = *(const f32x4*)(tab + pos * 32 + d1 + 2); }
#pragma unroll
            for (int it = 0; it < 8; ++it) { const int ai = it >> 2, m = it & 3; const int row = row0 + ai * 128 + m * 16;
                if (it + 1 < 8) { const int pos = (row0 + ((it + 1) >> 2) * 128 + ((it + 1) & 3) * 16) & (SEQ - 1); tb[(it + 1) & 1][0] = *(const f32x4*)(tab + pos * 32 + d1); tb[(it + 1) & 1][1] = *(const f32x4*)(tab + pos * 32 + d1 + 2); }
                asm volatile("" ::: "memory");
                const f32x4 t0 = tb[it & 1][0], t1 = tb[it & 1][1];
                const float cc[4] = {t0[0], t0[2], t1[0], t1[2]}, sn[4] = {t0[1], t0[3], t1[1], t1[3]};
#pragma unroll
                for (int bj = 0; bj < 2; ++bj) {
                    if (pn == 6 && bj == 1) {
                        { const u32x2 a = pack4(acc[ai][1][m][0]), b2 = pack4(acc[ai][1][m][1]); *(u32x4*)(vs + (size_t)row * 128 + cl8) = (u32x4){a.x, a.y, b2.x, b2.y}; }
                    } else {
                        const A4 x1 = acc[ai][bj][m][0], x2 = acc[ai][bj][m][1]; A4 o1, o2; const float sc = pn == 6 ? 1.0f : C2_SWA;
#pragma unroll
                        for (int e = 0; e < 4; ++e) { o1[e] = (x1[e] * cc[e] - x2[e] * sn[e]) * sc; o2[e] = (x2[e] * cc[e] + x1[e] * sn[e]) * sc; }
                        bf16* d = pn == 6 ? ks + (size_t)row * 128 + (wc >> 1) * 64 : qs + (size_t)row * 1024 + ((pn - 2) * 4 + bj * 2 + (wc >> 1)) * 64;
                        *(u32x2*)(d + d1) = pack4(o1); *(u32x2*)(d + 32 + d1) = pack4(o2);
                    }
                }
            }
        } else {
#pragma unroll
            EPI_ROWS(ai, m) { const int row = row0 + ai * 128 + m * 16;
#pragma unroll
                for (int bj = 0; bj < 2; ++bj) { const u32x2 a = pack4(sigmoid4(acc[ai][bj][m][0])), b2 = pack4(sigmoid4(acc[ai][bj][m][1]));
                    *(u32x4*)(gates + (size_t)row * 2048 + (pn - 7) * 256 + bj * 128 + cl8) = (u32x4){a.x, a.y, b2.x, b2.y}; }
            }
        }
    }
};

struct EpiP2 {
    static constexpr bool PERM = true, AFTER_DRAIN = false;
    bf16 *qn, *qr, *kn, *vm; const float *part_q, *part_kv; const f32x2* tab;
    __device__ __forceinline__ void mid(const A4 (&acc)[2][2][4][2], const pg8::Unit& u, int wr, int wc, int fr, int fq) const {}
    __device__ __forceinline__ void operator()(const A4 (&acc)[2][2][4][2], const pg8::Unit& u, int wr, int wc, int fr, int fq) const {
        const int pn = u.kind, row0 = (u.pm & 127) * 256 + wr * 64 + fr, cl8 = wc * 32 + fq * 8;
        const bool isq = pn < 6, isrope = pn == 4 || pn == 5; const float* part = isq ? part_q : part_kv; const float invn = isq ? (1.0f / 256.0f) : (1.0f / 128.0f);
        f32x4 pp[2]; f32x4 tb[2][2];
        pp[0] = *(const f32x4*)(part + (size_t)row0 * 4);
        if (isrope) { const int pos = row0 & (SEQ - 1); tb[0][0] = *(const f32x4*)(tab + pos * 32 + 8 * fq); tb[0][1] = *(const f32x4*)(tab + pos * 32 + 8 * fq + 4); }
        f32x4 tc[2][2];
        if (isrope) { const int pos = row0 & (SEQ - 1); tc[0][0] = *(const f32x4*)(tab + pos * 32 + 8 * fq + 2); tc[0][1] = *(const f32x4*)(tab + pos * 32 + 8 * fq + 6); }
#pragma unroll
        for (int it = 0; it < 8; ++it) { const int ai = it >> 2, m = it & 3; const int row = row0 + ai * 128 + m * 16;
            if (it + 1 < 8) { const int rn = row0 + ((it + 1) >> 2) * 128 + ((it + 1) & 3) * 16; pp[(it + 1) & 1] = *(const f32x4*)(part + (size_t)rn * 4);
                if (isrope) { const int pos = rn & (SEQ - 1); tb[(it + 1) & 1][0] = *(const f32x4*)(tab + pos * 32 + 8 * fq); tb[(it + 1) & 1][1] = *(const f32x4*)(tab + pos * 32 + 8 * fq + 4);
                    tc[(it + 1) & 1][0] = *(const f32x4*)(tab + pos * 32 + 8 * fq + 2); tc[(it + 1) & 1][1] = *(const f32x4*)(tab + pos * 32 + 8 * fq + 6); } }
            asm volatile("" ::: "memory");
            const f32x4 p4 = pp[it & 1];
            float rs = __builtin_amdgcn_rsqf(((p4[0] + p4[1]) + (p4[2] + p4[3])) * invn + EPS);
            if (isq) rs *= C2_MLA;
            if (isrope) {
                const float cc[4] = {tb[it & 1][0][0], tc[it & 1][0][0], tb[it & 1][1][0], tc[it & 1][1][0]}, sn[4] = {tb[it & 1][0][1], tc[it & 1][0][1], tb[it & 1][1][1], tc[it & 1][1][1]};
#pragma unroll
                for (int bj = 0; bj < 2; ++bj) { const A4 x1 = acc[ai][bj][m][0], x2 = acc[ai][bj][m][1]; A4 o1, o2;
#pragma unroll
                    for (int e = 0; e < 4; ++e) { o1[e] = (x1[e] * cc[e] - x2[e] * sn[e]) * rs; o2[e] = (x2[e] * cc[e] + x1[e] * sn[e]) * rs; }
                    bf16* d = qr + (size_t)row * 512 + ((pn - 4) * 8 + bj * 4 + wc) * 32;
                    *(u32x2*)(d + 4 * fq) = pack4(o1); *(u32x2*)(d + 16 + 4 * fq) = pack4(o2); }
            } else {
                bf16* d = pn < 4 ? qn + (size_t)row * 1024 + pn * 256 : (pn < 10 ? kn + (size_t)row * 1024 + (pn - 6) * 256 : vm + (size_t)row * 1024 + (pn - 10) * 256);
#pragma unroll
                for (int bj = 0; bj < 2; ++bj) { const u32x2 a = pack4(acc[ai][bj][m][0] * rs), b2 = pack4(acc[ai][bj][m][1] * rs); *(u32x4*)(d + bj * 128 + cl8) = (u32x4){a.x, a.y, b2.x, b2.y}; }
            }
        }
    }
};

struct EpiP4 {
    static constexpr bool PERM = true, AFTER_DRAIN = false;
    const bf16* gates; bf16* y; bf16* ya;
    __device__ __forceinline__ void mid(const A4 (&acc)[2][2][4][2], const pg8::Unit& u, int wr, int wc, int fr, int fq) const {
        const int row0 = u.pm * 256 + wr * 64 + fr, col0 = u.pn * 256 + wc * 32 + fq * 8;
        u32x4 gq[2][2];
#define P4_LD(buf, it_) do { const bf16* g_ = gates + (size_t)(row0 + ((it_) >> 2) * 128 + ((it_) & 3) * 16) * 2048 + col0; \
        _Pragma("unroll") for (int bj = 0; bj < 2; ++bj) gq[buf][bj] = *(const u32x4*)(g_ + bj * 128); } while (0)
        P4_LD(0, 0);
#pragma unroll
        for (int it = 0; it < 8; ++it) { const int ai = it >> 2, m = it & 3; const size_t row = (size_t)(row0 + ai * 128 + m * 16);
            if (it + 1 < 8) P4_LD((it + 1) & 1, it + 1);
            asm volatile("" ::: "memory");
#pragma unroll
            for (int bj = 0; bj < 2; ++bj) { const u32x4 g4 = gq[it & 1][bj];
                const u32x2 a = pack4(acc[ai][bj][m][0] * unpack4((u32x2){g4.x, g4.y})), b2 = pack4(acc[ai][bj][m][1] * unpack4((u32x2){g4.z, g4.w}));
                *(u32x4*)(ya + row * 1024 + col0 + bj * 128) = (u32x4){a.x, a.y, b2.x, b2.y}; }
        }
#undef P4_LD
    }
    __device__ __forceinline__ void operator()(const A4 (&acc)[2][2][4][2], const pg8::Unit& u, int wr, int wc, int fr, int fq) const {
        const int row0 = (u.pm - 128) * 256 + wr * 64 + fr, col0 = (u.pn - 4) * 256 + wc * 32 + fq * 8;
        u32x4 gq[2][2], yq[2][2];
#define P4_LD(buf, it_) do { const size_t r_ = (size_t)(row0 + ((it_) >> 2) * 128 + ((it_) & 3) * 16); const bf16* g_ = gates + r_ * 2048 + 1024 + col0; const bf16* y_ = ya + r_ * 1024 + col0; \
        _Pragma("unroll") for (int bj = 0; bj < 2; ++bj) { gq[buf][bj] = *(const u32x4*)(g_ + bj * 128); yq[buf][bj] = *(const u32x4*)(y_ + bj * 128); } } while (0)
        P4_LD(0, 0);
#pragma unroll
        for (int it = 0; it < 8; ++it) { const int ai = it >> 2, m = it & 3; const size_t row = (size_t)(row0 + ai * 128 + m * 16);
            if (it + 1 < 8) P4_LD((it + 1) & 1, it + 1);
            asm volatile("" ::: "memory");
#pragma unroll
            for (int bj = 0; bj < 2; ++bj) { const u32x4 g4 = gq[it & 1][bj], y4 = yq[it & 1][bj];
                const u32x2 a = pack4(unpack4((u32x2){y4.x, y4.y}) + acc[ai][bj][m][0] * unpack4((u32x2){g4.x, g4.y})), b2 = pack4(unpack4((u32x2){y4.z, y4.w}) + acc[ai][bj][m][1] * unpack4((u32x2){g4.z, g4.w}));
                *(u32x4*)(y + row * 1024 + col0 + bj * 128) = (u32x4){a.x, a.y, b2.x, b2.y}; }
        }
#undef P4_LD
    }
};

struct EpiT {
    static constexpr bool PERM = true, AFTER_DRAIN = false;
    bf16* o; float* part;
    __device__ __forceinline__ void mid(const A4 (&acc)[2][2][4][2], const pg8::Unit& u, int wr, int wc, int fr, int fq) const {}
    __device__ __forceinline__ void operator()(const A4 (&acc)[2][2][4][2], const pg8::Unit& u, int wr, int wc, int fr, int fq) const {
        const int row0 = u.pm * 256 + wr * 64 + fr, col0 = u.pn * 256 + wc * 32 + fq * 8;
#pragma unroll
        EPI_ROWS(ai, m) { const size_t row = (size_t)(row0 + ai * 128 + m * 16); float ss = 0.f;
#pragma unroll
            for (int bj = 0; bj < 2; ++bj) { const A4 v0 = acc[ai][bj][m][0], v1 = acc[ai][bj][m][1]; ss += dot4(v0) + dot4(v1);
                const u32x2 a = pack4(v0), b2 = pack4(v1);
                *(u32x4*)(o + row * 1024 + col0 + bj * 128) = (u32x4){a.x, a.y, b2.x, b2.y}; }
            ss += __shfl_xor(ss, 16); ss += __shfl_xor(ss, 32);
            if (fq == 0) part[row * 16 + u.pn * 4 + wc] = ss;
        }
    }
};

struct EpiRelu2 {
    static constexpr bool PERM = true, AFTER_DRAIN = false;
    bf16* o;
    __device__ __forceinline__ void mid(const A4 (&acc)[2][2][4][2], const pg8::Unit& u, int wr, int wc, int fr, int fq) const {}
    __device__ __forceinline__ void operator()(const A4 (&acc)[2][2][4][2], const pg8::Unit& u, int wr, int wc, int fr, int fq) const {
        const int row0 = u.pm * 256 + wr * 64 + fr, col0 = u.pn * 256 + wc * 32 + fq * 8;
#pragma unroll
        EPI_ROWS(ai, m) { const size_t row = (size_t)(row0 + ai * 128 + m * 16);
#pragma unroll
            for (int bj = 0; bj < 2; ++bj) { A4 v0 = acc[ai][bj][m][0], v1 = acc[ai][bj][m][1];
#pragma unroll
                for (int e = 0; e < 4; ++e) { const float r0 = __builtin_fmaxf(v0[e], 0.f), r1 = __builtin_fmaxf(v1[e], 0.f); v0[e] = r0 * r0; v1[e] = r1 * r1; }
                const u32x2 a = pack4(v0), b2 = pack4(v1);
                *(u32x4*)(o + row * FF + col0 + bj * 128) = (u32x4){a.x, a.y, b2.x, b2.y}; }
        }
    }
};

struct EpiOut {
    static constexpr bool PERM = true, AFTER_DRAIN = false;
    float* out; const bf16* x2b; const bf16* eraw; const float* rstd_e; const float* gple;
    __device__ __forceinline__ void mid(const A4 (&acc)[2][2][4][2], const pg8::Unit& u, int wr, int wc, int fr, int fq) const {}
    __device__ __forceinline__ void operator()(const A4 (&acc)[2][2][4][2], const pg8::Unit& u, int wr, int wc, int fr, int fq) const {
        const int row0 = u.pm * 256 + wr * 64 + fr, col0 = u.pn * 256 + wc * 32 + fq * 8;
        f32x4 gv[2][2];
#pragma unroll
        for (int bj = 0; bj < 2; ++bj)
#pragma unroll
            for (int n = 0; n < 2; ++n) gv[bj][n] = *(const f32x4*)(gple + col0 + bj * 128 + n * 4);
        u32x4 xq[2][2]; u32x4 eq[2][2]; float rq[2];
#define PO_LD(buf, it_) do { const size_t r_ = (size_t)(row0 + ((it_) >> 2) * 128 + ((it_) & 3) * 16); rq[buf] = rstd_e[r_]; \
        _Pragma("unroll") for (int bj = 0; bj < 2; ++bj) { const size_t off_ = r_ * 1024 + col0 + bj * 128; xq[buf][bj] = *(const u32x4*)(x2b + off_); eq[buf][bj] = *(const u32x4*)(eraw + off_); } } while (0)
        PO_LD(0, 0);
#pragma unroll
        for (int it = 0; it < 8; ++it) { const int ai = it >> 2, m = it & 3; const size_t row = (size_t)(row0 + ai * 128 + m * 16);
            if (it + 1 < 8) PO_LD((it + 1) & 1, it + 1);
            asm volatile("" ::: "memory");
#pragma unroll
            for (int bj = 0; bj < 2; ++bj) { const size_t off = row * 1024 + col0 + bj * 128; const u32x4 e4 = eq[it & 1][bj], x4 = xq[it & 1][bj];
                *(f32x4*)(out + off) = unpack4((u32x2){x4.x, x4.y}) + sigmoid4(acc[ai][bj][m][0]) * (unpack4((u32x2){e4.x, e4.y}) * rq[it & 1] * gv[bj][0]);
                *(f32x4*)(out + off + 4) = unpack4((u32x2){x4.z, x4.w}) + sigmoid4(acc[ai][bj][m][1]) * (unpack4((u32x2){e4.z, e4.w}) * rq[it & 1] * gv[bj][1]); }
        }
#undef PO_LD
    }
};

namespace att {
constexpr int KP = 208, VP = 192, KBUF = 64 * KP, VBUF = 64 * VP, STAGE = KBUF + VBUF;
__device__ __forceinline__ float max3f(float a, float b, float c) { float r; asm("v_max3_f32 %0, %1, %2, %3" : "=v"(r) : "v"(a), "v"(b), "v"(c)); return r; }
__device__ __forceinline__ float max2f(float a, float b) { float r; asm("v_max_f32_e32 %0, %1, %2" : "=v"(r) : "v"(a), "v"(b)); return r; }
__device__ __forceinline__ float xhalf_max(float v) { auto rr = __builtin_amdgcn_permlane32_swap(__float_as_uint(v), __float_as_uint(v), false, false); return max2f(__uint_as_float(rr[0]), __uint_as_float(rr[1])); }
__device__ __forceinline__ float xhalf_sum(float v) { auto rr = __builtin_amdgcn_permlane32_swap(__float_as_uint(v), __float_as_uint(v), false, false); return __uint_as_float(rr[0]) + __uint_as_float(rr[1]); }
__device__ __forceinline__ s16x4 vtr(const LAS unsigned char* p) { return __builtin_bit_cast(s16x4, __builtin_amdgcn_ds_read_tr16_b64_v4i16((LAS s16x4*)p)); }

template <int MODE>
__device__ __forceinline__ void unit(LAS unsigned char* lds, const bf16* __restrict__ Qa, const bf16* __restrict__ Qb, const bf16* __restrict__ Ka, const bf16* __restrict__ Kb, const bf16* __restrict__ Va, bf16* O,
                                     const float* __restrict__ sinks, int b, int h, int blk, int hp) {
    constexpr int NC = MODE == 0 ? 6 : 4;
    const int tid = threadIdx.x, lane = tid & 63, w = __builtin_amdgcn_readfirstlane(tid >> 6), l31 = lane & 31, hi = lane >> 5;
    int hq, qpos0w, t_beg, t_end, kpos_base; size_t krow_base; int kvpitch, kvcol;
    if (MODE == 0) { hq = h; qpos0w = blk * 256 + w * 32; t_beg = 0; t_end = 4 * blk + 4; kpos_base = 0; kvpitch = 1024; kvcol = h * 64; }
    else { hq = 8 * h + 2 * hp + (w >> 2); qpos0w = blk * 128 + (w & 3) * 32; t_beg = blk == 0 ? 2 : 0; t_end = 4; kpos_base = (blk - 1) * 128; kvpitch = 128; kvcol = h * 64; }
    const size_t seq0 = (size_t)b * SEQ;
    const int qpos = qpos0w + l31;
    bf16x8 qf[NC];
    { const bf16* qp = Qa + (seq0 + qpos) * 1024 + hq * 64 + hi * 8;
#pragma unroll
      for (int c = 0; c < 4; ++c) qf[c] = *(const bf16x8*)(qp + c * 16);
      if (MODE == 0) { const bf16* qp2 = Qb + (seq0 + qpos) * 512 + hq * 32 + hi * 8;
#pragma unroll
          for (int c = 4; c < NC; ++c) qf[c] = *(const bf16x8*)(qp2 + (c - 4) * 16); } }
    const int skey = tid >> 3, sch = tid & 7;
    const bf16* kg = Ka + ((long)seq0 + kpos_base + skey) * kvpitch + kvcol + sch * 8;
    const bf16* vg = Va + ((long)seq0 + kpos_base + skey) * kvpitch + kvcol + sch * 8;
    const bf16* rg = MODE == 0 ? Kb + (seq0 + (tid >> 2)) * 32 + (tid & 3) * 8 : nullptr;
    const int kw_off = skey * KP + sch * 16, vw_off = KBUF + skey * VP + sch * 16, rw_off = (tid >> 2) * KP + 128 + (tid & 3) * 16;
    const int pi = (l31 & 0x13) | ((l31 & 4) << 1) | ((l31 & 8) >> 1);
    const int kr_off = pi * KP + hi * 16;
    const int vr_off = KBUF + (8 * hi + ((lane & 15) >> 2)) * VP + (16 * ((lane >> 4) & 1) + 4 * (lane & 3)) * 2;
    float m_run, l_run;
    if (MODE == 0) { m_run = -1e30f; l_run = 0.f; } else { m_run = sinks[hq] * LOG2E; l_run = hi == 0 ? 1.f : 0.f; }
    f32x16 o0 = {}, o1 = {};
    u32x4 kreg, vreg, rreg = {};
    kreg = *(const u32x4*)(kg + (long)t_beg * 64 * kvpitch); vreg = *(const u32x4*)(vg + (long)t_beg * 64 * kvpitch);
    if (MODE == 0 && tid < 256) rreg = *(const u32x4*)(rg + (size_t)t_beg * 64 * 32);
    *(LAS u32x4*)(lds + kw_off) = kreg; *(LAS u32x4*)(lds + vw_off) = vreg;
    if (MODE == 0 && tid < 256) *(LAS u32x4*)(lds + rw_off) = rreg;
    __syncthreads();
    for (int t = t_beg; t < t_end; ++t) {
        const int st = ((t - t_beg) & 1) * STAGE, sn = STAGE - st;
        const bool more = t + 1 < t_end;
        if (more) { kreg = *(const u32x4*)(kg + (long)(t + 1) * 64 * kvpitch); vreg = *(const u32x4*)(vg + (long)(t + 1) * 64 * kvpitch);
            if (MODE == 0 && tid < 256) rreg = *(const u32x4*)(rg + (size_t)(t + 1) * 64 * 32); }
        const int kp0 = kpos_base + t * 64;
        bool doit, domask;
        if (MODE == 0) { doit = kp0 <= qpos0w + 31; domask = kp0 + 63 > qpos0w; }
        else { const int a = w & 3; doit = a < 2 ? (t <= 2) : (t >= 1); domask = true; }
        if (doit) {
            const LAS unsigned char* kb = lds + st + kr_off; const LAS unsigned char* vb = lds + st + vr_off;
            f32x16 s0 = {}, s1 = {};
#pragma unroll
            for (int c = 0; c < NC; ++c) { const bf16x8 k0 = *(const LAS bf16x8*)(kb + c * 32), k1 = *(const LAS bf16x8*)(kb + 32 * KP + c * 32);
                s0 = __builtin_amdgcn_mfma_f32_32x32x16_bf16(k0, qf[c], s0, 0, 0, 0); s1 = __builtin_amdgcn_mfma_f32_32x32x16_bf16(k1, qf[c], s1, 0, 0, 0); }
            if (domask) {
#pragma unroll
                for (int r = 0; r < 16; ++r) { const int kk = kp0 + 16 * (r >> 3) + 8 * hi + (r & 7); const int rel0 = qpos - kk, rel1 = rel0 - 32;
                    const bool ok0 = MODE == 0 ? rel0 >= 0 : (rel0 >= 0 && rel0 < 128), ok1 = MODE == 0 ? rel1 >= 0 : (rel1 >= 0 && rel1 < 128);
                    s0[r] = ok0 ? s0[r] : -1e30f; s1[r] = ok1 ? s1[r] : -1e30f; }
            }
            float mx = max2f(s0[0], s1[0]);
#pragma unroll
            for (int r = 1; r < 16; ++r) mx = max3f(mx, s0[r], s1[r]);
            mx = xhalf_max(mx);
            const float mnew = max2f(m_run, mx), alpha = __builtin_amdgcn_exp2f(m_run - mnew); m_run = mnew;
            f32x2 ps2 = {0.f, 0.f}; const f32x2 mn2 = {mnew, mnew};
#pragma unroll
            for (int r = 0; r < 16; r += 2) { f32x2 a2 = (f32x2){s0[r], s0[r + 1]} - mn2, b2 = (f32x2){s1[r], s1[r + 1]} - mn2;
                a2.x = __builtin_amdgcn_exp2f(a2.x); a2.y = __builtin_amdgcn_exp2f(a2.y); b2.x = __builtin_amdgcn_exp2f(b2.x); b2.y = __builtin_amdgcn_exp2f(b2.y);
                ps2 += a2; ps2 += b2; s0[r] = a2.x; s0[r + 1] = a2.y; s1[r] = b2.x; s1[r + 1] = b2.y; }
            l_run = l_run * alpha + (ps2.x + ps2.y);
            if (__builtin_amdgcn_ballot_w64(alpha != 1.0f) != 0ull) {
                const f32x2 al2 = {alpha, alpha};
#pragma unroll
                for (int r = 0; r < 16; r += 2) { f32x2 x = (f32x2){o0[r], o0[r + 1]} * al2, y = (f32x2){o1[r], o1[r + 1]} * al2; o0[r] = x.x; o0[r + 1] = x.y; o1[r] = y.x; o1[r + 1] = y.y; }
            }
            bf16x8 pk[4];
#pragma unroll
            for (int j = 0; j < 2; ++j) { u32x4 a, c2;
                a.x = cvtpk(s0[8 * j], s0[8 * j + 1]); a.y = cvtpk(s0[8 * j + 2], s0[8 * j + 3]); a.z = cvtpk(s0[8 * j + 4], s0[8 * j + 5]); a.w = cvtpk(s0[8 * j + 6], s0[8 * j + 7]);
                c2.x = cvtpk(s1[8 * j], s1[8 * j + 1]); c2.y = cvtpk(s1[8 * j + 2], s1[8 * j + 3]); c2.z = cvtpk(s1[8 * j + 4], s1[8 * j + 5]); c2.w = cvtpk(s1[8 * j + 6], s1[8 * j + 7]);
                pk[j] = __builtin_bit_cast(bf16x8, a); pk[2 + j] = __builtin_bit_cast(bf16x8, c2); }
#pragma unroll
            for (int j = 0; j < 4; ++j) {
                const s16x4 a0 = vtr(vb + (16 * j) * VP), a1 = vtr(vb + (16 * j + 4) * VP), b0 = vtr(vb + (16 * j) * VP + 64), b1 = vtr(vb + (16 * j + 4) * VP + 64);
                const bf16x8 va = {a0[0], a0[1], a0[2], a0[3], a1[0], a1[1], a1[2], a1[3]}, vb8 = {b0[0], b0[1], b0[2], b0[3], b1[0], b1[1], b1[2], b1[3]};
                o0 = __builtin_amdgcn_mfma_f32_32x32x16_bf16(va, pk[j], o0, 0, 0, 0); o1 = __builtin_amdgcn_mfma_f32_32x32x16_bf16(vb8, pk[j], o1, 0, 0, 0);
            }
        }
        if (more) { *(LAS u32x4*)(lds + sn + kw_off) = kreg; *(LAS u32x4*)(lds + sn + vw_off) = vreg;
            if (MODE == 0 && tid < 256) *(LAS u32x4*)(lds + sn + rw_off) = rreg; }
        __syncthreads();
    }
    const float inv = __builtin_amdgcn_rcpf(xhalf_sum(l_run));
    bf16* op = O + (seq0 + qpos) * 1024 + hq * 64 + 4 * hi;
#pragma unroll
    for (int g = 0; g < 4; ++g) { u32x2 w0, w1;
        w0.x = cvtpk(o0[4 * g] * inv, o0[4 * g + 1] * inv); w0.y = cvtpk(o0[4 * g + 2] * inv, o0[4 * g + 3] * inv);
        w1.x = cvtpk(o1[4 * g] * inv, o1[4 * g + 1] * inv); w1.y = cvtpk(o1[4 * g + 2] * inv, o1[4 * g + 3] * inv);
        *(u32x2*)(op + 8 * g) = w0; *(u32x2*)(op + 32 + 8 * g) = w1; }
}
}


__device__ __forceinline__ void swa_unit(LAS unsigned char* lds, const bf16* __restrict__ Qs, const bf16* __restrict__ Ks, const bf16* __restrict__ Vs, bf16* O, const float* __restrict__ sinks, int b, int g, int n) {
    using namespace att;
    constexpr int STG = KBUF + VBUF;
    const int tid = threadIdx.x, lane = tid & 63, w = __builtin_amdgcn_readfirstlane(tid >> 6), l31 = lane & 31, hi = lane >> 5;
    const int tb = n == 0 ? 2 : 0, kpos_base = (n - 1) * 128; const long seq0 = (long)b * SEQ;
    { const int skey = tid >> 3, sch = tid & 7; u32x4 kr[4], vr[4];
#pragma unroll
      for (int t = 0; t < 4; ++t) if (t >= tb) { const long off = (seq0 + kpos_base + t * 64 + skey) * 128 + g * 64 + sch * 8; kr[t] = *(const u32x4*)(Ks + off); vr[t] = *(const u32x4*)(Vs + off); }
#pragma unroll
      for (int t = 0; t < 4; ++t) if (t >= tb) { *(LAS u32x4*)(lds + t * STG + skey * KP + sch * 16) = kr[t]; *(LAS u32x4*)(lds + t * STG + KBUF + skey * VP + sch * 16) = vr[t]; } }
    __syncthreads();
    const int pi = (l31 & 0x13) | ((l31 & 4) << 1) | ((l31 & 8) >> 1);
    const int kr_k = pi * KP + hi * 16;
    const int vr_v = KBUF + (8 * hi + ((lane & 15) >> 2)) * VP + (16 * ((lane >> 4) & 1) + 4 * (lane & 3)) * 2;
    const int a = w & 3, qpos = n * 128 + a * 32 + l31;
    const int t0 = a < 2 ? tb : (tb > 1 ? tb : 1), t1 = a < 2 ? 2 : 3;
#pragma unroll 1
    for (int hp = 0; hp < 4; ++hp) {
        const int hq = 8 * g + 2 * hp + (w >> 2);
        bf16x8 qf[4];
        { const bf16* qp = Qs + (seq0 + qpos) * 1024 + hq * 64 + hi * 8;
#pragma unroll
          for (int c = 0; c < 4; ++c) qf[c] = *(const bf16x8*)(qp + c * 16); }
        float m_run = sinks[hq] * LOG2E, l_run = hi == 0 ? 1.f : 0.f;
        f32x16 o0 = {}, o1 = {};
#pragma unroll 1
        for (int t = t0; t <= t1; ++t) {
            const LAS unsigned char* kb = lds + t * STG + kr_k; const LAS unsigned char* vb = lds + t * STG + vr_v;
            f32x16 s0 = {}, s1 = {};
#pragma unroll
            for (int c = 0; c < 4; ++c) { const bf16x8 k0 = *(const LAS bf16x8*)(kb + c * 32), k1 = *(const LAS bf16x8*)(kb + 32 * KP + c * 32);
                s0 = __builtin_amdgcn_mfma_f32_32x32x16_bf16(k0, qf[c], s0, 0, 0, 0); s1 = __builtin_amdgcn_mfma_f32_32x32x16_bf16(k1, qf[c], s1, 0, 0, 0); }
            const int kp0 = kpos_base + t * 64;
#pragma unroll
            for (int r = 0; r < 16; ++r) { const int rel0 = qpos - (kp0 + 16 * (r >> 3) + 8 * hi + (r & 7)), rel1 = rel0 - 32;
                s0[r] = (rel0 >= 0 && rel0 < 128) ? s0[r] : -1e30f; s1[r] = (rel1 >= 0 && rel1 < 128) ? s1[r] : -1e30f; }
            float mx = max2f(s0[0], s1[0]);
#pragma unroll
            for (int r = 1; r < 16; ++r) mx = max3f(mx, s0[r], s1[r]);
            mx = xhalf_max(mx);
            const float mnew = max2f(m_run, mx), alpha = __builtin_amdgcn_exp2f(m_run - mnew); m_run = mnew;
            float ps = 0.f;
#pragma unroll
            for (int r = 0; r < 16; ++r) { s0[r] = __builtin_amdgcn_exp2f(s0[r] - mnew); s1[r] = __builtin_amdgcn_exp2f(s1[r] - mnew); ps += s0[r] + s1[r]; }
            l_run = l_run * alpha + ps;
#pragma unroll
            for (int r = 0; r < 16; ++r) { o0[r] *= alpha; o1[r] *= alpha; }
            bf16x8 pk[4];
#pragma unroll
            for (int j = 0; j < 2; ++j) { u32x4 a_, c_;
                a_.x = cvtpk(s0[8 * j], s0[8 * j + 1]); a_.y = cvtpk(s0[8 * j + 2], s0[8 * j + 3]); a_.z = cvtpk(s0[8 * j + 4], s0[8 * j + 5]); a_.w = cvtpk(s0[8 * j + 6], s0[8 * j + 7]);
                c_.x = cvtpk(s1[8 * j], s1[8 * j + 1]); c_.y = cvtpk(s1[8 * j + 2], s1[8 * j + 3]); c_.z = cvtpk(s1[8 * j + 4], s1[8 * j + 5]); c_.w = cvtpk(s1[8 * j + 6], s1[8 * j + 7]);
                pk[j] = __builtin_bit_cast(bf16x8, a_); pk[2 + j] = __builtin_bit_cast(bf16x8, c_); }
#pragma unroll
            for (int j = 0; j < 4; ++j) {
                const s16x4 a0 = vtr(vb + (16 * j) * VP), a1 = vtr(vb + (16 * j + 4) * VP), b0 = vtr(vb + (16 * j) * VP + 64), b1 = vtr(vb + (16 * j + 4) * VP + 64);
                const bf16x8 va = {a0[0], a0[1], a0[2], a0[3], a1[0], a1[1], a1[2], a1[3]}, vb8 = {b0[0], b0[1], b0[2], b0[3], b1[0], b1[1], b1[2], b1[3]};
                o0 = __builtin_amdgcn_mfma_f32_32x32x16_bf16(va, pk[j], o0, 0, 0, 0); o1 = __builtin_amdgcn_mfma_f32_32x32x16_bf16(vb8, pk[j], o1, 0, 0, 0); }
        }
        const float inv = __builtin_amdgcn_rcpf(xhalf_sum(l_run));
        bf16* op = O + (seq0 + qpos) * 1024 + hq * 64 + 4 * hi;
#pragma unroll
        for (int q4 = 0; q4 < 4; ++q4) { u32x2 w0, w1;
            w0.x = cvtpk(o0[4 * q4] * inv, o0[4 * q4 + 1] * inv); w0.y = cvtpk(o0[4 * q4 + 2] * inv, o0[4 * q4 + 3] * inv);
            w1.x = cvtpk(o1[4 * q4] * inv, o1[4 * q4 + 1] * inv); w1.y = cvtpk(o1[4 * q4 + 2] * inv, o1[4 * q4 + 3] * inv);
            *(u32x2*)(op + 8 * q4) = w0; *(u32x2*)(op + 32 + 8 * q4) = w1; }
    }
    __syncthreads();
}

__device__ __forceinline__ int rope64(int w) { return ((w >> 2) & 1) * 32 + ((w >> 5) & 1) * 16 + ((w >> 3) & 3) * 4 + (w & 3); }
__device__ __forceinline__ int rope32(int p) { return ((p >> 2) & 1) * 16 + ((p >> 3) & 3) * 4 + (p & 3); }
__device__ __forceinline__ int src_col(int which, int r) {
    switch (which) {
    case 0:
        if (r < 256) return r;
        if (r < 512) { const int p = r - 256; return p < 128 ? 256 + p : (p < 160 ? 384 + rope32(p - 128) : -1); }
        if (r < 1536) { const int p = r - 512; return 416 + (p & ~63) + rope64(p & 63); }
        if (r < 1792) { const int p = r - 1536; return p < 128 ? 1440 + (p & ~63) + rope64(p & 63) : 1568 + (p - 128); }
        return 1696 + (r - 1792);
    case 1:
        if (r < 1024) return (r >> 6) * 96 + (r & 63);
        { const int p = r - 1024; return (p >> 5) * 96 + 64 + rope32(p & 31); }
    case 2:
        if (r < 1024) return (r >> 6) * 128 + (r & 63);
        { const int p = r - 1024; return (p >> 6) * 128 + 64 + (p & 63); }
    default: return r;
    }
}
__device__ __forceinline__ void transpose_item(const float* __restrict__ W, int Ks, int N, bf16* WT, int R, int Kd, int which, const float* __restrict__ gs, LAS float* scr, int item, int lane) {
    const int nblk = R / 32, kb = item / nblk, nb = item % nblk, k0 = 64 * kb, n0 = 32 * nb;
    const int sc = src_col(which, n0 + (lane & 31));
    float vals[32];
#pragma unroll
    for (int i = 0; i < 32; ++i) { const int k = k0 + 2 * i + (lane >> 5); float v = 0.f;
        if (sc >= 0 && k < Ks) { v = W[(size_t)k * N + sc]; if (gs) v *= gs[k]; }
        vals[i] = v; }
#pragma unroll
    for (int i = 0; i < 32; ++i) scr[(2 * i + (lane >> 5)) * 33 + (lane & 31)] = vals[i];
    asm volatile("s_waitcnt lgkmcnt(0)" ::: "memory");
    const int c = lane & 7;
#pragma unroll
    for (int j = 0; j < 4; ++j) { const int n = (lane >> 3) + 8 * j; const LAS float* s = scr + (8 * c) * 33 + n;
        u32x4 o; o.x = cvtpk(s[0 * 33], s[1 * 33]); o.y = cvtpk(s[2 * 33], s[3 * 33]); o.z = cvtpk(s[4 * 33], s[5 * 33]); o.w = cvtpk(s[6 * 33], s[7 * 33]);
        *(u32x4*)(WT + (size_t)(n0 + n) * Kd + k0 + 8 * c) = o; }
    asm volatile("s_waitcnt lgkmcnt(0)" ::: "memory");
}


__device__ __forceinline__ float sum16(const float* p) { const f32x4* q = (const f32x4*)p; const f32x4 a = q[0], b = q[1], c = q[2], d = q[3];
    return (((a[0] + a[1]) + (a[2] + a[3])) + ((b[0] + b[1]) + (b[2] + b[3]))) + (((c[0] + c[1]) + (c[2] + c[3])) + ((d[0] + d[1]) + (d[2] + d[3]))); }
template <bool FIRST>
__device__ __forceinline__ void rowpass(const float* xin, const bf16* xin16, bf16* x1b, const bf16* T, const float* part_t, const float* gpost, const float* gpre, bf16* XN, const float* part_e, float* rstd_e, int gw, int NGW, int lane) {
    for (int row0 = gw; row0 < M; row0 += 4 * NGW) {
        f32x4 xv[4][4]; u32x4 tw[4][2]; float rt[4];
#pragma unroll
        for (int r2 = 0; r2 < 4; ++r2) { const size_t row = (size_t)(row0 + r2 * NGW);
#pragma unroll
            for (int j = 0; j < 2; ++j) { const int col = 512 * j + 8 * lane; tw[r2][j] = *(const u32x4*)(T + row * DM + col);
                if (FIRST) { xv[r2][2 * j] = *(const f32x4*)(xin + row * DM + col); xv[r2][2 * j + 1] = *(const f32x4*)(xin + row * DM + col + 4); }
                else { const u32x4 xw = *(const u32x4*)(xin16 + row * DM + col); xv[r2][2 * j] = unpack4((u32x2){xw.x, xw.y}); xv[r2][2 * j + 1] = unpack4((u32x2){xw.z, xw.w}); } }
            rt[r2] = __builtin_amdgcn_rsqf(sum16(part_t + row * 16) * (1.0f / DM) + EPS); }
#pragma unroll
        for (int r2 = 0; r2 < 4; ++r2) { const size_t row = (size_t)(row0 + r2 * NGW); float ss = 0.f;
#pragma unroll
            for (int j = 0; j < 2; ++j) { const int col = 512 * j + 8 * lane;
                const f32x4 ta = unpack4((u32x2){tw[r2][j].x, tw[r2][j].y}), tb = unpack4((u32x2){tw[r2][j].z, tw[r2][j].w});
                const f32x4 ga = *(const f32x4*)(gpost + col), gb = *(const f32x4*)(gpost + col + 4);
                xv[r2][2 * j] += ta * rt[r2] * ga; xv[r2][2 * j + 1] += tb * rt[r2] * gb; ss += dot4(xv[r2][2 * j]) + dot4(xv[r2][2 * j + 1]);
                const u32x2 a = pack4(xv[r2][2 * j]), b2 = pack4(xv[r2][2 * j + 1]);
                *(u32x4*)((FIRST ? x1b : XN) + row * DM + col) = (u32x4){a.x, a.y, b2.x, b2.y}; }
            if (FIRST) { const float r1 = __builtin_amdgcn_rsqf(wave_sum(ss) * (1.0f / DM) + EPS);
#pragma unroll
                for (int j = 0; j < 2; ++j) { const int col = 512 * j + 8 * lane; const f32x4 ga = *(const f32x4*)(gpre + col), gb = *(const f32x4*)(gpre + col + 4);
                    const u32x2 a = pack4(xv[r2][2 * j] * r1 * ga), b2 = pack4(xv[r2][2 * j + 1] * r1 * gb); *(u32x4*)(XN + row * DM + col) = (u32x4){a.x, a.y, b2.x, b2.y}; }
            } else {
                if (lane == 0) rstd_e[row] = __builtin_amdgcn_rsqf(sum16(part_e + row * 16) * (1.0f / DM) + EPS); }
        }
    }
}

#define XB_TMO      128
#define XB_XCNT(j)  (256  + 64 * (j))
#define XB_XSUB(j)  (1280 + 64 * (j))
#define XB_XGEN(j)  (2304 + 64 * (j))
#define XB_TOP      3328
#define XB_TOPGEN   3392
#define XCD_BAR_WORDS 3456
#define XB_SPIN_CAP (1u << 18)

__device__ __forceinline__ unsigned xb_ld(unsigned* p)              { return __hip_atomic_load(p, __ATOMIC_RELAXED, __HIP_MEMORY_SCOPE_AGENT); }
__device__ __forceinline__ unsigned xb_add(unsigned* p, unsigned v) { return __hip_atomic_fetch_add(p, v, __ATOMIC_RELAXED, __HIP_MEMORY_SCOPE_AGENT); }
__device__ __forceinline__ unsigned xb_xcc_id() { return (unsigned)__builtin_amdgcn_s_getreg((3 << 11) | 20) & 0xFu; }
#define XB_SPIN(cond, bar) do { unsigned _sp = 0; while (cond) { __builtin_amdgcn_s_sleep(1); \
    if ((++_sp & 255u) == 0u) { if (xb_ld(&(bar)[XB_TMO])) break; if (_sp > XB_SPIN_CAP) { atomicAdd(&(bar)[XB_TMO], 1u); break; } } } } while (0)

struct XcdBarrier {
    unsigned* bar; unsigned x;
    volatile LAS unsigned* st;
};

__device__ __forceinline__ XcdBarrier xcd_barrier_post(unsigned* bar, volatile LAS unsigned* st) {
    XcdBarrier b; b.bar = bar; b.x = xb_xcc_id(); b.st = st;
    if (threadIdx.x == 0) (void)xb_add(&bar[XB_XCNT(b.x)], 1u);
    return b;
}
__device__ __forceinline__ void xcd_barrier_complete(unsigned* bar, unsigned x, unsigned& nloc, unsigned& nx) {
    const unsigned G = gridDim.x * gridDim.y * gridDim.z;
    unsigned sum, cnt, mine, sp = 0u;
    for (;;) {
        sum = 0u; cnt = 0u; mine = 0u;
#pragma unroll
        for (unsigned j = 0; j < 16; ++j) { const unsigned c = xb_ld(&bar[XB_XCNT(j)]); sum += c; cnt += (c > 0u) ? 1u : 0u; mine = (j == x) ? c : mine; }
        if (sum == G) break;
        __builtin_amdgcn_s_sleep(1);
        if ((++sp & 255u) == 0u) { if (xb_ld(&bar[XB_TMO])) break; if (sp > XB_SPIN_CAP) { atomicAdd(&bar[XB_TMO], 1u); break; } }
    }
    nloc = mine > 0u ? mine : 1u; nx = cnt > 0u ? cnt : 1u;
}

__device__ __forceinline__ void xcd_barrier(const XcdBarrier& b) {
    asm volatile("s_waitcnt vmcnt(0)" ::: "memory");
    __syncthreads();
    if (threadIdx.x == 0) {
        unsigned* bar = b.bar;
        __builtin_amdgcn_s_waitcnt(0);
        unsigned nloc = b.st[0], nx = b.st[1];
        if (nloc == 0u) { xcd_barrier_complete(bar, b.x, nloc, nx); b.st[0] = nloc; b.st[1] = nx; }
        const unsigned old = xb_add(&bar[XB_XSUB(b.x)], 1u);
        const unsigned gen = old / nloc;
        if (old + 1u == (gen + 1u) * nloc) {
            __builtin_amdgcn_fence(__ATOMIC_RELEASE, "agent");
            asm volatile("s_waitcnt vmcnt(0)" ::: "memory");
            const unsigned og = xb_add(&bar[XB_TOP], 1u);
            const unsigned tg = og / nx;
            if (og + 1u == (tg + 1u) * nx) xb_add(&bar[XB_TOPGEN], 1u);
            else XB_SPIN(xb_ld(&bar[XB_TOPGEN]) == tg, bar);
            __builtin_amdgcn_fence(__ATOMIC_ACQUIRE, "agent");
            xb_add(&bar[XB_XGEN(b.x)], 1u);
            asm volatile("s_waitcnt vmcnt(0)" ::: "memory");
        } else {
            XB_SPIN(xb_ld(&bar[XB_XGEN(b.x)]) == gen, bar);
            __builtin_amdgcn_fence(__ATOMIC_ACQUIRE, "agent");
            asm volatile("s_waitcnt vmcnt(0)" ::: "memory");
        }
    }
    __syncthreads();
}

__global__ void __launch_bounds__(NWAVES * 64, 2) mega_fwd(Params P) {
    extern __shared__ __attribute__((aligned(16))) unsigned char lds_raw[];
    LAS unsigned char* lds = (LAS unsigned char*)lds_raw;
    const int tid = threadIdx.x, lane = tid & 63, wave = __builtin_amdgcn_readfirstlane(tid >> 6);
    const int G = gridDim.x, bx = blockIdx.x, vcu = (G % 8 == 0) ? (bx % 8) * (G / 8) + bx / 8 : bx;
    const int gw = vcu * NWAVES + wave, NGW = G * NWAVES;
    const int lo = P.ph_lo, hi = P.ph_hi;
#ifndef PH_MASK
#define PH_MASK 0x7ff
#endif
#define IN(k) (((PH_MASK >> (k)) & 1) && lo <= (k) && (k) < hi)
#ifdef PROBE_A
    unsigned long long t_a = 0, t_b = 0;
#define STAMP(id) do { if ((id) == PROBE_A) t_a = __builtin_amdgcn_s_memrealtime(); if ((id) == PROBE_B) t_b = __builtin_amdgcn_s_memrealtime(); } while (0)
#else
#define STAMP(id) do { } while (0)
#endif
    volatile LAS unsigned* bst = (volatile LAS unsigned*)(lds + 128 * 1024);
    if (tid < 2) bst[tid] = 0u;
    __syncthreads();
    XcdBarrier xbar = xcd_barrier_post((unsigned*)(P.ws + WS_CTL) + 1024, bst);
#define SEAM(k) do { if (IN(k) && IN((k) + 1)) { if (P.ph_hi > 64) cg::this_grid().sync(); else xcd_barrier(xbar); } STAMP((k) + 1); } while (0)
    STAMP(0);
#define tab ((const f32x2*)(P.ws + WS_TAB))
#define XN ((bf16*)(P.ws + WS_XN))
#define part_q ((float*)(P.ws + WS_PQ))
#define part_kv ((float*)(P.ws + WS_PKV))
#define part_t ((float*)(P.ws + WS_PT))
#define part_e ((float*)(P.ws + WS_PE))
#define rstd_e ((float*)(P.ws + WS_RSTDE))
#define gates ((bf16*)P.out)

    if (IN(0)) {
        LAS float* scr = (LAS float*)(lds + wave * 16384);
#define TR(IN_, KS, N_, R_, KD, WHICH, GSP, OFF) { const int nit = ((KD) / 64) * ((R_) / 32); for (; it < nit; it += nstep) transpose_item(P.in[IN_], KS, N_, (bf16*)(P.ws + (OFF)), R_, KD, WHICH, GSP, scr, it, lane); it -= nit; }
#define TR_LATE() do { \
        TR(5, 256, 1536, 1536, 256, 1, P.in[4], WS_WQKV) \
        TR(7, 128, 2048, 2048, 256, 2, P.in[6], WS_WQKV + (size_t)1536 * 256 * 2) \
        TR(9, 1024, 1024, 1024, 1024, 3, nullptr, WS_WUP) \
        TR(10, 1024, 1024, 1024, 1024, 3, nullptr, WS_WUP + (size_t)1024 * 1024 * 2) \
        TR(11, 1024, 1024, 1024, 1024, 3, nullptr, WS_WOUT) \
        TR(14, 1024, 4096, 4096, 1024, 3, nullptr, WS_W1) \
        TR(15, 4096, 1024, 1024, 4096, 3, nullptr, WS_W2) \
        TR(19, 1024, 1024, 1024, 1024, 3, nullptr, WS_WPG) \
        TR(17, 256, 1024, 1024, 256, 3, nullptr, WS_WPP) } while (0)
        { int it = gw; const int nstep = NGW;
          TR(3, 1024, 3744, N_IN_PAD, 1024, 0, nullptr, WS_WIN)
          if (G != 256) TR_LATE(); }
        { const float* x = P.in[0]; const float* g = P.in[2];
          for (int row0 = gw; row0 < M; row0 += 4 * NGW) {
              f32x4 v[4][4], pv[4]; float ss[4] = {0.f, 0.f, 0.f, 0.f};
#pragma unroll
              for (int r2 = 0; r2 < 4; ++r2) { const int row = row0 + r2 * NGW; const f32x4* xr = (const f32x4*)(x + (size_t)row * DM);
#pragma unroll
                  for (int j = 0; j < 4; ++j) v[r2][j] = xr[lane + 64 * j];
                  pv[r2] = ((const f32x4*)(P.in[1] + (size_t)row * 256))[lane]; }
#pragma unroll
              for (int r2 = 0; r2 < 4; ++r2) { const int row = row0 + r2 * NGW;
#pragma unroll
                  for (int j = 0; j < 4; ++j) ss[r2] += dot4(v[r2][j]);
                  const float rs = __builtin_amdgcn_rsqf(wave_sum(ss[r2]) * (1.0f / DM) + EPS);
#pragma unroll
                  for (int j = 0; j < 4; ++j) { const f32x4 gg = ((const f32x4*)g)[lane + 64 * j]; *(u32x2*)(XN + (size_t)row * DM + 4 * (lane + 64 * j)) = pack4(v[r2][j] * rs * gg); }
                  *(u32x2*)((bf16*)(P.ws + WS_PB) + (size_t)row * 256 + 4 * lane) = pack4(pv[r2]); }
          } }
        for (int i = (vcu * NWAVES + wave) * 64 + lane; i < SEQ * 32; i += NGW * 64) {
            const int pos = i >> 5, j = i & 31; const float inv = expf(-9.210340371976184f * (float)j * (2.0f / 64.0f)); const float ang = (float)pos * inv;
            ((f32x2*)(P.ws + WS_TAB))[i] = (f32x2){cosf(ang), sinf(ang)}; }
    }
    SEAM(0);
    if (IN(1)) {
        pg8::Gemm g{XN, (const bf16*)(P.ws + WS_WIN), M, N_IN_PAD, 1024}; Sched S = make_sched(G, bx, 15);
        EpiP1 E{(bf16*)(P.ws + WS_QA), (bf16*)(P.ws + WS_KVR), (bf16*)(P.ws + WS_KROPE), (bf16*)(P.ws + WS_QS), (bf16*)(P.ws + WS_KS), (bf16*)(P.ws + WS_VS), gates, part_q, part_kv, tab};
        pg8::gemm_phase<EpiP1, Sched, true, true>(lds, g, S, E);
        if (G == 256 && bx >= 128) {
            LAS float* scr = (LAS float*)(lds + wave * 16384);
            int it = (bx - 128) * NWAVES + wave; const int nstep = 128 * NWAVES;
            TR_LATE();
        }
    }
#undef TR
#undef TR_LATE
    SEAM(1);
    if (IN(2)) {
        pg8::Gemm g{(const bf16*)(P.ws + WS_QA), (const bf16*)(P.ws + WS_WQKV), 2 * M, 3584, 256};
        Sched S = make_sched(G, bx, 6); S.nseg = 2; S.nN[1] = 8; S.pmo[1] = 128; S.pno[1] = 6; S.start[1] = 768; S.start[2] = 768 + 1024;
        EpiP2 E{(bf16*)(P.ws + WS_QN), (bf16*)(P.ws + WS_QR), (bf16*)(P.ws + WS_KN), (bf16*)(P.ws + WS_VM), part_q, part_kv, tab};
        pg8::gemm_phase<EpiP2, Sched, true, true>(lds, g, S, E);
    }
    SEAM(2);
    if (IN(3)) {
        for (int U = vcu; U < 2048; U += G) {
            const int c8 = U & 255, i = U >> 8, bh = c8 >> 1, s = c8 & 1, k = i >> 1, qb = (i & 1) ? 15 - 2 * k - s : 2 * k + s;
            att::unit<0>(lds, (const bf16*)(P.ws + WS_QN), (const bf16*)(P.ws + WS_QR), (const bf16*)(P.ws + WS_KN), (const bf16*)(P.ws + WS_KROPE), (const bf16*)(P.ws + WS_VM), (bf16*)(P.ws + WS_QN), nullptr, bh >> 4, bh & 15, qb, 0);
        }
        STAMP(12);
        for (int U = vcu; U < 512; U += G) swa_unit(lds, (const bf16*)(P.ws + WS_QS), (const bf16*)(P.ws + WS_KS), (const bf16*)(P.ws + WS_VS), (bf16*)(P.ws + WS_QS), P.in[8], U >> 6, (U >> 5) & 1, U & 31);
    }
    SEAM(3);
    if (IN(4)) {
        pg8::Gemm g{(const bf16*)(P.ws + WS_QN), (const bf16*)(P.ws + WS_WUP), 2 * M, 2048, 1024}; Sched S = make_sched(G, bx, 4); S.pairs = 1;
        EpiP4 E{gates, XN, (bf16*)(P.ws + WS_QA)};
        pg8::gemm_phase<EpiP4, Sched, true, true>(lds, g, S, E);
    }
    SEAM(4);
    if (IN(5)) {
        pg8::Gemm g{XN, (const bf16*)(P.ws + WS_WOUT), M, 1024, 1024}; Sched S = make_sched(G, bx, 4);
        EpiT E{(bf16*)(P.ws + WS_T), part_t};
        pg8::gemm_phase<EpiT, Sched, true, true>(lds, g, S, E);
    }
    SEAM(5);
    if (IN(6)) rowpass<true>(P.in[0], nullptr, (bf16*)P.out, (const bf16*)(P.ws + WS_T), part_t, P.in[12], P.in[13], XN, nullptr, nullptr, gw, NGW, lane);
    SEAM(6);
    if (IN(7)) {
        pg8::Gemm g{XN, (const bf16*)(P.ws + WS_W1), M, FF, 1024}; Sched S = make_sched(G, bx, 16);
        EpiRelu2 E{(bf16*)(P.ws + WS_U)};
        pg8::gemm_phase<EpiRelu2, Sched, true, true>(lds, g, S, E);
    }
    SEAM(7);
    if (IN(8)) {
        { pg8::Gemm g{(const bf16*)(P.ws + WS_U), (const bf16*)(P.ws + WS_W2), M, 1024, FF}; Sched S = make_sched(G, bx, 4);
          EpiT E{(bf16*)(P.ws + WS_T), part_t};
          pg8::gemm_phase<EpiT, Sched, true, true>(lds, g, S, E); }
        { pg8::Gemm g{(const bf16*)(P.ws + WS_PB), (const bf16*)(P.ws + WS_WPP), M, 1024, 256}; Sched S = make_sched(G, bx, 4);
          EpiT E{(bf16*)(P.ws + WS_ERAW), part_e};
          pg8::gemm_phase<EpiT, Sched, true, true>(lds, g, S, E); }
    }
    SEAM(8);
    if (IN(9)) rowpass<false>(nullptr, (const bf16*)P.out, nullptr, (const bf16*)(P.ws + WS_T), part_t, P.in[16], nullptr, XN, part_e, rstd_e, gw, NGW, lane);
    SEAM(9);
    if (IN(10)) {
        pg8::Gemm g{XN, (const bf16*)(P.ws + WS_WPG), M, 1024, 1024}; Sched S = make_sched(G, bx, 4);
        EpiOut E{P.out, XN, (const bf16*)(P.ws + WS_ERAW), rstd_e, P.in[18]};
        pg8::gemm_phase<EpiOut, Sched, true, true>(lds, g, S, E);
    }
    STAMP(11);
#ifdef PROBE_A
    cg::this_grid().sync();
    STAMP(13); cg::this_grid().sync(); cg::this_grid().sync(); cg::this_grid().sync(); cg::this_grid().sync(); STAMP(14);
    if (bx == 0 && tid == 0) P.out[0] += (float)(((t_b - t_a) / PROBE_Q) * (PROBE_Q / 100ull));
#endif
#undef IN
#undef SEAM
#undef tab
#undef XN
#undef part_q
#undef part_kv
#undef part_t
#undef part_e
#undef rstd_e
#undef gates
}

extern "C" void kernel_launch(void* const* d_in, const int* in_sizes, int n_in, void* d_out, int out_size, void* d_ws, size_t ws_size, hipStream_t stream) {
    static int grid = 0;
    if (grid == 0) {
        int dev = 0, cus = 0, per_cu = 0;
        hipGetDevice(&dev); hipDeviceGetAttribute(&cus, hipDeviceAttributeMultiprocessorCount, dev);
        if (hipFuncSetAttribute((const void*)mega_fwd, hipFuncAttributeMaxDynamicSharedMemorySize, LDS_BYTES) != hipSuccess) { fprintf(stderr, "hipFuncSetAttribute failed\n"); }
        if (hipOccupancyMaxActiveBlocksPerMultiprocessor(&per_cu, (const void*)mega_fwd, NWAVES * 64, LDS_BYTES) != hipSuccess || per_cu < 1) { fprintf(stderr, "occupancy query: %d\n", per_cu); per_cu = 1; }
        (void)hipGetLastError();
        grid = cus * per_cu;
        if (n_in != 20 || ws_size < WS_END) fprintf(stderr, "kernel_launch: unexpected n_in %d / ws %zu\n", n_in, ws_size);
    }
    Params p{};
    for (int i = 0; i < 20; ++i) p.in[i] = (const float*)d_in[i];
    p.out = (float*)d_out; p.ws = (unsigned char*)d_ws;
#if MK_N_LAUNCHES == 1
    (void)hipMemsetAsync((unsigned char*)d_ws + WS_CTL, 0, CTL_BYTES, stream);
    p.ph_lo = 0; p.ph_hi = 11;
    void* args[] = {&p};
    hipError_t e = hipLaunchCooperativeKernel((const void*)mega_fwd, dim3(grid), dim3(NWAVES * 64), args, LDS_BYTES, stream);
    if (e != hipSuccess) fprintf(stderr, "cooperative launch failed: %s (grid %d)\n", hipGetErrorString(e), grid);
#else
    for (int k = 0; k < 11; ++k) { p.ph_lo = k; p.ph_hi = k + 1; hipLaunchKernelGGL(mega_fwd, dim3(grid), dim3(NWAVES * 64), LDS_BYTES, stream, p); }
#endif
}
```
